# Optimizing an MI355X kernel written in HIP

```python
import math
import jax, jax.numpy as jnp
from jax import lax
import numpy as np

D_MODEL = 1024
BATCH = 16
SEQ = 4096
DEPTH = 1

PLE_DIM = 256
EPS = 1e-6
GN_EPS = 1e-5
NEG = -1e30

RET_HEADS = 8
RET_DV = D_MODEL // RET_HEADS
RET_DK = RET_DV // 2
RET_CHUNK = 128

NSA_HEADS = 16
NSA_GROUPS = 2
NSA_HPG = NSA_HEADS // NSA_GROUPS
NSA_DV = D_MODEL // NSA_HEADS
NSA_DK = 3 * NSA_DV // 2
CMP_LEN = 32
CMP_STRIDE = 16
SEL_LEN = 64
SEL_TOPN = 16
WINDOW = 512
NSA_Q_BLOCK = 32

D_FF = -(-8 * D_MODEL // (3 * 256)) * 256

IN_SPLITS = (
    RET_HEADS * RET_DK,
    RET_HEADS * RET_DK,
    RET_HEADS * RET_DV,
    RET_HEADS * RET_DV,
    NSA_HEADS * NSA_DK,
    NSA_GROUPS * NSA_DK,
    NSA_GROUPS * NSA_DV,
    NSA_GROUPS * NSA_DK,
    NSA_GROUPS * NSA_DV,
    NSA_GROUPS * NSA_DK,
    NSA_GROUPS * NSA_DV,
    3 * NSA_HEADS,
    2 * D_MODEL,
)
IN_TOTAL = sum(IN_SPLITS)

kernel_name = "hybrid_retention_nsa_block"


def rms(x):
    xf = x.astype(jnp.float32)
    return (xf * lax.rsqrt(jnp.mean(xf * xf, axis=-1, keepdims=True) + EPS)).astype(x.dtype)


def rms_norm(x, g):
    xf = x.astype(jnp.float32)
    y = xf * lax.rsqrt(jnp.mean(xf * xf, axis=-1, keepdims=True) + EPS)
    return (y * g.astype(jnp.float32)).astype(x.dtype)


def retention(q, k, v):
    B_, S, H, dk = q.shape
    dv = v.shape[-1]
    n_chunks = S // RET_CHUNK
    qf = q.astype(jnp.float32)
    kf = k.astype(jnp.float32) * (dk ** -0.5)
    vf = v.astype(jnp.float32)

    def to_chunks(t):
        return t.reshape(B_, n_chunks, RET_CHUNK, H, t.shape[-1]).transpose(1, 0, 3, 2, 4)

    qc, kc, vc = to_chunks(qf), to_chunks(kf), to_chunks(vf)
    log_g = jnp.log1p(-(2.0 ** (-5.0 - jnp.arange(H, dtype=jnp.float32))))
    idx = jnp.arange(RET_CHUNK, dtype=jnp.float32)
    diff = idx[:, None] - idx[None, :]
    dmat = jnp.exp(log_g[:, None, None] * jnp.maximum(diff, 0.0)) * (diff >= 0)
    xi = jnp.exp(log_g[:, None] * (idx + 1.0))
    zeta = jnp.exp(log_g[:, None] * (RET_CHUNK - 1.0 - idx))
    chunk_decay = jnp.exp(log_g * RET_CHUNK)

    def step(R, inp):
        qi, ki, vi = inp
        inner = jnp.einsum('bhcd,bhsd->bhcs', qi, ki) * dmat[None]
        o = (jnp.einsum('bhcs,bhse->bhce', inner, vi)
             + jnp.einsum('bhcd,bhde->bhce', qi, R) * xi[None, :, :, None])
        R = (R * chunk_decay[None, :, None, None]
             + jnp.einsum('bhsd,bhse->bhde', ki * zeta[None, :, :, None], vi))
        return R, o

    R0 = jnp.zeros((B_, H, dk, dv), jnp.float32)
    _, o = lax.scan(step, R0, (qc, kc, vc))
    return o.transpose(1, 0, 3, 2, 4).reshape(B_, S, H, dv)


def group_norm_heads(o, g):
    mu = jnp.mean(o, axis=-1, keepdims=True)
    var = jnp.mean(jnp.square(o - mu), axis=-1, keepdims=True)
    y = (o - mu) * lax.rsqrt(var + GN_EPS)
    B_, S, H, dv = o.shape
    return y.reshape(B_, S, H * dv) * g.astype(jnp.float32)


def compress_blocks(src, pe, w1, w2):
    B_, S, G, d = src.shape
    n_cmp = (S - CMP_LEN) // CMP_STRIDE + 1
    idx = jnp.arange(n_cmp)[:, None] * CMP_STRIDE + jnp.arange(CMP_LEN)[None, :]
    blocks = src[:, idx] + pe[:, None, :]
    blocks = blocks.transpose(0, 3, 1, 2, 4).reshape(B_, G, n_cmp, CMP_LEN * d)
    return jax.nn.gelu(blocks @ w1) @ w2


def masked_softmax(s, mask):
    s = jnp.where(mask, s.astype(jnp.float32), NEG)
    return jax.nn.softmax(s, axis=-1) * mask


def gather_blocks(blocks, idx):
    return blocks[idx]


def nsa_attention(q, k_c, v_c, k_s, v_s, k_w, v_w, gates,
                  pe_k, w1_k, w2_k, pe_v, w1_v, w2_v):
    B_, S, H, dk = q.shape
    G, hpg, dv = NSA_GROUPS, NSA_HPG, NSA_DV
    scale = dk ** -0.5
    slopes = (2.0 ** (-8.0 * (jnp.arange(H, dtype=jnp.float32) + 1.0) / H)).reshape(G, hpg)
    sl = slopes[None, :, :, None, None]

    k_cmp = compress_blocks(k_c, pe_k, w1_k, w2_k)
    v_cmp = compress_blocks(v_c, pe_v, w1_v, w2_v)
    n_cmp = k_cmp.shape[2]
    cmp_start = jnp.arange(n_cmp) * CMP_STRIDE
    cmp_end = cmp_start + CMP_LEN - 1

    n_sel = S // SEL_LEN
    topn = min(SEL_TOPN, n_sel)
    sel_start = jnp.arange(n_sel) * SEL_LEN
    overlap = ((cmp_start[:, None] < sel_start[None, :] + SEL_LEN)
               & (cmp_start[:, None] + CMP_LEN > sel_start[None, :])).astype(jnp.float32)
    ks_blocks = k_s.reshape(B_, n_sel, SEL_LEN, G, dk).transpose(0, 3, 1, 2, 4)
    vs_blocks = v_s.reshape(B_, n_sel, SEL_LEN, G, dv).transpose(0, 3, 1, 2, 4)

    kw_pad = jnp.pad(k_w.transpose(0, 2, 1, 3), ((0, 0), (0, 0), (WINDOW, 0), (0, 0)))
    vw_pad = jnp.pad(v_w.transpose(0, 2, 1, 3), ((0, 0), (0, 0), (WINDOW, 0), (0, 0)))

    n_q = S // NSA_Q_BLOCK
    q_chunks = q.reshape(B_, n_q, NSA_Q_BLOCK, G, hpg, dk).transpose(1, 0, 3, 4, 2, 5)
    g_chunks = gates.reshape(B_, n_q, NSA_Q_BLOCK, 3, G, hpg).transpose(1, 3, 0, 4, 5, 2)
    c_ids = jnp.arange(n_q, dtype=jnp.int32)

    def one_block(inp):
        c, qg, gg = inp
        t = c * NSA_Q_BLOCK + jnp.arange(NSA_Q_BLOCK)
        tf = t.astype(jnp.float32)

        s_c = jnp.einsum('bghtd,bgnd->bghtn', qg, k_cmp) * scale
        s_c = s_c - sl * (tf[:, None] - cmp_end[None, :].astype(jnp.float32))
        valid_c = cmp_end[None, :] <= t[:, None]
        p_c = masked_softmax(s_c, valid_c)
        o_c = jnp.einsum('bghtn,bgne->bghte', p_c, v_cmp.astype(jnp.float32))

        imp = jnp.einsum('bgtn,nj->bgtj', jnp.sum(p_c, axis=2), overlap)
        blk = jnp.arange(n_sel)
        cur = t // SEL_LEN
        valid_s = sel_start[None, :] <= t[:, None]
        forced = (blk[None, :] == 0) | (blk[None, :] == cur[:, None]) | (blk[None, :] == cur[:, None] - 1)
        score = jnp.where(forced, 1e6, jnp.where(valid_s, imp, -1e6))
        _, sel = lax.top_k(score, topn)
        k_g = jax.vmap(jax.vmap(gather_blocks))(ks_blocks, sel).reshape(B_, G, NSA_Q_BLOCK, topn * SEL_LEN, dk)
        v_g = jax.vmap(jax.vmap(gather_blocks))(vs_blocks, sel).reshape(B_, G, NSA_Q_BLOCK, topn * SEL_LEN, dv)
        pos_s = (sel[..., None] * SEL_LEN + jnp.arange(SEL_LEN)).reshape(B_, G, NSA_Q_BLOCK, topn * SEL_LEN)
        s_s = jnp.einsum('bghtd,bgtkd->bghtk', qg, k_g) * scale
        s_s = s_s - sl * (tf[None, None, None, :, None] - pos_s[:, :, None].astype(jnp.float32))
        valid_sel = (pos_s <= t[None, None, :, None])[:, :, None]
        p_s = masked_softmax(s_s, valid_sel)
        o_s = jnp.einsum('bghtk,bgtke->bghte', p_s, v_g.astype(jnp.float32))

        start = c * NSA_Q_BLOCK
        k_win = lax.dynamic_slice_in_dim(kw_pad, start, NSA_Q_BLOCK + WINDOW, axis=2)
        v_win = lax.dynamic_slice_in_dim(vw_pad, start, NSA_Q_BLOCK + WINDOW, axis=2)
        pos_w = start - WINDOW + jnp.arange(NSA_Q_BLOCK + WINDOW)
        s_w = jnp.einsum('bghtd,bgkd->bghtk', qg, k_win) * scale
        s_w = s_w - sl * (tf[:, None] - pos_w[None, :].astype(jnp.float32))
        valid_w = (pos_w[None, :] <= t[:, None]) & (pos_w[None, :] > t[:, None] - WINDOW) & (pos_w[None, :] >= 0)
        p_w = masked_softmax(s_w, valid_w)
        o_w = jnp.einsum('bghtk,bgke->bghte', p_w, v_win.astype(jnp.float32))

        gf = gg.astype(jnp.float32)[..., None]
        return gf[0] * o_c + gf[1] * o_s + gf[2] * o_w

    out = lax.map(one_block, (c_ids, q_chunks, g_chunks))
    out = out.transpose(1, 0, 4, 2, 3, 5).reshape(B_, S, H * dv)
    return out.astype(q.dtype)


def setup_inputs(seed: int = 0) -> dict:
    key = jax.random.key(seed)
    ks = jax.random.split(key, 20)
    f32 = jnp.float32

    def w(k, shape, fan_in):
        return jax.random.normal(k, shape, f32) * (fan_in ** -0.5)

    def gain(k, shape):
        return 1.0 + 0.05 * jax.random.normal(k, shape, f32)

    return {
        "x": jax.random.normal(ks[0], (BATCH, SEQ, D_MODEL), f32),
        "p": jax.random.normal(ks[1], (DEPTH, BATCH, SEQ, PLE_DIM), f32),
        "norm_mix_pre": gain(ks[2], (DEPTH, D_MODEL)),
        "norm_mix_post": gain(ks[3], (DEPTH, D_MODEL)),
        "norm_ffn_pre": gain(ks[4], (DEPTH, D_MODEL)),
        "norm_ffn_post": gain(ks[5], (DEPTH, D_MODEL)),
        "w_in": w(ks[6], (DEPTH, D_MODEL, IN_TOTAL), D_MODEL),
        "ret_gn_g": gain(ks[7], (DEPTH, RET_HEADS * RET_DV)),
        "cmp_pe_k": 0.1 * jax.random.normal(ks[8], (DEPTH, CMP_LEN, NSA_DK), f32),
        "cmp_w1_k": w(ks[9], (DEPTH, CMP_LEN * NSA_DK, NSA_DK), CMP_LEN * NSA_DK),
        "cmp_w2_k": w(ks[10], (DEPTH, NSA_DK, NSA_DK), NSA_DK),
        "cmp_pe_v": 0.1 * jax.random.normal(ks[11], (DEPTH, CMP_LEN, NSA_DV), f32),
        "cmp_w1_v": w(ks[12], (DEPTH, CMP_LEN * NSA_DV, NSA_DV), CMP_LEN * NSA_DV),
        "cmp_w2_v": w(ks[13], (DEPTH, NSA_DV, NSA_DV), NSA_DV),
        "w_out": w(ks[14], (DEPTH, D_MODEL, D_MODEL), D_MODEL),
        "w_ffn_in": w(ks[15], (DEPTH, D_MODEL, 2 * D_FF), D_MODEL),
        "w_ffn_out": w(ks[16], (DEPTH, D_FF, D_MODEL), D_FF),
        "w_ple": w(ks[17], (DEPTH, PLE_DIM, D_MODEL), PLE_DIM),
        "w_ple_gate": w(ks[18], (DEPTH, D_MODEL, D_MODEL), D_MODEL),
    }


def reference(x, p, norm_mix_pre, norm_mix_post, norm_ffn_pre, norm_ffn_post, w_in, ret_gn_g,
              cmp_pe_k, cmp_w1_k, cmp_w2_k, cmp_pe_v, cmp_w1_v, cmp_w2_v,
              w_out, w_ffn_in, w_ffn_out, w_ple, w_ple_gate):
    B_, S, _ = x.shape
    offsets = [int(o) for o in np.cumsum(IN_SPLITS)[:-1]]
    for i in range(DEPTH):
        h = rms_norm(x, norm_mix_pre[i])
        proj = h @ w_in[i]
        (r_q, r_k, r_v, r_g, n_q, kc, vc, ks_, vs_, kw, vw, n_g, m_g) = jnp.split(proj, offsets, axis=-1)

        ret = retention(r_q.reshape(B_, S, RET_HEADS, RET_DK),
                        r_k.reshape(B_, S, RET_HEADS, RET_DK),
                        r_v.reshape(B_, S, RET_HEADS, RET_DV))
        ret = (jax.nn.silu(r_g.astype(jnp.float32)) * group_norm_heads(ret, ret_gn_g[i])).astype(x.dtype)

        nsa = nsa_attention(
            n_q.reshape(B_, S, NSA_HEADS, NSA_DK),
            kc.reshape(B_, S, NSA_GROUPS, NSA_DK), vc.reshape(B_, S, NSA_GROUPS, NSA_DV),
            ks_.reshape(B_, S, NSA_GROUPS, NSA_DK), vs_.reshape(B_, S, NSA_GROUPS, NSA_DV),
            kw.reshape(B_, S, NSA_GROUPS, NSA_DK), vw.reshape(B_, S, NSA_GROUPS, NSA_DV),
            jax.nn.sigmoid(n_g).reshape(B_, S, 3, NSA_HEADS),
            cmp_pe_k[i], cmp_w1_k[i], cmp_w2_k[i], cmp_pe_v[i], cmp_w1_v[i], cmp_w2_v[i])

        g_a, g_b = jnp.split(jax.nn.sigmoid(m_g), 2, axis=-1)
        mix = (g_a * ret + g_b * nsa) @ w_out[i]
        x = x + rms_norm(mix, norm_mix_post[i])

        h = rms_norm(x, norm_ffn_pre[i])
        u, v = jnp.split(h @ w_ffn_in[i], 2, axis=-1)
        f = (jax.nn.silu(u) * v) @ w_ffn_out[i]
        x = x + rms_norm(f, norm_ffn_post[i])

        gate = jax.nn.sigmoid(rms(x) @ w_ple_gate[i])
        x = x + gate * (p[i] @ w_ple[i])
    return x
```

```cpp
#include <hip/hip_runtime.h>
#include <cstdio>
#include <cstdint>

#ifndef MK_N_LAUNCHES
#define MK_N_LAUNCHES 1
#endif

constexpr int NB = 16, SEQ = 4096, DM = 1024, M_TOK = NB * SEQ, DFF = 2816, PLE_D = 256;
constexpr int IN_TOTAL = 7664, IN_VIRT = 7680;
constexpr float RMS_EPS = 1e-6f, GN_EPS = 1e-5f, LOG2E = 1.4426950408889634f;
constexpr float QSCALE = 0.10206207261596575f * 1.4426950408889634f;
constexpr size_t MiB = 1u << 20;
constexpr size_t WS_CTL = 0, CTL_ZERO_BYTES = 1 * MiB;
constexpr size_t WS_WIN = 1 * MiB;
constexpr size_t WS_WOUT = 16 * MiB;
constexpr size_t WS_WFI = 18 * MiB;
constexpr size_t WS_WFO = 29 * MiB;
constexpr size_t WS_WPLE = 34 * MiB + 512 * 1024;
constexpr size_t WS_WG = 35 * MiB;
constexpr size_t WS_W1K = 37 * MiB;
constexpr size_t WS_W1V = 37 * MiB + 589824;
constexpr size_t WS_W2K = 38 * MiB, WS_W2V = 38 * MiB + 32768;
constexpr size_t WS_C1K = 38 * MiB + 65536, WS_C1V = 38 * MiB + 65536 + 2048;
constexpr size_t WS_KCMP = 39 * MiB;
constexpr size_t WS_VCMP = 40 * MiB + 512 * 1024;
constexpr size_t WS_SSP = 42 * MiB;
constexpr size_t WS_RS2 = 46 * MiB, WS_RS3 = 46 * MiB + 512 * 1024;
constexpr size_t WS_XBUF = 47 * MiB;
constexpr size_t WS_SSP2 = 420 * MiB;
constexpr size_t CW_XCNT = 65536;
constexpr size_t WS_NQ = 48 * MiB, WS_KC = 240 * MiB, WS_VC = 264 * MiB, WS_KS = 280 * MiB, WS_VS = 304 * MiB, WS_KW = 320 * MiB, WS_VW = 344 * MiB, WS_NG = 360 * MiB;
constexpr size_t WS_RQ = 366 * MiB, WS_RK = 430 * MiB, WS_RV = 494 * MiB, WS_RG = 622 * MiB, WS_MG = 750 * MiB, WS_END = 1006 * MiB;
constexpr size_t WS_MIXIN = WS_NQ;
constexpr size_t WS_MIX = WS_RQ;
constexpr size_t WS_PLEO = WS_RV;
constexpr size_t WS_H2 = WS_RG;
constexpr size_t WS_ACT = WS_NQ;
constexpr size_t OUT_H = 0;
constexpr size_t OUT_PBF = 128 * MiB;
constexpr size_t OUT_NSA = 0;
constexpr size_t OUT_F = 0;

namespace pg8 {
#define PG8_LAS __attribute__((address_space(3)))
typedef unsigned short bf16_t;
typedef short bf16x8 __attribute__((ext_vector_type(8)));
typedef float f32x4 __attribute__((ext_vector_type(4)));
typedef unsigned u32x4 __attribute__((ext_vector_type(4)));
constexpr int BM = 256, BK = 64, HALF = 128, HTB = HALF * BK * 2  , STAGE_BYTES = 8 * HTB, NXCD = 8, WGM = 4;

__host__ __device__ __forceinline__ int lds_byte(int r, int c) { const int st = (r >> 4) * 2 + (c >> 5), rr = r & 15, cc = c & 31, ob = rr * 64 + cc * 2; return st * 1024 + (ob ^ (((ob >> 9) & 1) << 5)); }
__host__ __device__ __forceinline__ void stage_rc(int b, int& R, int& C) { const int st = b / 1024, sb = b % 1024, swz = sb ^ (((sb >> 9) & 1) << 5); R = (st >> 1) * 16 + swz / 64; C = (st & 1) * 32 + (swz % 64) / 2; }
__host__ __device__ __forceinline__ int perm32(int rho) { const int n = rho >> 4, i = rho & 15; return 8 * (i >> 2) + 4 * n + (i & 3); }

struct Unit { int pm, pn; };
struct Gemm { const bf16_t* A; const bf16_t* Bt; int M, N, K; };

struct StaticOrder {
    int nM, nN, nwg, G, c;
    __host__ __device__ void init(int M, int N, int G_, int c_) { nM = M / BM; nN = N / BM; nwg = nM * nN; G = G_; c = c_; }
    __host__ __device__ bool next(int i, Unit& u) const {
        const long L = (long)i * G + c; if (L >= nwg) return false;
        int wgid = (int)L; { const int q = nwg / NXCD, r = nwg % NXCD, xcd = wgid % NXCD, off = wgid / NXCD; wgid = (xcd < r ? xcd * (q + 1) : r * (q + 1) + (xcd - r) * q) + off; }
        const int nig = WGM * nN, gid = wgid / nig, fm = gid * WGM, gsz = (nM - fm) < WGM ? (nM - fm) : WGM;
        u.pm = fm + ((wgid % nig) % gsz); u.pn = (wgid % nig) / gsz; return true;
    }
    __device__ __forceinline__ void a_ready(const Unit&) const {}
    __device__ __forceinline__ void done(const Unit&) const {}
};

struct PanelOrder {
    int nN, pm;
    __device__ __forceinline__ void init(int N, int pm_) { int n_ = N / BM; asm volatile("" : "+s"(n_)); nN = n_; pm = pm_; }
    __device__ __forceinline__ bool next(int i, Unit& u) const { if (i >= nN) return false; u.pm = pm; u.pn = i; return true; }
    __device__ __forceinline__ void a_ready(const Unit&) const {}
    __device__ __forceinline__ void done(const Unit&) const {}
};

typedef float f32x2_t __attribute__((ext_vector_type(2))); typedef __bf16 bf16x2_t __attribute__((ext_vector_type(2)));
__device__ __forceinline__ unsigned cvt_pk_bf16(float lo, float hi) { f32x2_t v = {lo, hi}; bf16x2_t b = __builtin_convertvector(v, bf16x2_t); return __builtin_bit_cast(unsigned, b); }
__device__ __forceinline__ float bf_lo(unsigned w) { return __uint_as_float(w << 16); }
__device__ __forceinline__ float bf_hi(unsigned w) { return __uint_as_float(w & 0xffff0000u); }
__device__ __forceinline__ float fast_sigmoid(float x) { return __builtin_amdgcn_rcpf(1.f + __builtin_amdgcn_exp2f(-x * ::LOG2E)); }

constexpr int EPI_STG_OFF = 131072, EPI_STG_ROW = 144, EPI_STG_WAVE = 16 * EPI_STG_ROW;
__device__ __forceinline__ void stage_store_rows(PG8_LAS unsigned char* stg, int fr, int fq, const u32x4& w0, const u32x4& w1, unsigned char* gblock, size_t pitch, int nchunk) {
    *(PG8_LAS u32x4*)(stg + fr * EPI_STG_ROW + fq * 16) = w0; *(PG8_LAS u32x4*)(stg + fr * EPI_STG_ROW + 64 + fq * 16) = w1;
    const int ln = fq * 16 + fr, r = ln >> 3, c = ln & 7;
#pragma unroll
    for (int h = 0; h < 2; ++h) { const u32x4 v = *(const PG8_LAS u32x4*)(stg + (8 * h + r) * EPI_STG_ROW + c * 16);
        if (c < nchunk) *(u32x4*)(gblock + (size_t)(8 * h + r) * pitch + c * 16) = v; }
}
__device__ __forceinline__ u32x4 pack8(const f32x4& v0, const f32x4& v1) { u32x4 w; w.x = cvt_pk_bf16(v0[0], v0[1]); w.y = cvt_pk_bf16(v0[2], v0[3]); w.z = cvt_pk_bf16(v1[0], v1[1]); w.w = cvt_pk_bf16(v1[2], v1[3]); return w; }

struct EpiProj {
    static constexpr bool PERM = true, AFTER_DRAIN = false;
    bf16_t* ws; PG8_LAS unsigned char* lds; unsigned char* scr;
    __device__ __forceinline__ static void route(int v, size_t& off, int& ld, float& sc, int& nch) {
        sc = 1.f; nch = 8;
        if (v < 512)       { off = ::WS_RQ / 2 + v;            ld = 512; }
        else if (v < 1024) { off = ::WS_RK / 2 + (v - 512);    ld = 512; }
        else if (v < 2048) { off = ::WS_RV / 2 + (v - 1024);   ld = 1024; }
        else if (v < 3072) { off = ::WS_RG / 2 + (v - 2048);   ld = 1024; }
        else if (v < 4608) { off = ::WS_NQ / 2 + (v - 3072);   ld = 1536; sc = ::QSCALE; }
        else if (v < 6656) { off = ::WS_MG / 2 + (v - 4608);   ld = 2048; sc = ::LOG2E; }
        else { const int w = v - 6656;
            if (w < 192)       { off = ::WS_KC / 2 + w;          ld = 192; }
            else if (w < 320)  { off = ::WS_VC / 2 + (w - 192);  ld = 128; }
            else if (w < 512)  { off = ::WS_KS / 2 + (w - 320);  ld = 192; }
            else if (w < 640)  { off = ::WS_VS / 2 + (w - 512);  ld = 128; }
            else if (w < 832)  { off = ::WS_KW / 2 + (w - 640);  ld = 192; }
            else if (w < 960)  { off = ::WS_VW / 2 + (w - 832);  ld = 128; }
            else               { off = ::WS_NG / 2 + (w - 960);  ld = 48; nch = 6; } }
    }
    __device__ __forceinline__ void operator()(const f32x4 (&acc)[2][2][4][2], const Unit& u, int wr, int wc, int fr_in, int fq_in) const {
        int fr = fr_in, fq = fq_in; asm volatile("" : "+v"(fr), "+v"(fq));
        size_t off; int ld, nch; float sc;
        route(u.pn * BM + wc * 64, off, ld, sc, nch);
        PG8_LAS unsigned char* stg = lds + EPI_STG_OFF + (wr * 4 + wc) * EPI_STG_WAVE;
        const int rowb = u.pm * BM + wr * 64;
#pragma unroll
        for (int ai = 0; ai < 2; ++ai)
#pragma unroll
            for (int m = 0; m < 4; ++m) { const size_t row = (size_t)(rowb + ai * HALF + m * 16);
                stage_store_rows(stg, fr, fq, pack8(acc[ai][0][m][0] * sc, acc[ai][0][m][1] * sc), pack8(acc[ai][1][m][0] * sc, acc[ai][1][m][1] * sc), (unsigned char*)(ws + off + row * ld), (size_t)ld * 2, nch);
#if defined(EPI_PROBE) && (EPI_PROBE == 4 || EPI_PROBE == 5)
                { const u32x4 wz = pack8(acc[ai][0][m][0], acc[ai][0][m][1]); const int ln = fq * 16 + fr, k2_ = (ai * 4 + m) * 2;
                  unsigned char* sb = scr + (size_t)blockIdx.x * 131072 + (size_t)(wr * 4 + wc) * 16384;
                  if (EPI_PROBE == 4) { *(volatile __attribute__((address_space(1))) u32x4*)(sb + (size_t)k2_ * 1024 + ln * 16) = wz; *(volatile __attribute__((address_space(1))) u32x4*)(sb + (size_t)(k2_ + 1) * 1024 + ln * 16) = wz; }
                  else { *(volatile __attribute__((address_space(1))) u32x4*)(scr + (size_t)blockIdx.x * 131072 + (size_t)(k2_ * 8 + (ln >> 3)) * 1024 + (wr * 4 + wc) * 128 + (ln & 7) * 16) = wz;
                         *(volatile __attribute__((address_space(1))) u32x4*)(scr + (size_t)blockIdx.x * 131072 + (size_t)((k2_ + 1) * 8 + (ln >> 3)) * 1024 + (wr * 4 + wc) * 128 + (ln & 7) * 16) = wz; } }
#endif
                }
    }
};

#if defined(GEMM_PROBE)
struct EpiNone {
    static constexpr bool PERM = true, AFTER_DRAIN = false;
    PG8_LAS unsigned char* lds;
    __device__ __forceinline__ void operator()(const f32x4 (&acc)[2][2][4][2], const Unit& u, int wr, int wc, int fr_in, int fq_in) const {
#pragma unroll
        for (int ai = 0; ai < 2; ++ai)
#pragma unroll
            for (int bj = 0; bj < 2; ++bj)
#pragma unroll
                for (int m = 0; m < 4; ++m)
#pragma unroll
                    for (int n = 0; n < 2; ++n) asm volatile("" :: "v"(acc[ai][bj][m][n]));
    }
};
#endif

struct EpiPlain {
    static constexpr bool PERM = true, AFTER_DRAIN = false;
    bf16_t* O; int ldc; PG8_LAS unsigned char* lds;
    __device__ __forceinline__ void operator()(const f32x4 (&acc)[2][2][4][2], const Unit& u, int wr, int wc, int fr_in, int fq_in) const {
        int fr = fr_in, fq = fq_in; asm volatile("" : "+v"(fr), "+v"(fq));
        PG8_LAS unsigned char* stg = lds + EPI_STG_OFF + (wr * 4 + wc) * EPI_STG_WAVE;
        const int rowb = u.pm * BM + wr * 64, colb = u.pn * BM + wc * 64;
#pragma unroll
        for (int ai = 0; ai < 2; ++ai)
#pragma unroll
            for (int m = 0; m < 4; ++m) { const size_t row = (size_t)(rowb + ai * HALF + m * 16);
                stage_store_rows(stg, fr, fq, pack8(acc[ai][0][m][0], acc[ai][0][m][1]), pack8(acc[ai][1][m][0], acc[ai][1][m][1]), (unsigned char*)(O + row * ldc + colb), (size_t)ldc * 2, 8); }
    }
};

struct EpiSumsq {
    static constexpr bool PERM = true, AFTER_DRAIN = false;
    bf16_t* O; float* ssp; PG8_LAS unsigned char* lds;
    __device__ __forceinline__ void operator()(const f32x4 (&acc)[2][2][4][2], const Unit& u, int wr, int wc, int fr_in, int fq_in) const {
        int fr = fr_in, fq = fq_in; asm volatile("" : "+v"(fr), "+v"(fq));
        PG8_LAS unsigned char* stg = lds + EPI_STG_OFF + (wr * 4 + wc) * EPI_STG_WAVE;
        const int rowb = u.pm * BM + wr * 64, colb = u.pn * BM + wc * 64;
#pragma unroll
        for (int ai = 0; ai < 2; ++ai)
#pragma unroll
            for (int m = 0; m < 4; ++m) { const int row = rowb + ai * HALF + m * 16; float s = 0.f;
#pragma unroll
                for (int bj = 0; bj < 2; ++bj) { const f32x4 v0 = acc[ai][bj][m][0], v1 = acc[ai][bj][m][1];
                    s += (v0[0] * v0[0] + v0[1] * v0[1]) + (v0[2] * v0[2] + v0[3] * v0[3]); s += (v1[0] * v1[0] + v1[1] * v1[1]) + (v1[2] * v1[2] + v1[3] * v1[3]); }
                stage_store_rows(stg, fr, fq, pack8(acc[ai][0][m][0], acc[ai][0][m][1]), pack8(acc[ai][1][m][0], acc[ai][1][m][1]), (unsigned char*)(O + (size_t)row * 1024 + colb), 2048, 8);
                s += __shfl_xor(s, 16); s += __shfl_xor(s, 32);
                if (fq == 0) ssp[(size_t)(row + fr) * 16 + u.pn * 4 + wc] = s; }
    }
};

constexpr int EPI_P_OFF = EPI_STG_OFF + 8 * EPI_STG_WAVE, EPI_S_OFF = EPI_P_OFF + 4096, EPI_X_END = EPI_S_OFF + 1024;
struct EpiNormRes {
    static constexpr bool PERM = true, AFTER_DRAIN = false;
    bf16_t* X; const float* gpost; float* ssp2; unsigned* xbuf; unsigned* cnt; PG8_LAS unsigned char* lds;
    __device__ __forceinline__ void operator()(const f32x4 (&acc)[2][2][4][2], const Unit& u, int wr, int wc, int fr_in, int fq_in) const {
        int fr = fr_in, fq = fq_in; asm volatile("" : "+v"(fr), "+v"(fq));
        const int tid = threadIdx.x, wid = __builtin_amdgcn_readfirstlane(tid >> 6), lane = tid & 63;
        PG8_LAS float* P = (PG8_LAS float*)(lds + EPI_P_OFF); PG8_LAS float* S = (PG8_LAS float*)(lds + EPI_S_OFF);
        PG8_LAS unsigned char* stg = lds + EPI_STG_OFF + (wr * 4 + wc) * EPI_STG_WAVE;
        const int rowb = u.pm * BM + wr * 64, colb = u.pn * BM + wc * 64;
        constexpr int NPRE = 6;
        u32x4 pre[NPRE][2];
#pragma unroll
        for (int q = 0; q < NPRE; ++q) { const size_t idx = (size_t)(rowb + (q >> 2) * HALF + (q & 3) * 16 + fr) * 1024 + colb + 8 * fq; pre[q][0] = *(const u32x4*)(X + idx); pre[q][1] = *(const u32x4*)(X + idx + 32); }
#pragma unroll
        for (int ai = 0; ai < 2; ++ai)
#pragma unroll
            for (int m = 0; m < 4; ++m) { float s = 0.f;
#pragma unroll
                for (int bj = 0; bj < 2; ++bj) { const f32x4 v0 = acc[ai][bj][m][0], v1 = acc[ai][bj][m][1];
                    s += (v0[0] * v0[0] + v0[1] * v0[1]) + (v0[2] * v0[2] + v0[3] * v0[3]); s += (v1[0] * v1[0] + v1[1] * v1[1]) + (v1[2] * v1[2] + v1[3] * v1[3]); }
                s += __shfl_xor(s, 16); s += __shfl_xor(s, 32);
                if (fq == 0) P[(ai * HALF + wr * 64 + m * 16 + fr) * 4 + wc] = s; }
        asm volatile("s_waitcnt lgkmcnt(0)" ::: "memory"); __builtin_amdgcn_s_barrier(); asm volatile("" ::: "memory");
        if (tid < 256) { const f32x4 p4 = *(const PG8_LAS f32x4*)(P + tid * 4);
            __hip_atomic_store(xbuf + (size_t)(u.pm * BM + tid) * 4 + u.pn, __float_as_uint((p4[0] + p4[1]) + (p4[2] + p4[3])), __ATOMIC_RELAXED, __HIP_MEMORY_SCOPE_AGENT); }
        asm volatile("s_waitcnt vmcnt(0)" ::: "memory");
        if (tid < 256 && lane == 0) __hip_atomic_fetch_add(cnt + 64 * u.pm, 1u, __ATOMIC_RELAXED, __HIP_MEMORY_SCOPE_AGENT);
        if (wid == 0) { unsigned sp = 0u;
            while ((unsigned)__builtin_amdgcn_readfirstlane(__hip_atomic_load(cnt + 64 * u.pm, __ATOMIC_RELAXED, __HIP_MEMORY_SCOPE_AGENT)) < 16u) { __builtin_amdgcn_s_sleep(2); if (++sp > (1u << 21)) break; } }
        asm volatile("s_waitcnt vmcnt(0) lgkmcnt(0)" ::: "memory"); __builtin_amdgcn_s_barrier(); asm volatile("" ::: "memory");
        if (tid < 256) { const unsigned long long* sl = (const unsigned long long*)(xbuf + (size_t)(u.pm * BM + tid) * 4);
            const unsigned long long a = __hip_atomic_load(sl, __ATOMIC_RELAXED, __HIP_MEMORY_SCOPE_AGENT), b = __hip_atomic_load(sl + 1, __ATOMIC_RELAXED, __HIP_MEMORY_SCOPE_AGENT);
            const float t = (__uint_as_float((unsigned)a) + __uint_as_float((unsigned)(a >> 32))) + (__uint_as_float((unsigned)b) + __uint_as_float((unsigned)(b >> 32)));
            S[tid] = __builtin_amdgcn_rsqf(t * (1.f / 1024.f) + ::RMS_EPS); }
        asm volatile("s_waitcnt lgkmcnt(0)" ::: "memory"); __builtin_amdgcn_s_barrier(); asm volatile("" ::: "memory");
        f32x4 gp[2][2];
#pragma unroll
        for (int bj = 0; bj < 2; ++bj)
#pragma unroll
            for (int n = 0; n < 2; ++n) gp[bj][n] = *(const f32x4*)(gpost + colb + 32 * bj + 8 * fq + 4 * n);
#pragma unroll
        for (int ai = 0; ai < 2; ++ai)
#pragma unroll
            for (int m = 0; m < 4; ++m) { const int rl = ai * HALF + wr * 64 + m * 16 + fr, row = u.pm * BM + rl; const float rs = S[rl];
                const size_t idx = (size_t)row * 1024 + colb + 8 * fq;
                const u32x4 xw0 = (ai * 4 + m) < NPRE ? pre[(ai * 4 + m) < NPRE ? ai * 4 + m : 0][0] : *(const u32x4*)(X + idx), xw1 = (ai * 4 + m) < NPRE ? pre[(ai * 4 + m) < NPRE ? ai * 4 + m : 0][1] : *(const u32x4*)(X + idx + 32);
                f32x4 o[2][2]; float s2 = 0.f;
#pragma unroll
                for (int bj = 0; bj < 2; ++bj) { const u32x4 xw = bj ? xw1 : xw0;
                    const f32x4 x0 = {bf_lo(xw.x), bf_hi(xw.x), bf_lo(xw.y), bf_hi(xw.y)}, x1v = {bf_lo(xw.z), bf_hi(xw.z), bf_lo(xw.w), bf_hi(xw.w)};
                    o[bj][0] = x0 + acc[ai][bj][m][0] * rs * gp[bj][0]; o[bj][1] = x1v + acc[ai][bj][m][1] * rs * gp[bj][1];
                    s2 += (o[bj][0][0] * o[bj][0][0] + o[bj][0][1] * o[bj][0][1]) + (o[bj][0][2] * o[bj][0][2] + o[bj][0][3] * o[bj][0][3]);
                    s2 += (o[bj][1][0] * o[bj][1][0] + o[bj][1][1] * o[bj][1][1]) + (o[bj][1][2] * o[bj][1][2] + o[bj][1][3] * o[bj][1][3]); }
                stage_store_rows(stg, fr, fq, pack8(o[0][0], o[0][1]), pack8(o[1][0], o[1][1]), (unsigned char*)(X + (size_t)(row - fr) * 1024 + colb), 2048, 8);
                s2 += __shfl_xor(s2, 16); s2 += __shfl_xor(s2, 32);
                if (fq == 0) ssp2[(size_t)row * 16 + u.pn * 4 + wc] = s2; }
    }
};

struct EpiSwiglu {
    static constexpr bool PERM = true, AFTER_DRAIN = false;
    bf16_t* O; const float* rs;
    __device__ __forceinline__ void operator()(const f32x4 (&acc)[2][2][4][2], const Unit& u, int wr, int wc, int fr_in, int fq_in) const {
        int fr = fr_in, fq = fq_in; asm volatile("" : "+v"(fr), "+v"(fq));
        const int row0 = u.pm * BM + wr * 64 + fr, col0 = u.pn * HALF + wc * 32 + 8 * fq;
#pragma unroll
        for (int ai = 0; ai < 2; ++ai)
#pragma unroll
            for (int m = 0; m < 4; ++m) { const int row = row0 + ai * HALF + m * 16; bf16_t* rowp = O + (size_t)row * ::DFF + col0; float r[8]; const float rsv = rs[row];
#pragma unroll
                for (int n = 0; n < 2; ++n)
#pragma unroll
                    for (int k = 0; k < 4; ++k) { const float a = acc[ai][0][m][n][k] * rsv, b = acc[ai][1][m][n][k] * rsv; r[4 * n + k] = a * fast_sigmoid(a) * b; }
                u32x4 w; w.x = cvt_pk_bf16(r[0], r[1]); w.y = cvt_pk_bf16(r[2], r[3]); w.z = cvt_pk_bf16(r[4], r[5]); w.w = cvt_pk_bf16(r[6], r[7]);
                *(u32x4*)rowp = w; }
    }
};

struct EpiFinal {
    static constexpr bool PERM = true, AFTER_DRAIN = false;
    const bf16_t* x2; const bf16_t* ple; const float* ssp2; float* out; PG8_LAS unsigned char* lds;
    struct In { f32x4 pp[4]; u32x4 xw[2], pw[2]; };
    __device__ __forceinline__ In load(int row, int colb, int fq) const { In r; const f32x4* p = (const f32x4*)(ssp2 + (size_t)row * 16);
#pragma unroll
        for (int q = 0; q < 4; ++q) r.pp[q] = p[q];
#pragma unroll
        for (int bj = 0; bj < 2; ++bj) { const size_t idx = (size_t)row * 1024 + colb + 32 * bj + 8 * fq; r.xw[bj] = *(const u32x4*)(x2 + idx); r.pw[bj] = *(const u32x4*)(ple + idx); }
        return r; }
    __device__ __forceinline__ void operator()(const f32x4 (&acc)[2][2][4][2], const Unit& u, int wr, int wc, int fr_in, int fq_in) const {
        int fr = fr_in, fq = fq_in; asm volatile("" : "+v"(fr), "+v"(fq));
        PG8_LAS unsigned char* stg = lds + EPI_STG_OFF + (wr * 4 + wc) * EPI_STG_WAVE;
        const int rowb = u.pm * BM + wr * 64, colb = u.pn * BM + wc * 64;
        const int ln = fq * 16 + fr, r8 = ln >> 3, c8 = ln & 7;
        In cur = load(rowb + fr, colb, fq);
#pragma unroll
        for (int g = 0; g < 8; ++g) { const int ai = g >> 2, m = g & 3; const int rowblk = rowb + ai * HALF + m * 16;
            In nxt = cur; if (g < 7) nxt = load(rowb + ((g + 1) >> 2) * HALF + ((g + 1) & 3) * 16 + fr, colb, fq);
            const f32x4 p0 = cur.pp[0], p1 = cur.pp[1], p2 = cur.pp[2], p3 = cur.pp[3];
            const float t = (((p0[0] + p0[1]) + (p0[2] + p0[3])) + ((p1[0] + p1[1]) + (p1[2] + p1[3]))) + (((p2[0] + p2[1]) + (p2[2] + p2[3])) + ((p3[0] + p3[1]) + (p3[2] + p3[3])));
            const float rsv = __builtin_amdgcn_rsqf(t * (1.f / 1024.f) + ::RMS_EPS);
#pragma unroll
            for (int bj = 0; bj < 2; ++bj) { const u32x4 xw = cur.xw[bj], pw = cur.pw[bj];
                const f32x4 a0 = acc[ai][bj][m][0] * rsv, a1 = acc[ai][bj][m][1] * rsv; u32x4 o0, o1;
                o0.x = __float_as_uint(bf_lo(xw.x) + fast_sigmoid(a0[0]) * bf_lo(pw.x)); o0.y = __float_as_uint(bf_hi(xw.x) + fast_sigmoid(a0[1]) * bf_hi(pw.x));
                o0.z = __float_as_uint(bf_lo(xw.y) + fast_sigmoid(a0[2]) * bf_lo(pw.y)); o0.w = __float_as_uint(bf_hi(xw.y) + fast_sigmoid(a0[3]) * bf_hi(pw.y));
                o1.x = __float_as_uint(bf_lo(xw.z) + fast_sigmoid(a1[0]) * bf_lo(pw.z)); o1.y = __float_as_uint(bf_hi(xw.z) + fast_sigmoid(a1[1]) * bf_hi(pw.z));
                o1.z = __float_as_uint(bf_lo(xw.w) + fast_sigmoid(a1[2]) * bf_lo(pw.w)); o1.w = __float_as_uint(bf_hi(xw.w) + fast_sigmoid(a1[3]) * bf_hi(pw.w));
                *(PG8_LAS u32x4*)(stg + fr * EPI_STG_ROW + fq * 32) = o0; *(PG8_LAS u32x4*)(stg + fr * EPI_STG_ROW + fq * 32 + 16) = o1;
#pragma unroll
                for (int h = 0; h < 2; ++h) { const u32x4 v = *(const PG8_LAS u32x4*)(stg + (8 * h + r8) * EPI_STG_ROW + c8 * 16);
                    *(u32x4*)((unsigned char*)out + ((size_t)(rowblk + 8 * h + r8) * 1024 + colb + 32 * bj) * 4 + c8 * 16) = v; } }
            cur = nxt; }
    }
};

template <class E> struct ProbeTraits { static constexpr bool no_stage = false, no_lds = false; };
#if defined(GEMM_PROBE)
template <> struct ProbeTraits<EpiNone> { static constexpr bool no_stage = (GEMM_PROBE == 2 || GEMM_PROBE == 4), no_lds = (GEMM_PROBE == 3 || GEMM_PROBE == 4); };
#endif
template <class Epi, class Sched, bool ALIGN_EPI = false, bool SP2 = false>
__device__ __forceinline__ void gemm_phase(PG8_LAS unsigned char* lds, const Gemm g, const Sched& S, const Epi& E) {
    const int tid = threadIdx.x, wid = __builtin_amdgcn_readfirstlane(tid >> 6), lane = tid & 63, wr = wid >> 2, wc = wid & 3, fr = lane & 15, fq = lane >> 4;
    const int K = g.K, nt = K / BK;
    unsigned voffA[2], voffB[2];
#pragma unroll
    for (int i = 0; i < 2; ++i) { int R, C; stage_rc(tid * 16 + i * 8192, R, C); const int Rb = Epi::PERM ? ((R & ~31) + perm32(R & 31)) : R;
        voffA[i] = (unsigned)(R * K + C) * 2u; voffB[i] = (unsigned)(Rb * K + C) * 2u; }
    const size_t kstep = (size_t)(BK * 2);
    const size_t hstep = (size_t)HALF * K * 2;
    const size_t tstep = 2 * hstep;
    const unsigned ldsw = (unsigned)wid * 1024u;
    const int aoff = lds_byte(wr * 64 + fr, fq * 8), boff = lds_byte(wc * 32 + fr, fq * 8);
#define PG8_SA(b, h) (((b) * 2 + (h)) * HTB)
#define PG8_SB(b, h) ((4 + (b) * 2 + (h)) * HTB)
#if !defined(PG8_GLOBAL_DMA)
    const __amdgpu_buffer_rsrc_t rsrcA = __builtin_amdgcn_make_buffer_rsrc((void*)g.A, 0, 0x7fffffff, 0x00020000), rsrcB = __builtin_amdgcn_make_buffer_rsrc((void*)g.Bt, 0, 0x7fffffff, 0x00020000);
#define PG8_STAGE(bufoff, gbase, voff) do { if constexpr (!ProbeTraits<Epi>::no_stage) { const bool isA_ = ((const void*)(voff) == (const void*)voffA); \
        const int so_ = (int)((const char*)(gbase) - (isA_ ? (const char*)g.A : (const char*)g.Bt)); _Pragma("unroll") for (int _i = 0; _i < 2; ++_i) { \
        if (isA_) __builtin_amdgcn_raw_ptr_buffer_load_lds(rsrcA, (PG8_LAS unsigned*)(lds + (bufoff) + ldsw + _i * 8192), 16, (int)(voff)[_i], so_, 0, 0); \
        else      __builtin_amdgcn_raw_ptr_buffer_load_lds(rsrcB, (PG8_LAS unsigned*)(lds + (bufoff) + ldsw + _i * 8192), 16, (int)(voff)[_i], so_, 0, 0); } } } while (0)
#else
#define PG8_STAGE(bufoff, gbase, voff) do { if constexpr (!ProbeTraits<Epi>::no_stage) _Pragma("unroll") for (int _i = 0; _i < 2; ++_i) \
        __builtin_amdgcn_global_load_lds((const unsigned*)((const char*)(gbase) + (voff)[_i]), (PG8_LAS unsigned*)(lds + (bufoff) + ldsw + _i * 8192), 16, 0, 0); } while (0)
#endif
#define PG8_LDA(dst, b, h) do { if constexpr (!ProbeTraits<Epi>::no_lds) _Pragma("unroll") for (int m = 0; m < 4; ++m) _Pragma("unroll") for (int k = 0; k < 2; ++k) dst[m][k] = *(const PG8_LAS bf16x8*)(lds + PG8_SA(b, h) + aoff + m * 2048 + k * 1024); } while (0)
#define PG8_LDB(dst, b, h) do { if constexpr (!ProbeTraits<Epi>::no_lds) _Pragma("unroll") for (int n = 0; n < 2; ++n) _Pragma("unroll") for (int k = 0; k < 2; ++k) dst[n][k] = *(const PG8_LAS bf16x8*)(lds + PG8_SB(b, h) + boff + n * 2048 + k * 1024); } while (0)
#if defined(PG8_NO_PRIO)
#define PG8_PRIO(x) do { } while (0)
#else
#if defined(PG8_PRIO_HI)
#define PG8_PRIO(x) __builtin_amdgcn_s_setprio((x) ? PG8_PRIO_HI : 0)
#else
#define PG8_PRIO(x) __builtin_amdgcn_s_setprio(x)
#endif
#endif
#define PG8_MMA(ai, bj, At, Bt) do { PG8_PRIO(1); _Pragma("unroll") for (int m = 0; m < 4; ++m) _Pragma("unroll") for (int n = 0; n < 2; ++n) _Pragma("unroll") for (int k = 0; k < 2; ++k) \
        acc[ai][bj][m][n] = __builtin_amdgcn_mfma_f32_16x16x32_bf16(Bt[n][k], At[m][k], acc[ai][bj][m][n], 0, 0, 0); PG8_PRIO(0); } while (0)
#define PG8_MMA_H(ai, bj, At, Bt, mlo, mhi) do { __builtin_amdgcn_s_setprio(1); _Pragma("unroll") for (int m = mlo; m < mhi; ++m) _Pragma("unroll") for (int n = 0; n < 2; ++n) _Pragma("unroll") for (int k = 0; k < 2; ++k) \
        acc[ai][bj][m][n] = __builtin_amdgcn_mfma_f32_16x16x32_bf16(Bt[n][k], At[m][k], acc[ai][bj][m][n], 0, 0, 0); __builtin_amdgcn_s_setprio(0); } while (0)
#define PG8_WAIT_V(n) asm volatile("s_waitcnt vmcnt(" #n ")" ::: "memory")
#define PG8_WAIT_L(n) asm volatile("s_waitcnt lgkmcnt(" #n ")" ::: "memory")
#define PG8_BAR __builtin_amdgcn_s_barrier()
#define PG8_SCHED __builtin_amdgcn_sched_barrier(0)
    Unit cur, nxt; int ui = 0;
    if (!S.next(0, cur)) return;
    f32x4 acc[2][2][4][2];
#pragma unroll
    for (int a = 0; a < 2; ++a)
#pragma unroll
        for (int b = 0; b < 2; ++b)
#pragma unroll
            for (int m = 0; m < 4; ++m)
#pragma unroll
                for (int n = 0; n < 2; ++n) acc[a][b][m][n] = (f32x4){0.f, 0.f, 0.f, 0.f};
    bf16x8 At[4][2], B0[2][2], B1[2][2];
    if constexpr (ProbeTraits<Epi>::no_lds) { _Pragma("unroll") for (int m = 0; m < 4; ++m) _Pragma("unroll") for (int k = 0; k < 2; ++k) { _Pragma("unroll") for (int e = 0; e < 8; ++e) At[m][k][e] = (short)(0x3e00 | ((tid * 2654435761u + (m * 2 + k) * 40503u + e * 9176u) >> 16 & 0x81ff)); } _Pragma("unroll") for (int n = 0; n < 2; ++n) _Pragma("unroll") for (int k = 0; k < 2; ++k) { _Pragma("unroll") for (int e = 0; e < 8; ++e) { B0[n][k][e] = (short)(0x3e00 | ((tid * 40503u + (n * 2 + k) * 2654435761u + e * 7919u) >> 13 & 0x81ff)); B1[n][k][e] = (short)(0x3e00 | ((tid * 9973u + (n * 2 + k) * 1234577u + e * 7919u) >> 11 & 0x81ff)); } } }
    const char* cA = (const char*)g.A + (size_t)cur.pm * tstep; const char* cB = (const char*)g.Bt + (size_t)cur.pn * tstep;
    S.a_ready(cur);
    if constexpr (SP2) {
        PG8_STAGE(PG8_SB(0, 0), cB, voffB); PG8_STAGE(PG8_SB(0, 1), cB + hstep, voffB); PG8_STAGE(PG8_SA(0, 0), cA, voffA); PG8_STAGE(PG8_SA(0, 1), cA + hstep, voffA);
        if (wr == 1) PG8_BAR;
        PG8_WAIT_V(2); PG8_BAR;
#if defined(PG8_BAL_DMA)
        PG8_STAGE(PG8_SB(1, 0), cB + kstep, voffB); PG8_STAGE(PG8_SA(1, 0), cA + kstep, voffA);
        PG8_WAIT_V(4); PG8_BAR;
#else
        PG8_STAGE(PG8_SB(1, 0), cB + kstep, voffB); PG8_STAGE(PG8_SA(1, 0), cA + kstep, voffA); PG8_STAGE(PG8_SB(1, 1), cB + hstep + kstep, voffB);
        PG8_WAIT_V(6); PG8_BAR;
#endif
    } else {
        PG8_STAGE(PG8_SB(0, 0), cB, voffB); PG8_STAGE(PG8_SA(0, 0), cA, voffA); PG8_STAGE(PG8_SB(0, 1), cB + hstep, voffB); PG8_STAGE(PG8_SA(0, 1), cA + hstep, voffA);
        if (wr == 1) PG8_BAR;
        PG8_WAIT_V(4); PG8_BAR;
        PG8_STAGE(PG8_SB(1, 0), cB + kstep, voffB); PG8_STAGE(PG8_SA(1, 0), cA + kstep, voffA); PG8_STAGE(PG8_SB(1, 1), cB + hstep + kstep, voffB);
        PG8_WAIT_V(6); PG8_BAR;
    }
    for (;;) {
        const bool has_next = S.next(ui + 1, nxt);
        const char* nA = has_next ? (const char*)g.A + (size_t)nxt.pm * tstep : cA; const char* nB = has_next ? (const char*)g.Bt + (size_t)nxt.pn * tstep : cB;
#pragma unroll 1
        for (int t = 0; t < nt; t += 2) {
            const bool last = (t == nt - 2);
            const char* a1 = cA + (size_t)(t + 1) * kstep;
            const char* b1 = cB + (size_t)(t + 1) * kstep; (void)b1;
            const char* a2 = last ? nA : cA + (size_t)(t + 2) * kstep; const char* b2 = last ? nB : cB + (size_t)(t + 2) * kstep;
            const char* a3 = a2 + kstep; const char* b3 = b2 + kstep;
            if (last && has_next) S.a_ready(nxt);
            if constexpr (SP2) {
#if defined(PG8_BAL_DMA)
            PG8_LDB(B0, 0, 0); PG8_LDB(B1, 0, 1); PG8_SCHED; PG8_LDA(At, 0, 0); PG8_STAGE(PG8_SB(1, 1), b1 + hstep, voffB); PG8_STAGE(PG8_SA(1, 1), a1 + hstep, voffA);
            PG8_WAIT_V(8); PG8_WAIT_L(0); PG8_BAR; PG8_MMA(0, 0, At, B0); PG8_MMA(0, 1, At, B1); PG8_BAR; PG8_SCHED;
            PG8_LDA(At, 0, 1); PG8_STAGE(PG8_SB(0, 0), b2, voffB); PG8_STAGE(PG8_SA(0, 0), a2, voffA);
            PG8_WAIT_V(6); PG8_WAIT_L(0); PG8_BAR; PG8_MMA(1, 0, At, B0); PG8_MMA(1, 1, At, B1); PG8_BAR; PG8_SCHED;
            PG8_LDB(B0, 1, 0); PG8_LDB(B1, 1, 1); PG8_SCHED; PG8_LDA(At, 1, 0); PG8_STAGE(PG8_SB(0, 1), b2 + hstep, voffB); PG8_STAGE(PG8_SA(0, 1), a2 + hstep, voffA);
            PG8_WAIT_V(8); PG8_WAIT_L(0); PG8_BAR; PG8_MMA(0, 0, At, B0); PG8_MMA(0, 1, At, B1); PG8_BAR; PG8_SCHED;
            PG8_LDA(At, 1, 1); PG8_STAGE(PG8_SB(1, 0), b3, voffB); PG8_STAGE(PG8_SA(1, 0), a3, voffA);
            PG8_WAIT_V(6); PG8_WAIT_L(0); PG8_BAR; PG8_MMA(1, 0, At, B0); PG8_MMA(1, 1, At, B1); PG8_BAR; PG8_SCHED;
#elif defined(PG8_STAGE_IN_MMA)
            PG8_LDB(B0, 0, 0); PG8_LDB(B1, 0, 1); PG8_SCHED; PG8_LDA(At, 0, 0);
            PG8_WAIT_V(6); PG8_WAIT_L(0); PG8_BAR; PG8_MMA_H(0, 0, At, B0, 0, 2); PG8_SCHED; PG8_STAGE(PG8_SA(1, 1), a1 + hstep, voffA); PG8_SCHED; PG8_MMA_H(0, 0, At, B0, 2, 4); PG8_MMA(0, 1, At, B1); PG8_BAR; PG8_SCHED;
            PG8_LDA(At, 0, 1);
            PG8_WAIT_V(2); PG8_WAIT_L(0); PG8_BAR; PG8_MMA_H(1, 0, At, B0, 0, 2); PG8_SCHED; PG8_STAGE(PG8_SB(0, 0), b2, voffB); PG8_SCHED; PG8_MMA_H(1, 0, At, B0, 2, 4); PG8_SCHED; PG8_STAGE(PG8_SB(0, 1), b2 + hstep, voffB); PG8_SCHED;
            PG8_MMA_H(1, 1, At, B1, 0, 2); PG8_SCHED; PG8_STAGE(PG8_SA(0, 0), a2, voffA); PG8_SCHED; PG8_MMA_H(1, 1, At, B1, 2, 4); PG8_BAR; PG8_SCHED;
            PG8_LDB(B0, 1, 0); PG8_LDB(B1, 1, 1); PG8_SCHED; PG8_LDA(At, 1, 0);
            PG8_WAIT_V(6); PG8_WAIT_L(0); PG8_BAR; PG8_MMA_H(0, 0, At, B0, 0, 2); PG8_SCHED; PG8_STAGE(PG8_SA(0, 1), a2 + hstep, voffA); PG8_SCHED; PG8_MMA_H(0, 0, At, B0, 2, 4); PG8_MMA(0, 1, At, B1); PG8_BAR; PG8_SCHED;
            PG8_LDA(At, 1, 1);
            PG8_WAIT_V(2); PG8_WAIT_L(0); PG8_BAR; PG8_MMA_H(1, 0, At, B0, 0, 2); PG8_SCHED; PG8_STAGE(PG8_SB(1, 0), b3, voffB); PG8_SCHED; PG8_MMA_H(1, 0, At, B0, 2, 4); PG8_SCHED; PG8_STAGE(PG8_SB(1, 1), b3 + hstep, voffB); PG8_SCHED;
            PG8_MMA_H(1, 1, At, B1, 0, 2); PG8_SCHED; PG8_STAGE(PG8_SA(1, 0), a3, voffA); PG8_SCHED; PG8_MMA_H(1, 1, At, B1, 2, 4); PG8_BAR; PG8_SCHED;
#else
            PG8_LDB(B0, 0, 0); PG8_LDB(B1, 0, 1); PG8_SCHED; PG8_LDA(At, 0, 0); PG8_STAGE(PG8_SA(1, 1), a1 + hstep, voffA);
            PG8_WAIT_V(8); PG8_WAIT_L(0); PG8_BAR; PG8_MMA(0, 0, At, B0); PG8_MMA(0, 1, At, B1); PG8_BAR; PG8_SCHED;
            PG8_LDA(At, 0, 1); PG8_STAGE(PG8_SB(0, 0), b2, voffB); PG8_STAGE(PG8_SB(0, 1), b2 + hstep, voffB); PG8_STAGE(PG8_SA(0, 0), a2, voffA);
            PG8_WAIT_V(8); PG8_WAIT_L(0); PG8_BAR; PG8_MMA(1, 0, At, B0); PG8_MMA(1, 1, At, B1); PG8_BAR; PG8_SCHED;
            PG8_LDB(B0, 1, 0); PG8_LDB(B1, 1, 1); PG8_SCHED; PG8_LDA(At, 1, 0); PG8_STAGE(PG8_SA(0, 1), a2 + hstep, voffA);
            PG8_WAIT_V(8); PG8_WAIT_L(0); PG8_BAR; PG8_MMA(0, 0, At, B0); PG8_MMA(0, 1, At, B1); PG8_BAR; PG8_SCHED;
            PG8_LDA(At, 1, 1); PG8_STAGE(PG8_SB(1, 0), b3, voffB); PG8_STAGE(PG8_SB(1, 1), b3 + hstep, voffB); PG8_STAGE(PG8_SA(1, 0), a3, voffA);
            PG8_WAIT_V(8); PG8_WAIT_L(0); PG8_BAR; PG8_MMA(1, 0, At, B0); PG8_MMA(1, 1, At, B1); PG8_BAR; PG8_SCHED;
#endif
            } else {
            PG8_LDB(B0, 0, 0); PG8_SCHED; PG8_LDA(At, 0, 0); PG8_STAGE(PG8_SA(1, 1), a1 + hstep, voffA);
            PG8_WAIT_L(8); PG8_BAR; PG8_WAIT_L(0); PG8_MMA(0, 0, At, B0); PG8_BAR; PG8_SCHED;
            PG8_LDB(B1, 0, 1); PG8_STAGE(PG8_SB(0, 0), b2, voffB);
            PG8_BAR; PG8_WAIT_L(0); PG8_MMA(0, 1, At, B1); PG8_BAR;
            PG8_LDA(At, 0, 1); PG8_STAGE(PG8_SA(0, 0), a2, voffA);
            PG8_BAR; PG8_WAIT_L(0); PG8_MMA(1, 0, At, B0); PG8_BAR; PG8_SCHED;
            PG8_STAGE(PG8_SB(0, 1), b2 + hstep, voffB);
            PG8_WAIT_V(6); PG8_BAR; PG8_MMA(1, 1, At, B1); PG8_BAR;
            PG8_LDB(B0, 1, 0); PG8_SCHED; PG8_LDA(At, 1, 0); PG8_STAGE(PG8_SA(0, 1), a2 + hstep, voffA);
            PG8_WAIT_L(8); PG8_BAR; PG8_WAIT_L(0); PG8_MMA(0, 0, At, B0); PG8_BAR; PG8_SCHED;
            PG8_LDB(B1, 1, 1); PG8_STAGE(PG8_SB(1, 0), b3, voffB);
            PG8_BAR; PG8_WAIT_L(0); PG8_MMA(0, 1, At, B1); PG8_BAR;
            PG8_LDA(At, 1, 1); PG8_STAGE(PG8_SA(1, 0), a3, voffA);
            PG8_BAR; PG8_WAIT_L(0); PG8_MMA(1, 0, At, B0); PG8_BAR; PG8_SCHED;
            PG8_STAGE(PG8_SB(1, 1), b3 + hstep, voffB);
            PG8_WAIT_V(6); PG8_BAR; PG8_MMA(1, 1, At, B1); PG8_BAR;
            }
        }
        if constexpr (ALIGN_EPI) { if (wr == 0) PG8_BAR; }
        if constexpr (!Epi::AFTER_DRAIN) { E(acc, cur, wr, wc, fr, fq); S.done(cur); }
        if (!has_next) break;
#pragma unroll
        for (int a = 0; a < 2; ++a)
#pragma unroll
            for (int b = 0; b < 2; ++b)
#pragma unroll
                for (int m = 0; m < 4; ++m)
#pragma unroll
                    for (int n = 0; n < 2; ++n) acc[a][b][m][n] = (f32x4){0.f, 0.f, 0.f, 0.f};
        cur = nxt; cA = nA; cB = nB; ++ui;
        if constexpr (ALIGN_EPI) { if (wr == 1) PG8_BAR; }
    }
    PG8_WAIT_V(0);
    if constexpr (!ALIGN_EPI) { if (wr == 0) PG8_BAR; }
    PG8_BAR;
    if constexpr (Epi::AFTER_DRAIN) { E.fused(acc, cur, wr, wc, fr, fq, lds, wid, lane); S.done(cur); }
#undef PG8_SA
#undef PG8_SB
#undef PG8_STAGE
#undef PG8_LDA
#undef PG8_LDB
#undef PG8_MMA
#undef PG8_WAIT_V
#undef PG8_WAIT_L
#undef PG8_BAR
#undef PG8_SCHED
}
}

constexpr int NWAVES = 8;
constexpr int N_PHASES = 11;
constexpr int N_LAUNCHES = MK_N_LAUNCHES;
constexpr int LDS_BYTES = 155648;
constexpr int RING_BYTES = 131072, LDSCTL_OFF = LDS_BYTES - 512, MISC_OFF = LDSCTL_OFF + 320;
constexpr int CW_BAR = 4096;
#define GAS __attribute__((address_space(1)))
#define LAS __attribute__((address_space(3)))
typedef unsigned short bf16;
typedef unsigned v4u __attribute__((ext_vector_type(4)));
typedef unsigned v2u __attribute__((ext_vector_type(2)));
typedef float f32x4 __attribute__((ext_vector_type(4)));
typedef float f32x16 __attribute__((ext_vector_type(16)));
typedef short bf16x8 __attribute__((ext_vector_type(8)));
typedef short s16x4 __attribute__((ext_vector_type(4)));
typedef short v4i16_t __attribute__((ext_vector_type(4)));
typedef GAS unsigned gu32;
#define LDS_WAIT() asm volatile("s_waitcnt lgkmcnt(0)" ::: "memory")
#define VM_WAIT() asm volatile("s_waitcnt vmcnt(0)" ::: "memory")
__device__ __forceinline__ unsigned pk2(float lo, float hi) { return pg8::cvt_pk_bf16(lo, hi); }
__device__ __forceinline__ float bflo(unsigned w) { return __uint_as_float(w << 16); }
__device__ __forceinline__ float bfhi(unsigned w) { return __uint_as_float(w & 0xffff0000u); }
__device__ __forceinline__ float bf1(bf16 h) { return __uint_as_float((unsigned)h << 16); }
__device__ __forceinline__ float ex2(float x) { return __builtin_amdgcn_exp2f(x); }
__device__ __forceinline__ float sigm(float x) { return __builtin_amdgcn_rcpf(1.f + __builtin_amdgcn_exp2f(-x * LOG2E)); }
__device__ __forceinline__ float wave_sum(float v) {
#pragma unroll
    for (int o = 1; o < 64; o <<= 1) v += __shfl_xor(v, o);
    return v;
}
__device__ __forceinline__ float swap32f(float v) {
    auto rr = __builtin_amdgcn_permlane32_swap(__float_as_uint(v), __float_as_uint(v), false, false);
    return (threadIdx.x & 32) ? __uint_as_float(rr[0]) : __uint_as_float(rr[1]);
}
__device__ __forceinline__ s16x4 trrd(const LAS char* p) { return __builtin_bit_cast(s16x4, __builtin_amdgcn_ds_read_tr16_b64_v4i16((LAS v4i16_t*)p)); }
#define MK8(lo, hi) (bf16x8){lo[0], lo[1], lo[2], lo[3], hi[0], hi[1], hi[2], hi[3]}

#define XB_TMO      128
#define XB_XCNT(j)  (256  + 64 * (j))
#define XB_XSUB(j)  (1280 + 64 * (j))
#define XB_XGEN(j)  (2304 + 64 * (j))
#define XB_TOP      3328
#define XB_TOPGEN   3392
#define XCD_BAR_WORDS 3456
#define XB_SPIN_CAP (1u << 18)

__device__ __forceinline__ unsigned xb_ld(unsigned* p)              { return __hip_atomic_load(p, __ATOMIC_RELAXED, __HIP_MEMORY_SCOPE_AGENT); }
__device__ __forceinline__ unsigned xb_add(unsigned* p, unsigned v) { return __hip_atomic_fetch_add(p, v, __ATOMIC_RELAXED, __HIP_MEMORY_SCOPE_AGENT); }
__device__ __forceinline__ unsigned xb_xcc_id() { return (unsigned)__builtin_amdgcn_s_getreg((3 << 11) | 20) & 0xFu; }
#define XB_SPIN(cond, bar) do { unsigned _sp = 0; while (cond) { __builtin_amdgcn_s_sleep(1); \
    if ((++_sp & 255u) == 0u) { if (xb_ld(&(bar)[XB_TMO])) break; if (_sp > XB_SPIN_CAP) { atomicAdd(&(bar)[XB_TMO], 1u); break; } } } } while (0)

struct XcdBarrier {
    unsigned* bar; unsigned x;
    volatile LAS unsigned* st;
};

__device__ __forceinline__ XcdBarrier xcd_barrier_post(unsigned* bar, volatile LAS unsigned* st) {
    XcdBarrier b; b.bar = bar; b.x = xb_xcc_id(); b.st = st;
    if (threadIdx.x == 0) (void)xb_add(&bar[XB_XCNT(b.x)], 1u);
    return b;
}
__device__ __forceinline__ void xcd_barrier_complete(unsigned* bar, unsigned x, unsigned& nloc, unsigned& nx) {
    const unsigned G = gridDim.x * gridDim.y * gridDim.z;
    unsigned sum, cnt, mine, sp = 0u;
    for (;;) {
        sum = 0u; cnt = 0u; mine = 0u;
#pragma unroll
        for (unsigned j = 0; j < 16; ++j) { const unsigned c = xb_ld(&bar[XB_XCNT(j)]); sum += c; cnt += (c > 0u) ? 1u : 0u; mine = (j == x) ? c : mine; }
        if (sum == G) break;
        __builtin_amdgcn_s_sleep(1);
        if ((++sp & 255u) == 0u) { if (xb_ld(&bar[XB_TMO])) break; if (sp > XB_SPIN_CAP) { atomicAdd(&bar[XB_TMO], 1u); break; } }
    }
    nloc = mine > 0u ? mine : 1u; nx = cnt > 0u ? cnt : 1u;
}

__device__ __forceinline__ void xcd_barrier(const XcdBarrier& b) {
    asm volatile("s_waitcnt vmcnt(0)" ::: "memory");
    __syncthreads();
    if (threadIdx.x == 0) {
        unsigned* bar = b.bar;
        __builtin_amdgcn_s_waitcnt(0);
        unsigned nloc = b.st[0], nx = b.st[1];
        if (nloc == 0u) { xcd_barrier_complete(bar, b.x, nloc, nx); b.st[0] = nloc; b.st[1] = nx; }
        const unsigned old = xb_add(&bar[XB_XSUB(b.x)], 1u);
        const unsigned gen = old / nloc;
        if (old + 1u == (gen + 1u) * nloc) {
            __builtin_amdgcn_fence(__ATOMIC_RELEASE, "agent");
            asm volatile("s_waitcnt vmcnt(0)" ::: "memory");
            const unsigned og = xb_add(&bar[XB_TOP], 1u);
            const unsigned tg = og / nx;
            if (og + 1u == (tg + 1u) * nx) xb_add(&bar[XB_TOPGEN], 1u);
            else XB_SPIN(xb_ld(&bar[XB_TOPGEN]) == tg, bar);
            __builtin_amdgcn_fence(__ATOMIC_ACQUIRE, "agent");
            xb_add(&bar[XB_XGEN(b.x)], 1u);
            asm volatile("s_waitcnt vmcnt(0)" ::: "memory");
        } else {
            XB_SPIN(xb_ld(&bar[XB_XGEN(b.x)]) == gen, bar);
            __builtin_amdgcn_fence(__ATOMIC_ACQUIRE, "agent");
            asm volatile("s_waitcnt vmcnt(0)" ::: "memory");
        }
    }
    __syncthreads();
}

struct Args { const float* in[19]; float* out; unsigned char* ws; int ph_lo, ph_hi, li, pad; };
enum { I_X = 0, I_P, I_NMPRE, I_NMPOST, I_NFPRE, I_NFPOST, I_WIN, I_GNG, I_PEK, I_W1K, I_W2K, I_PEV, I_W1V, I_W2V, I_WOUT, I_WFI, I_WFO, I_WPLE, I_WGATE };
struct Ctx { LAS unsigned char* lds; int tid, lane, wave, vcu, G; };

struct MapId { __device__ __forceinline__ int operator()(int v) const { return v; } };
struct MapWin { __device__ __forceinline__ int operator()(int v) const { return v < 4608 ? v : (v < 6656 ? v - 4608 + 5616 : (v < 7664 ? v - 6656 + 4608 : -1)); } };
struct MapFfn { __device__ __forceinline__ int operator()(int v) const { const int pn = v >> 8, r = v & 255, ch = pn * 128 + 32 * (r >> 6) + (r & 31); return ((r >> 5) & 1) ? DFF + ch : ch; } };
__device__ __forceinline__ int tile_logical(int v) { return (v & ~255) | (64 * ((v >> 5) & 3) + 32 * ((v >> 7) & 1) + (v & 31)); }
template <class MAP>
__device__ __forceinline__ void p0_transpose_item(const float* W, int K, int N, int Nv, bf16* WT, LAS float* scr, int item, int lane, const MAP& map, bool tperm, const float* kscale = nullptr) {
    const int nblk = Nv / 32, kb = item / nblk, nb = item % nblk, k0 = 64 * kb, n0 = 32 * nb;
    const int ac = map(tperm ? tile_logical(n0 + (lane & 31)) : n0 + (lane & 31));
#pragma unroll 16
    for (int i = 0; i < 32; ++i) { const int kk = 2 * i + (lane >> 5); const float ks = kscale ? kscale[k0 + kk] : 1.f; scr[kk * 33 + (lane & 31)] = ac >= 0 ? W[(size_t)(k0 + kk) * N + ac] * ks : 0.f; }
    LDS_WAIT(); asm volatile("" ::: "memory");
    const int c = lane & 7;
#pragma unroll
    for (int j = 0; j < 4; ++j) { const int n = (lane >> 3) + 8 * j; const LAS float* s = scr + (8 * c) * 33 + n;
        v4u o; o.x = pk2(s[0 * 33], s[1 * 33]); o.y = pk2(s[2 * 33], s[3 * 33]); o.z = pk2(s[4 * 33], s[5 * 33]); o.w = pk2(s[6 * 33], s[7 * 33]);
        *(GAS v4u*)(WT + (size_t)(n0 + n) * K + k0 + 8 * c) = o; }
    LDS_WAIT(); asm volatile("" ::: "memory");
}
template <int NR>
__device__ __forceinline__ void rms_rows_to_bf16(const float* x, const float* p, const f32x4 (&gg)[4], bf16* H, bf16* PB, int m0, int stride, int lane) {
    f32x4 v[NR][4], pv[NR];
#pragma unroll
    for (int r = 0; r < NR; ++r) { const GAS f32x4* xr = (const GAS f32x4*)(x + (size_t)(m0 + r * stride) * DM) + lane;
#pragma unroll
        for (int j = 0; j < 4; ++j) v[r][j] = __builtin_nontemporal_load(xr + 64 * j);
        pv[r] = __builtin_nontemporal_load((const GAS f32x4*)(p + (size_t)(m0 + r * stride) * PLE_D) + lane); }
#pragma unroll
    for (int r = 0; r < NR; ++r) { float s = 0.f;
#pragma unroll
        for (int j = 0; j < 4; ++j) s += (v[r][j].x * v[r][j].x + v[r][j].y * v[r][j].y) + (v[r][j].z * v[r][j].z + v[r][j].w * v[r][j].w);
        const float rstd = __builtin_amdgcn_rsqf(wave_sum(s) * (1.f / DM) + RMS_EPS);
        GAS v2u* o8 = (GAS v2u*)(H + (size_t)(m0 + r * stride) * DM) + lane;
#pragma unroll
        for (int j = 0; j < 4; ++j) { v2u w; w.x = pk2(v[r][j].x * rstd * gg[j].x, v[r][j].y * rstd * gg[j].y); w.y = pk2(v[r][j].z * rstd * gg[j].z, v[r][j].w * rstd * gg[j].w); o8[64 * j] = w; }
        v2u w; w.x = pk2(pv[r].x, pv[r].y); w.y = pk2(pv[r].z, pv[r].w); *((GAS v2u*)(PB + (size_t)(m0 + r * stride) * PLE_D) + lane) = w; }
}
__device__ __forceinline__ void p0_prologue(const Ctx& C, const Args& A) {
    LAS float* scr = (LAS float*)(C.lds + C.wave * 16384);
    const int gw = C.vcu * NWAVES + C.wave, NGW = C.G * NWAVES, lane = C.lane;
    unsigned char* ws = A.ws;
    constexpr int I_IN = 16 * (IN_VIRT / 32), I_OUT = 16 * 32, I_FI = 16 * (2 * DFF / 32), I_FO = (DFF / 64) * 32, I_PL = 4 * 32, I_GT = 16 * 32, I_1K = 48 * 3, I_1V = 32 * 2;
    constexpr int NITEMS = I_IN + I_OUT + I_FI + I_FO + I_PL + I_GT + I_1K + I_1V;
#if defined(P0_PROBE)
    for (int it2 = gw; it2 < 2 * NITEMS; it2 += NGW) {
        const int it = it2 >= NITEMS ? it2 - NITEMS : it2;
        int r = it;
#else
    for (int it = gw; it < NITEMS; it += NGW) {
        int r = it;
#endif
        if (r < I_IN) { p0_transpose_item(A.in[I_WIN], DM, IN_TOTAL, IN_VIRT, (bf16*)(ws + WS_WIN), scr, r, lane, MapWin(), true); continue; } r -= I_IN;
        if (r < I_OUT) { p0_transpose_item(A.in[I_WOUT], DM, DM, DM, (bf16*)(ws + WS_WOUT), scr, r, lane, MapId(), true); continue; } r -= I_OUT;
        if (r < I_FI) { p0_transpose_item(A.in[I_WFI], DM, 2 * DFF, 2 * DFF, (bf16*)(ws + WS_WFI), scr, r, lane, MapFfn(), true, A.in[I_NFPRE]); continue; } r -= I_FI;
        if (r < I_FO) { p0_transpose_item(A.in[I_WFO], DFF, DM, DM, (bf16*)(ws + WS_WFO), scr, r, lane, MapId(), true); continue; } r -= I_FO;
        if (r < I_PL) { p0_transpose_item(A.in[I_WPLE], PLE_D, DM, DM, (bf16*)(ws + WS_WPLE), scr, r, lane, MapId(), true); continue; } r -= I_PL;
        if (r < I_GT) { p0_transpose_item(A.in[I_WGATE], DM, DM, DM, (bf16*)(ws + WS_WG), scr, r, lane, MapId(), true); continue; } r -= I_GT;
        if (r < I_1K) { p0_transpose_item(A.in[I_W1K], 3072, 96, 96, (bf16*)(ws + WS_W1K), scr, r, lane, MapId(), false); continue; } r -= I_1K;
        p0_transpose_item(A.in[I_W1V], 2048, 64, 64, (bf16*)(ws + WS_W1V), scr, r, lane, MapId(), false);
    }
    { const int gt = (C.vcu * NWAVES + C.wave) * 64 + lane, NGT = NGW * 64;
      for (int i = gt; i < 96 * 96; i += NGT) { const int n = i / 96, k = i % 96; ((bf16*)(ws + WS_W2K))[i] = (bf16)(pk2(A.in[I_W2K][k * 96 + n], 0.f) & 0xffffu); }
      for (int i = gt; i < 64 * 64; i += NGT) { const int n = i / 64, k = i % 64; ((bf16*)(ws + WS_W2V))[i] = (bf16)(pk2(A.in[I_W2V][k * 64 + n], 0.f) & 0xffffu); } }
    { constexpr int W0 = (NITEMS % (256 * NWAVES)) + 640 <= 256 * NWAVES ? NITEMS % (256 * NWAVES) : 0;
      const int o4 = gw - W0;
      if (o4 >= 0 && o4 < 640) {
        const int o = o4 >> 2, sl = o4 & 3; const bool isk = o < 96; const int j = isk ? o : o - 96, J = isk ? 96 : 64, KQ = isk ? 768 : 512;
        const GAS float* pe = (const GAS float*)A.in[isk ? I_PEK : I_PEV] + sl * KQ; const GAS float* w1 = (const GAS float*)A.in[isk ? I_W1K : I_W1V] + (size_t)sl * KQ * J;
        float s = 0.f;
#pragma unroll 4
        for (int k = lane; k < KQ; k += 64) s += pe[k] * w1[(size_t)k * J + j];
        s = wave_sum(s);
        if (lane == 0) ((GAS float*)(ws + (isk ? WS_C1K : WS_C1V)))[4 * j + sl] = s;
      } }
    bf16* H = (bf16*)((unsigned char*)A.out + OUT_H); bf16* PB = (bf16*)((unsigned char*)A.out + OUT_PBF);
    { f32x4 gg[4];
#pragma unroll
      for (int j = 0; j < 4; ++j) gg[j] = *((const GAS f32x4*)A.in[I_NMPRE] + lane + 64 * j);
      static_assert(M_TOK % (4 * 256 * NWAVES) == 0, "four rows per wave per step");
      for (int m = gw; m < M_TOK; m += 4 * NGW) rms_rows_to_bf16<4>(A.in[I_X], A.in[I_P], gg, H, PB, m, NGW, lane); }
}


__device__ __forceinline__ int crow(int r, int hi) { return (r & 3) + 8 * (r >> 2) + 4 * hi; }
template <int DD, int NJT>
__device__ __forceinline__ void cmp_unit(const Ctx& C, const bf16* src, const bf16* w1t, const bf16* w2t, const float* c1, bf16* dst, int bg, int nt) {
    constexpr int J = DD, KK = 32 * DD, HS = J + 8;
    const int lane = C.lane, w = C.wave, r32 = lane & 31, hi = lane >> 5;
    const int b = bg >> 1, g = bg & 1, n0 = 32 * nt;
    LAS float* red = (LAS float*)C.lds;
    LAS bf16* hidg = (LAS bf16*)(C.lds + 8 * 32 * J * 4);
    f32x16 acc[NJT];
#pragma unroll
    for (int jt = 0; jt < NJT; ++jt) acc[jt] = f32x16{};
    const int n = n0 + r32;
#pragma unroll 1
    for (int li = 0; li < 4; ++li) {
        const int l = 4 * w + li;
        int tok = 16 * n + l; tok = tok < SEQ ? tok : SEQ - 1;
        const bf16* ap = src + ((size_t)(b * SEQ + tok)) * (2 * DD) + g * DD + hi * 8;
        const bf16* bp = w1t + (size_t)r32 * KK + l * DD + hi * 8;
#pragma unroll
        for (int s = 0; s < DD / 16; ++s) {
            const bf16x8 af = *(const bf16x8*)(ap + 16 * s);
#pragma unroll
            for (int jt = 0; jt < NJT; ++jt) { const bf16x8 bfr = *(const bf16x8*)(bp + (size_t)(32 * jt) * KK + 16 * s);
                acc[jt] = __builtin_amdgcn_mfma_f32_32x32x16_bf16(af, bfr, acc[jt], 0, 0, 0); }
        }
    }
#pragma unroll
    for (int jt = 0; jt < NJT; ++jt)
#pragma unroll
        for (int r = 0; r < 16; ++r) red[(w * 32 + crow(r, hi)) * J + 32 * jt + r32] = acc[jt][r];
    __syncthreads();
    for (int e = C.tid; e < 32 * J; e += NWAVES * 64) { const int nn = e / J, j = e % J; const f32x4 c4 = *(const GAS f32x4*)(c1 + 4 * j); float s = (c4.x + c4.y) + (c4.z + c4.w);
#pragma unroll
        for (int ww = 0; ww < 8; ++ww) s += red[(ww * 32 + nn) * J + j];
        const float u = 0.7978845608028654f * (s + 0.044715f * s * s * s);
        const float th = 1.f - 2.f * __builtin_amdgcn_rcpf(1.f + ex2(2.f * LOG2E * u));
        hidg[nn * HS + j] = (bf16)(pk2(0.5f * s * (1.f + th), 0.f) & 0xffffu); }
    __syncthreads();
    if (w < NJT) {
        f32x16 a2 = f32x16{};
#pragma unroll
        for (int s = 0; s < J / 16; ++s) { const bf16x8 af = *(const LAS bf16x8*)(hidg + r32 * HS + 16 * s + 8 * hi); const bf16x8 bfr = *(const bf16x8*)(w2t + (size_t)(32 * w + r32) * J + 16 * s + 8 * hi);
            a2 = __builtin_amdgcn_mfma_f32_32x32x16_bf16(af, bfr, a2, 0, 0, 0); }
#pragma unroll
        for (int r = 0; r < 16; ++r) { const int nn = n0 + crow(r, hi); dst[((size_t)bg * 256 + nn) * J + 32 * w + r32] = (bf16)(pk2(nn < 255 ? a2[r] : 0.f, 0.f) & 0xffffu); }
    }
    __syncthreads();
}
__device__ __forceinline__ void p2_compress(const Ctx& C, const Args& A) {
    unsigned char* ws = A.ws;
#if defined(DBG_CMP_ZERO)
    { v4u z = v4u{0u, 0u, 0u, 0u}; v4u* o = (v4u*)(ws + WS_KCMP);
      for (size_t i = (size_t)C.vcu * 512 + C.tid; i < (size_t)(WS_SSP - WS_KCMP) / 16; i += (size_t)C.G * 512) o[i] = z; }
    return;
#endif
    for (int u = C.vcu; u < 512; u += C.G) {
        const int idx = u & 255, bg = idx >> 3, nt = idx & 7;
        if (u < 256) cmp_unit<96, 3>(C, (const bf16*)(ws + WS_KC), (const bf16*)(ws + WS_W1K), (const bf16*)(ws + WS_W2K), (const float*)(ws + WS_C1K), (bf16*)(ws + WS_KCMP), bg, nt);
        else         cmp_unit<64, 2>(C, (const bf16*)(ws + WS_VC), (const bf16*)(ws + WS_W1V), (const bf16*)(ws + WS_W2V), (const float*)(ws + WS_C1V), (bf16*)(ws + WS_VCMP), bg, nt);
    }
}


constexpr int NSA_KSTR = 208;
constexpr int NSA_KB = 64 * NSA_KSTR;
constexpr int NSA_K0 = 0, NSA_K1 = NSA_KB, NSA_V0 = 2 * NSA_KB, NSA_V1 = NSA_V0 + 8192, NSA_IMPG = NSA_V1 + 8192, NSA_IMPL = NSA_IMPG + 64 * 32 * 4, NSA_WM = NSA_IMPL + 65 * 32 * 4, NSA_END = NSA_WM + 64, NSA_OUT = 61440, NSA_OUT_END = NSA_OUT + 8 * 10240, NSA_IMPS_END = NSA_OUT_END;
static_assert(NSA_END <= NSA_OUT && NSA_IMPS_END <= LDSCTL_OFF && NSA_OUT_END <= LDSCTL_OFF && (NSA_WM % 16) == 0, "NSA LDS map");
constexpr float NEGBIG = -1e30f, M_INIT = -5e29f;

constexpr float NSA_THR = 8.f;
template <int MODE, bool SEL, bool IMPS = false>
__device__ __forceinline__ void nsa_branch(const Ctx& C, const GAS bf16* Kg, int kp, const GAS bf16* Vg, int vp, unsigned long long tilemask,
                                           const bf16x8 (&qf)[6], float& mref, bool& has, float& l, f32x16& o0, f32x16& o1,
                                           int t, int lo, int hq, bool lane_en, unsigned long long selmask, unsigned long long wavemask,
                                           int wlo, int whi, int wlo_in, int whi_in, float slope2, int ka, int kb, float invl, int qi) {
    constexpr bool LOADV = (MODE == 0);
    const int tid = C.tid, lane = C.lane, r32 = lane & 31, hi = lane >> 5;
    LAS char* lds = (LAS char*)C.lds;
    const int kr0 = tid / 12, kc0 = tid % 12, kr1 = (tid + 512) / 12, kc1 = (tid + 512) % 12, vr = tid >> 3, vc = tid & 7;
    const unsigned kd0 = kr0 * NSA_KSTR + kc0 * 16, kd1 = kr1 * NSA_KSTR + kc1 * 16, vd = (vc >> 2) * 4096 + vr * 64 + (vc & 3) * 16;
    const bool k2 = tid < 256;
    v4u sk0 = v4u{}, sk1 = v4u{}, sv = v4u{};
#define NSA_GLOAD(jj) do { const size_t rb_ = (size_t)(64 * (jj)); sk0 = *(const GAS v4u*)(Kg + (rb_ + kr0) * kp + kc0 * 8); if (k2) sk1 = *(const GAS v4u*)(Kg + (rb_ + kr1) * kp + kc1 * 8); \
        if (LOADV) sv = *(const GAS v4u*)(Vg + (rb_ + vr) * vp + vc * 8); } while (0)
#define NSA_LSTORE(bb) do { *(LAS v4u*)(lds + ((bb) ? NSA_K1 : NSA_K0) + kd0) = sk0; if (k2) *(LAS v4u*)(lds + ((bb) ? NSA_K1 : NSA_K0) + kd1) = sk1; \
        if (LOADV) *(LAS v4u*)(lds + ((bb) ? NSA_V1 : NSA_V0) + vd) = sv; } while (0)
#define NSA_TOPBIT(x) (63 - __builtin_clzll(x))
    unsigned long long rem = tilemask;
    if (rem == 0ull) return;
    int j = NSA_TOPBIT(rem); rem &= ~(1ull << j);
    NSA_GLOAD(j); NSA_LSTORE(0); __syncthreads();
    int buf = 0;
    const float sa = slope2 * (float)ka;
    const unsigned span = (unsigned)(hq - lo);
    for (;;) {
        const bool more = rem != 0ull; int jn = 0;
        if (more) { jn = NSA_TOPBIT(rem); rem &= ~(1ull << jn); NSA_GLOAD(jn); }
        const bool wneed = SEL ? (((wavemask >> j) & 1ull) != 0ull) : true;
        if (wneed) {
            const bool en = lane_en && (SEL ? (((selmask >> j) & 1ull) != 0ull) : true);
            const bool do1 = (64 * j + 32 <= whi) && (64 * j + 63 >= wlo), do0 = (64 * j <= whi) && (64 * j + 31 >= wlo);
            const LAS char* kt_ = lds + (buf ? NSA_K1 : NSA_K0) + r32 * NSA_KSTR + hi * 16;
            const LAS char* vt_ = lds + (buf ? NSA_V1 : NSA_V0) + ((lane >> 4) & 1) * 32 + (lane & 3) * 8 + (4 * hi + ((lane & 15) >> 2)) * 64;
            bf16x8 kfA[6], kfB[6]; s16x4 vA[8], vB[8];
            if (do1) {
#pragma unroll
                for (int s = 0; s < 6; ++s) kfA[s] = *(const LAS bf16x8*)(kt_ + 32 * NSA_KSTR + 32 * s);
                if (MODE == 0) {
#pragma unroll
                    for (int q = 0; q < 4; ++q) { vA[2 * q] = trrd(vt_ + 2048 + (q >> 1) * 4096 + (q & 1) * 1024); vA[2 * q + 1] = trrd(vt_ + 2048 + (q >> 1) * 4096 + (q & 1) * 1024 + 512); }
                }
            }
            if (do0) {
#pragma unroll
                for (int s = 0; s < 6; ++s) kfB[s] = *(const LAS bf16x8*)(kt_ + 32 * s);
                if (MODE == 0) {
#pragma unroll
                    for (int q = 0; q < 4; ++q) { vB[2 * q] = trrd(vt_ + (q >> 1) * 4096 + (q & 1) * 1024); vB[2 * q + 1] = trrd(vt_ + (q >> 1) * 4096 + (q & 1) * 1024 + 512); }
                }
            }
#pragma unroll
            for (int sb = 0; sb < 2; ++sb) {
                const int sub = 1 - sb;
                const int i0 = 64 * j + 32 * sub;
                if (sub ? do1 : do0) {
                    const int ib = i0 + 4 * hi;
                    const float bias0 = en ? (-slope2 * (float)(t - (ka * ib + kb)) - mref) : NEGBIG;
                    f32x16 p;
                    if (i0 >= wlo_in && i0 + 31 <= whi_in) {
#pragma unroll
                        for (int r = 0; r < 16; ++r) { const int ci = (r & 3) + 8 * (r >> 2); p[r] = bias0 + sa * (float)ci; }
                    } else {
#pragma unroll
                        for (int r = 0; r < 16; ++r) { const int ci = (r & 3) + 8 * (r >> 2); const bool v = ((unsigned)(ib + ci - lo) <= span); p[r] = v ? (bias0 + sa * (float)ci) : NEGBIG; }
                    }
#pragma unroll
                    for (int s = 0; s < 6; ++s) p = __builtin_amdgcn_mfma_f32_32x32x16_bf16(sub ? kfA[s] : kfB[s], qf[s], p, 0, 0, 0);
                    if (MODE == 0) {
                        float mx = __builtin_fmaxf(__builtin_fmaxf(p[0], p[1]), p[2]);
#pragma unroll
                        for (int r = 3; r < 15; r += 2) mx = __builtin_fmaxf(__builtin_fmaxf(mx, p[r]), p[r + 1]);
                        mx = __builtin_fmaxf(mx, p[15]);
                        { auto rr = __builtin_amdgcn_permlane32_swap(__float_as_uint(mx), __float_as_uint(mx), false, false); mx = __builtin_fmaxf(__uint_as_float(rr[0]), __uint_as_float(rr[1])); }
                        const bool valid = mx > -1e29f;
                        const bool mv = valid && (!has || mx > NSA_THR);
                        if (__any(mv)) {
                            const float delta = mv ? mx : 0.f, f = (mv && has) ? ex2(-delta) : 1.f;
                            mref += delta; has = has || valid;
#pragma unroll
                            for (int r = 0; r < 16; ++r) p[r] -= delta;
                            l *= f; o0 = o0 * f; o1 = o1 * f;
                        }
#pragma unroll
                        for (int r = 0; r < 16; ++r) p[r] = ex2(p[r]);
                        const float g0_ = (p[0] + p[1]) + (p[2] + p[3]), g1_ = (p[4] + p[5]) + (p[6] + p[7]), g2_ = (p[8] + p[9]) + (p[10] + p[11]), g3_ = (p[12] + p[13]) + (p[14] + p[15]);
                        l += (g0_ + g1_) + (g2_ + g3_);
                        v4u w0, w1; w0.x = pk2(p[0], p[1]); w0.y = pk2(p[2], p[3]); w0.z = pk2(p[4], p[5]); w0.w = pk2(p[6], p[7]);
                        w1.x = pk2(p[8], p[9]); w1.y = pk2(p[10], p[11]); w1.z = pk2(p[12], p[13]); w1.w = pk2(p[14], p[15]);
                        const bf16x8 pa0 = __builtin_bit_cast(bf16x8, w0), pa1 = __builtin_bit_cast(bf16x8, w1);
                        if (IMPS) {
                            LAS unsigned* ip = (LAS unsigned*)(lds + NSA_OUT + ((C.wave * 8 + (i0 >> 5)) * 320 + lane) * 4);
                            ip[0] = pk2(g0_, g1_); ip[64] = pk2(g2_, g3_); ip[128] = __builtin_amdgcn_perm(w0.w, w0.y, 0x07060302u); ip[192] = __builtin_amdgcn_perm(w1.w, w1.y, 0x07060302u); ip[256] = __float_as_uint(mref); }
                        if (sub) {
                            o0 = __builtin_amdgcn_mfma_f32_32x32x16_bf16(MK8(vA[0], vA[1]), pa0, o0, 0, 0, 0); o1 = __builtin_amdgcn_mfma_f32_32x32x16_bf16(MK8(vA[4], vA[5]), pa0, o1, 0, 0, 0);
                            o0 = __builtin_amdgcn_mfma_f32_32x32x16_bf16(MK8(vA[2], vA[3]), pa1, o0, 0, 0, 0); o1 = __builtin_amdgcn_mfma_f32_32x32x16_bf16(MK8(vA[6], vA[7]), pa1, o1, 0, 0, 0);
                        } else {
                            o0 = __builtin_amdgcn_mfma_f32_32x32x16_bf16(MK8(vB[0], vB[1]), pa0, o0, 0, 0, 0); o1 = __builtin_amdgcn_mfma_f32_32x32x16_bf16(MK8(vB[4], vB[5]), pa0, o1, 0, 0, 0);
                            o0 = __builtin_amdgcn_mfma_f32_32x32x16_bf16(MK8(vB[2], vB[3]), pa1, o0, 0, 0, 0); o1 = __builtin_amdgcn_mfma_f32_32x32x16_bf16(MK8(vB[6], vB[7]), pa1, o1, 0, 0, 0);
                        }
                    } else {
                        LAS float* impG = (LAS float*)(lds + NSA_IMPG); LAS float* impL = (LAS float*)(lds + NSA_IMPL);
#pragma unroll
                        for (int r = 0; r < 16; ++r) p[r] = ex2(p[r]);
#pragma unroll
                        for (int k = 0; k < 4; ++k) { float G = ((p[4 * k] + p[4 * k + 1]) + (p[4 * k + 2] + p[4 * k + 3])) * invl, L = p[4 * k + 3] * invl;
                            G += __shfl_xor(G, 1); L += __shfl_xor(L, 1); G += __shfl_xor(G, 2); L += __shfl_xor(L, 2); G += __shfl_xor(G, 4); L += __shfl_xor(L, 4);
                            if ((r32 & 7) == 0) { const int jb = (i0 >> 2) + 2 * k + hi; impG[jb * 32 + qi] = G; impL[(jb + 1) * 32 + qi] = L; } }
                    }
                }
            }
        }
        if (more) NSA_LSTORE(buf ^ 1);
        __syncthreads();
        if (!more) break;
        j = jn; buf ^= 1;
    }
#undef NSA_GLOAD
#undef NSA_LSTORE
#undef NSA_TOPBIT
}

__device__ __forceinline__ void nsa_unit(const Ctx& C, const Args& A, int b, int g, int c) {
    unsigned long long wsu = (unsigned long long)A.ws, outu = (unsigned long long)A.out;
    asm volatile("" : "+s"(wsu), "+s"(outu));
    const GAS unsigned char* ws = (const GAS unsigned char*)wsu; GAS unsigned char* outb = (GAS unsigned char*)outu;
    const int tid = C.tid, lane = C.lane, w = C.wave, r32 = lane & 31, hi = lane >> 5, q4 = r32 >> 3, hh = r32 & 7;
    LAS char* lds = (LAS char*)C.lds;
    const int qi = 4 * w + q4, t = 32 * c + qi, head = g * 8 + hh;
    const size_t row = (size_t)b * SEQ + t;
    const float slope2 = ex2(-0.5f * (float)(head + 1)) * LOG2E;
    const int tmin = 32 * c + 4 * w, tmax = tmin + 3;
    for (int i = tid; i < (64 + 65) * 32; i += NWAVES * 64) ((LAS float*)(lds + NSA_IMPG))[i] = 0.f;
    bf16x8 qf[6];
    { const GAS bf16* qp = (const GAS bf16*)(ws + WS_NQ) + row * 1536 + head * 96 + hi * 8;
#pragma unroll
      for (int s = 0; s < 6; ++s) qf[s] = *(const GAS bf16x8*)(qp + 16 * s); }
    const GAS bf16* ng = (const GAS bf16*)(ws + WS_NG) + row * 48;
    const float g_c = sigm(bf1(ng[head])), g_s = sigm(bf1(ng[16 + head])), g_w = sigm(bf1(ng[32 + head]));
    LAS float* ost = (LAS float*)(lds + NSA_OUT) + w * 2560 + lane;
    const size_t bg = (size_t)(b * 2 + g);
    __syncthreads();
    const int nmax = (t - 31) >> 4;
    const int wnmax = (tmax - 31) >> 4;
    const unsigned long long cmask = (2ull << ((2 * c) >> 6)) - 1ull;
    float m_c = 0.f, l_c = 0.f, invl_c; bool has_c = false;
    const int wnmin = (tmin - 31) >> 4;
    {
        f32x16 o0 = f32x16{}, o1 = f32x16{};
        nsa_branch<0, false, true>(C, (const GAS bf16*)(ws + WS_KCMP) + bg * 256 * 96, 96, (const GAS bf16*)(ws + WS_VCMP) + bg * 256 * 64, 64, cmask, qf, m_c, has_c, l_c, o0, o1,
                             t, 0, nmax, nmax >= 0, 0ull, 0ull, 0, wnmax, 0, wnmin, slope2, 16, 31, 0.f, qi);
        { auto rr = __builtin_amdgcn_permlane32_swap(__float_as_uint(l_c), __float_as_uint(l_c), false, false); l_c = __uint_as_float(rr[0]) + __uint_as_float(rr[1]); }
        invl_c = l_c > 0.f ? __builtin_amdgcn_rcpf(l_c) : 0.f;
        { LAS float* impG = (LAS float*)(lds + NSA_IMPG); LAS float* impL = (LAS float*)(lds + NSA_IMPL);
          const int nslot = wnmax >= 0 ? (wnmax >> 5) + 1 : 0;
          for (int slot = 0; slot < nslot; ++slot) {
              const LAS unsigned* ip = (const LAS unsigned*)(lds + NSA_OUT + ((w * 8 + slot) * 320 + lane) * 4);
              const unsigned g01 = ip[0], g23 = ip[64], l01 = ip[128], l23 = ip[192];
              const float scl = ex2(__builtin_fminf(__uint_as_float(ip[256]) - m_c, 0.f)) * invl_c;
              const float Gv[4] = {bflo(g01), bfhi(g01), bflo(g23), bfhi(g23)}, Lv[4] = {bflo(l01), bfhi(l01), bflo(l23), bfhi(l23)};
#pragma unroll
              for (int k = 0; k < 4; ++k) { float G = Gv[k] * scl, L = Lv[k] * scl;
                  G += __shfl_xor(G, 1); L += __shfl_xor(L, 1); G += __shfl_xor(G, 2); L += __shfl_xor(L, 2); G += __shfl_xor(G, 4); L += __shfl_xor(L, 4);
                  if ((r32 & 7) == 0) { const int jb = 8 * slot + 2 * k + hi; impG[jb * 32 + qi] = G; impL[(jb + 1) * 32 + qi] = L; } } } }
        const float sc = g_c * invl_c;
#pragma unroll
        for (int r = 0; r < 16; ++r) { ost[64 * r] = o0[r] * sc; ost[64 * (16 + r)] = o1[r] * sc; }
    }
    unsigned long long mymask = 0ull, wmask = 0ull;
    {
        const LAS float* impG = (const LAS float*)(lds + NSA_IMPG); const LAS float* impL = (const LAS float*)(lds + NSA_IMPL);
#pragma unroll
        for (int qq = 0; qq < 4; ++qq) {
            const int qx = 4 * w + qq, tq = 32 * c + qx, cur = tq >> 6, jj = lane;
            const float imp = impG[jj * 32 + qx] + impL[jj * 32 + qx];
            const bool forced = (jj == 0) | (jj == cur) | (jj == cur - 1);
            const int key = forced ? (0x7f000000 | (63 - jj)) : (jj <= cur ? ((__float_as_int(imp) & ~63) | (63 - jj)) : (-1 - jj));
            int rank = 0;
#pragma unroll
            for (int i = 0; i < 64; ++i) { const int ki = __builtin_amdgcn_readlane(key, i); rank += (ki > key) ? 1 : 0; }
            const unsigned long long sm = __ballot(rank < 16);
            wmask |= sm; if (q4 == qq) mymask = sm;
        }
        if (lane == 0) *(LAS unsigned long long*)(lds + NSA_WM + 8 * w) = wmask;
    }
    __syncthreads();
    unsigned long long umask = 0ull;
#pragma unroll
    for (int i = 0; i < 8; ++i) umask |= *(const LAS unsigned long long*)(lds + NSA_WM + 8 * i);
    const int curmax = (32 * c + 31) >> 6;
    umask &= (2ull << curmax) - 1ull;
    { const unsigned ulo = __builtin_amdgcn_readfirstlane((unsigned)umask), uhi = __builtin_amdgcn_readfirstlane((unsigned)(umask >> 32)); umask = ((unsigned long long)uhi << 32) | ulo; }
    { const unsigned wlo_ = __builtin_amdgcn_readfirstlane((unsigned)wmask), whi_ = __builtin_amdgcn_readfirstlane((unsigned)(wmask >> 32)); wmask = ((unsigned long long)whi_ << 32) | wlo_; }
    {
        float m_s = 0.f, l_s = 0.f; bool has_s = false; f32x16 o0 = f32x16{}, o1 = f32x16{};
        nsa_branch<0, true>(C, (const GAS bf16*)(ws + WS_KS) + ((size_t)b * SEQ) * 192 + g * 96, 192, (const GAS bf16*)(ws + WS_VS) + ((size_t)b * SEQ) * 128 + g * 64, 128, umask, qf, m_s, has_s, l_s, o0, o1,
                            t, 0, t, true, mymask, wmask, 0, tmax, 0, tmin, slope2, 1, 0, 0.f, qi);
        { auto rr = __builtin_amdgcn_permlane32_swap(__float_as_uint(l_s), __float_as_uint(l_s), false, false); l_s = __uint_as_float(rr[0]) + __uint_as_float(rr[1]); }
        const float sc = g_s * (l_s > 0.f ? __builtin_amdgcn_rcpf(l_s) : 0.f);
#pragma unroll
        for (int r = 0; r < 16; ++r) { ost[64 * r] += o0[r] * sc; ost[64 * (16 + r)] += o1[r] * sc; }
    }
    {
        const int plo = 32 * c - 511 > 0 ? 32 * c - 511 : 0;
        const int jlo = plo >> 6, jhi = (32 * c + 31) >> 6;
        const unsigned long long wm_ = ((2ull << jhi) - 1ull) & ~((1ull << jlo) - 1ull);
        float m_w = 0.f, l_w = 0.f; bool has_w = false; f32x16 o0 = f32x16{}, o1 = f32x16{};
        nsa_branch<0, false>(C, (const GAS bf16*)(ws + WS_KW) + ((size_t)b * SEQ) * 192 + g * 96, 192, (const GAS bf16*)(ws + WS_VW) + ((size_t)b * SEQ) * 128 + g * 64, 128, wm_, qf, m_w, has_w, l_w, o0, o1,
                             t, t - 511, t, true, 0ull, 0ull, tmin - 511, tmax, tmax - 511, tmin, slope2, 1, 0, 0.f, qi);
        { auto rr = __builtin_amdgcn_permlane32_swap(__float_as_uint(l_w), __float_as_uint(l_w), false, false); l_w = __uint_as_float(rr[0]) + __uint_as_float(rr[1]); }
        const float sc = g_w * (l_w > 0.f ? __builtin_amdgcn_rcpf(l_w) : 0.f);
        f32x16 out0, out1;
#pragma unroll
        for (int r = 0; r < 16; ++r) { out0[r] = ost[64 * r] + o0[r] * sc; out1[r] = ost[64 * (16 + r)] + o1[r] * sc; }
        LAS char* ot = lds + NSA_K0 + w * 4096;
#pragma unroll
        for (int k = 0; k < 4; ++k) { v2u w0; w0.x = pk2(out0[4 * k], out0[4 * k + 1]); w0.y = pk2(out0[4 * k + 2], out0[4 * k + 3]); *(LAS v2u*)(ot + q4 * 1024 + hh * 128 + (8 * k + 4 * hi) * 2) = w0;
            v2u w1; w1.x = pk2(out1[4 * k], out1[4 * k + 1]); w1.y = pk2(out1[4 * k + 2], out1[4 * k + 3]); *(LAS v2u*)(ot + q4 * 1024 + hh * 128 + (32 + 8 * k + 4 * hi) * 2) = w1; }
        GAS unsigned char* ob = outb + OUT_NSA + ((size_t)b * SEQ + 32 * c + 4 * w) * 2048 + g * 1024;
#pragma unroll
        for (int i = 0; i < 4; ++i) { const v4u v = *(const LAS v4u*)(ot + i * 1024 + lane * 16); *(GAS v4u*)(ob + (size_t)i * 2048 + lane * 16) = v; }
    }
}
__device__ __forceinline__ void p3_nsa(const Ctx& C, const Args& A) {
#if defined(DBG_COPY_OFF)
    { const bf16* src = (const bf16*)(A.ws + (size_t)DBG_COPY_OFF * MiB); bf16* o = (bf16*)((unsigned char*)A.out + OUT_NSA);
      for (size_t i = (size_t)C.vcu * 512 + C.tid; i < (size_t)M_TOK * 1024; i += (size_t)C.G * 512) { const size_t r = (i >> 10) & DBG_COPY_RMASK, c = i & 1023; o[i] = src[r * DBG_COPY_LD + (c % DBG_COPY_LD)]; } }
    return;
#endif
#if defined(DBG_NSA_ZERO)
    { v4u z = v4u{0u, 0u, 0u, 0u}; v4u* o = (v4u*)((unsigned char*)A.out + OUT_NSA);
      for (size_t i = (size_t)C.vcu * 512 + C.tid; i < (size_t)M_TOK * 1024 * 2 / 16; i += (size_t)C.G * 512) o[i] = z; }
    return;
#endif
    for (int u = C.vcu; u < 4096; u += C.G) {
        const int bg = (u & 255) >> 3, c = (u & 7) + 8 * (u >> 8);
        nsa_unit(C, A, bg >> 1, bg & 1, c);
    }
}


constexpr int RT_KZ = 0, RT_KZS = 144, RT_V = 128 * RT_KZS, RT_R = RT_V + 32768, RT_Y = RT_R + 128 * RT_KZS, RT_YS = 528, RT_END = RT_Y + 8 * 16 * RT_YS;
static_assert(RT_END <= LDSCTL_OFF, "retention LDS map");
typedef float f32x4v __attribute__((ext_vector_type(4)));
#ifndef RT_SPLIT
#define RT_SPLIT 18
#endif
#define RT_BAR() asm volatile("s_waitcnt lgkmcnt(0)\n\ts_barrier" ::: "memory")

__device__ __forceinline__ void ret_unit(const Ctx& C, const Args& A, int b, int h, int seg) {
    unsigned char* ws = A.ws;
    const int tid = C.tid, lane = C.lane, w = C.wave, i_in = lane & 15, fq = lane >> 4;
    LAS char* lds = (LAS char*)C.lds;
    const float eps_g = ex2(-5.f - (float)h);
    const float lg = -eps_g * (1.f + eps_g * (0.5f + eps_g * (0.33333334f + eps_g * (0.25f + eps_g * (0.2f + eps_g * 0.16666667f))))) * LOG2E;
    const float dec128 = ex2(128.f * lg);
    const int ic = 16 * w + i_in;
    const float gi = ex2((float)(ic - 127) * lg), xi = ex2((float)(ic + 1) * lg);
    unsigned long long wsu = (unsigned long long)ws, nsu = (unsigned long long)((const unsigned char*)A.out + OUT_NSA);
    const GAS bf16* wsb = (const GAS bf16*)wsu; const GAS bf16* nsb = (const GAS bf16*)nsu;
#define RT_OPAQUE() do { asm volatile("" : "+s"(wsu), "+s"(nsu)); wsb = (const GAS bf16*)wsu; nsb = (const GAS bf16*)nsu; } while (0)
    constexpr unsigned O_RQ = (unsigned)(WS_RQ / 2), O_RK = (unsigned)(WS_RK / 2), O_RV = (unsigned)(WS_RV / 2), O_RG = (unsigned)(WS_RG / 2), O_MG = (unsigned)(WS_MG / 2), O_MX = (unsigned)(WS_MIXIN / 2);
    const int ec = 8 * (lane & 15), er = lane >> 4;
    const f32x4 gnA = *(const f32x4*)(A.in[I_GNG] + h * 128 + ec), gnB = *(const f32x4*)(A.in[I_GNG] + h * 128 + ec + 4);
    f32x4v R[4];
#pragma unroll
    for (int dt = 0; dt < 4; ++dt) R[dt] = f32x4v{0.f, 0.f, 0.f, 0.f};
    const int tq = i_in >> 2, tp = i_in & 3;
    const int c_first = seg ? RT_SPLIT : 0, n_total = seg ? 32 : RT_SPLIT;
    if (c_first == 0) {
#pragma unroll
        for (int dt = 0; dt < 4; ++dt)
#pragma unroll
            for (int r = 0; r < 4; ++r) *(LAS bf16*)(lds + RT_R + (16 * w + 4 * fq + r) * RT_KZS + (16 * dt + i_in) * 2) = (bf16)0;
    }
    v4u sK[2], sV[4]; bf16x8 qn[2] = {bf16x8{}, bf16x8{}};
#define RT_LOADKV(chn) do { const unsigned T_ = (unsigned)(b * SEQ + (chn) * 128); \
        _Pragma("unroll") for (int i_ = 0; i_ < 2; ++i_) { const unsigned x_ = tid + 512 * i_; sK[i_] = *(const GAS v4u*)(wsb + (O_RK + (T_ + (x_ >> 3)) * 512u + h * 64 + (x_ & 7) * 8)); } \
        _Pragma("unroll") for (int i_ = 0; i_ < 4; ++i_) { const unsigned x_ = tid + 512 * i_; sV[i_] = *(const GAS v4u*)(wsb + (O_RV + (T_ + (x_ >> 4)) * 1024u + h * 128 + (x_ & 15) * 8)); } } while (0)
#define RT_LOADQ(chn) do { const unsigned qo_ = O_RQ + (unsigned)(b * SEQ + (chn) * 128 + ic) * 512u + h * 64 + 8 * fq; qn[0] = *(const GAS bf16x8*)(wsb + qo_); qn[1] = *(const GAS bf16x8*)(wsb + qo_ + 32); } while (0)
    RT_LOADKV(0); if (c_first == 0) RT_LOADQ(0);
#pragma unroll 1
    for (int ch = 0; ch < n_total; ++ch) {
        RT_OPAQUE();
        const bool full = ch >= c_first;
        const unsigned T0 = (unsigned)(b * SEQ + ch * 128);
#pragma unroll
        for (int i = 0; i < 2; ++i) { const int x = tid + 512 * i, rr = x >> 3, cc = x & 7; const v4u kv = sK[i];
            const float z = ex2((float)(127 - rr) * lg) * 0.125f;
            v4u o; o.x = pk2(bflo(kv.x) * z, bfhi(kv.x) * z); o.y = pk2(bflo(kv.y) * z, bfhi(kv.y) * z); o.z = pk2(bflo(kv.z) * z, bfhi(kv.z) * z); o.w = pk2(bflo(kv.w) * z, bfhi(kv.w) * z);
            *(LAS v4u*)(lds + RT_KZ + rr * RT_KZS + cc * 16) = o; }
#pragma unroll
        for (int i = 0; i < 4; ++i) { const int x = tid + 512 * i, rr = x >> 4, cc = x & 15;
            *(LAS v4u*)(lds + RT_V + (cc >> 1) * 4096 + rr * 32 + (cc & 1) * 16) = sV[i]; }
        const bf16x8 qf0 = qn[0], qf1 = qn[1];
        RT_BAR();
        if (ch + 1 < n_total) { RT_LOADKV(ch + 1); if (ch + 1 >= c_first) RT_LOADQ(ch + 1); }
        v4u eRG[4], eGA[4], eGB[4], eNS[4];
        if (full) {
#pragma unroll
            for (int k = 0; k < 4; ++k) { const unsigned rw = T0 + 16 * w + 4 * k + er; const unsigned e0 = h * 128 + ec;
                eRG[k] = *(const GAS v4u*)(wsb + (O_RG + rw * 1024u + e0)); eGA[k] = *(const GAS v4u*)(wsb + (O_MG + rw * 2048u + e0));
#if defined(RT_PROBE) && RT_PROBE == 2
                eGB[k] = *(const GAS v4u*)(wsb + (O_MG + rw * 2048u + 1024u + e0)); eNS[k] = *(const GAS v4u*)(nsb + (rw * 1024u + e0));
#endif
                }
        }
        if (full) {
            f32x4v acc[8];
#pragma unroll
            for (int et = 0; et < 8; ++et) { const LAS char* rp = lds + RT_R + (16 * et + i_in) * RT_KZS + fq * 16;
                f32x4v a = f32x4v{0.f, 0.f, 0.f, 0.f};
                a = __builtin_amdgcn_mfma_f32_16x16x32_bf16(*(const LAS bf16x8*)rp, qf0, a, 0, 0, 0);
                a = __builtin_amdgcn_mfma_f32_16x16x32_bf16(*(const LAS bf16x8*)(rp + 64), qf1, a, 0, 0, 0);
                acc[et] = a * xi; }
            bf16x8 pf[4];
#pragma unroll
            for (int a = 0; a < 4; ++a) {
                v4u pw = v4u{0u, 0u, 0u, 0u};
                if (2 * a <= w) {
#pragma unroll
                    for (int hf = 0; hf < 2; ++hf) { const int jt = 2 * a + hf;
                        if (jt <= w) { const LAS char* kp = lds + RT_KZ + (16 * jt + i_in) * RT_KZS + fq * 16;
                            f32x4v s = f32x4v{0.f, 0.f, 0.f, 0.f};
                            s = __builtin_amdgcn_mfma_f32_16x16x32_bf16(*(const LAS bf16x8*)kp, qf0, s, 0, 0, 0);
                            s = __builtin_amdgcn_mfma_f32_16x16x32_bf16(*(const LAS bf16x8*)(kp + 64), qf1, s, 0, 0, 0);
                            float pv[4];
#pragma unroll
                            for (int r = 0; r < 4; ++r) pv[r] = (jt < w || (4 * fq + r) <= i_in) ? s[r] * gi : 0.f;
                            if (hf == 0) { pw.x = pk2(pv[0], pv[1]); pw.y = pk2(pv[2], pv[3]); } else { pw.z = pk2(pv[0], pv[1]); pw.w = pk2(pv[2], pv[3]); } } }
                }
                pf[a] = __builtin_bit_cast(bf16x8, pw);
            }
#if !defined(RT_PROBE) || RT_PROBE != 2
#pragma unroll
            for (int k = 0; k < 4; ++k) { const unsigned rw = T0 + 16 * w + 4 * k + er; const unsigned e0 = h * 128 + ec;
                eGB[k] = *(const GAS v4u*)(wsb + (O_MG + rw * 2048u + 1024u + e0)); eNS[k] = *(const GAS v4u*)(nsb + (rw * 1024u + e0)); }
#endif
#pragma unroll
            for (int a = 0; a < 4; ++a) {
                if (2 * a <= w) {
#pragma unroll
                    for (int et = 0; et < 8; ++et) { const LAS char* vp = lds + RT_V + et * 4096 + (32 * a + 4 * fq + tq) * 32 + tp * 8;
                        const s16x4 lo_ = trrd(vp), hi_ = trrd(vp + 16 * 32);
                        acc[et] = __builtin_amdgcn_mfma_f32_16x16x32_bf16(MK8(lo_, hi_), pf[a], acc[et], 0, 0, 0); }
                }
            }
            float s1 = 0.f;
#pragma unroll
            for (int et = 0; et < 8; ++et) s1 += (acc[et][0] + acc[et][1]) + (acc[et][2] + acc[et][3]);
            s1 += __shfl_xor(s1, 16); s1 += __shfl_xor(s1, 32);
            const float mu = s1 * (1.f / 128.f);
            float s2 = 0.f;
#pragma unroll
            for (int et = 0; et < 8; ++et) { const f32x4v dlt = acc[et] - mu; s2 += (dlt[0] * dlt[0] + dlt[1] * dlt[1]) + (dlt[2] * dlt[2] + dlt[3] * dlt[3]); }
            s2 += __shfl_xor(s2, 16); s2 += __shfl_xor(s2, 32);
            const float rstd = __builtin_amdgcn_rsqf(s2 * (1.f / 128.f) + GN_EPS);
            LAS char* yw = lds + RT_Y + w * (16 * RT_YS);
#pragma unroll
            for (int et = 0; et < 8; ++et) *(LAS f32x4v*)(yw + i_in * RT_YS + (16 * et + 4 * fq) * 4) = (acc[et] - mu) * rstd;
            LDS_WAIT();
#pragma unroll
            for (int k = 0; k < 4; ++k) { const f32x4v ya = *(const LAS f32x4v*)(yw + (4 * k + er) * RT_YS + ec * 4), yb = *(const LAS f32x4v*)(yw + (4 * k + er) * RT_YS + ec * 4 + 16);
                const float yf_[8] = {ya[0], ya[1], ya[2], ya[3], yb[0], yb[1], yb[2], yb[3]};
                const unsigned rg_[4] = {eRG[k].x, eRG[k].y, eRG[k].z, eRG[k].w}, ga_[4] = {eGA[k].x, eGA[k].y, eGA[k].z, eGA[k].w};
                const unsigned gb_[4] = {eGB[k].x, eGB[k].y, eGB[k].z, eGB[k].w}, ns_[4] = {eNS[k].x, eNS[k].y, eNS[k].z, eNS[k].w};
                const float gn_[8] = {gnA.x, gnA.y, gnA.z, gnA.w, gnB.x, gnB.y, gnB.z, gnB.w};
                unsigned ow[4];
#pragma unroll
                for (int q = 0; q < 4; ++q) { float o2[2];
#pragma unroll
                    for (int hh = 0; hh < 2; ++hh) { const float y = yf_[2 * q + hh] * gn_[2 * q + hh], rg = hh ? bfhi(rg_[q]) : bflo(rg_[q]), ga = hh ? bfhi(ga_[q]) : bflo(ga_[q]);
                        const float gb = hh ? bfhi(gb_[q]) : bflo(gb_[q]), nsv = hh ? bfhi(ns_[q]) : bflo(ns_[q]);
                        const float den = (1.f + ex2(-rg * LOG2E)) * (1.f + ex2(-ga));
                        o2[hh] = rg * __builtin_amdgcn_rcpf(den) * y + __builtin_amdgcn_rcpf(1.f + ex2(-gb)) * nsv; }
                    ow[q] = pk2(o2[0], o2[1]); }
                v4u ov; ov.x = ow[0]; ov.y = ow[1]; ov.z = ow[2]; ov.w = ow[3];
                *(GAS v4u*)((GAS bf16*)wsb + (O_MX + (T0 + 16 * w + 4 * k + er) * 1024u + h * 128 + ec)) = ov; }
        }
#pragma unroll
        for (int dt = 0; dt < 4; ++dt) R[dt] = R[dt] * dec128;
#pragma unroll
        for (int a = 0; a < 4; ++a) { const LAS char* vp = lds + RT_V + w * 4096 + (32 * a + 4 * fq + tq) * 32 + tp * 8;
            const s16x4 vlo = trrd(vp), vhi = trrd(vp + 16 * 32); const bf16x8 vf = MK8(vlo, vhi);
#pragma unroll
            for (int dt = 0; dt < 4; ++dt) { const LAS char* kp = lds + RT_KZ + (32 * a + 4 * fq + tq) * RT_KZS + (16 * dt + 4 * tp) * 2;
                const s16x4 klo = trrd(kp), khi = trrd(kp + 16 * RT_KZS);
                R[dt] = __builtin_amdgcn_mfma_f32_16x16x32_bf16(vf, MK8(klo, khi), R[dt], 0, 0, 0); } }
        RT_BAR();
        if (ch + 1 >= c_first && ch + 1 < n_total) {
#pragma unroll
            for (int dt = 0; dt < 4; ++dt)
#pragma unroll
                for (int r = 0; r < 4; ++r) *(LAS bf16*)(lds + RT_R + (16 * w + 4 * fq + r) * RT_KZS + (16 * dt + i_in) * 2) = (bf16)(pk2(R[dt][r], 0.f) & 0xffffu);
        }
    }
    __syncthreads();
#undef RT_LOADKV
#undef RT_OPAQUE
#undef RT_LOADQ
}
__device__ __forceinline__ void p4_retention(const Ctx& C, const Args& A) {
    for (int u = C.vcu; u < 256; u += C.G) ret_unit(C, A, u >> 4, (u >> 1) & 7, u & 1);
}


template <bool XF32>
__device__ __forceinline__ void thin_phase(const Ctx& C, const void* xi, const bf16* add, const float* ssp, const float* g_post, bf16* xo, float* rso) {
    const int gw = C.vcu * NWAVES + C.wave, NGW = C.G * NWAVES, lane = C.lane;
    for (int m = gw; m < M_TOK; m += NGW) {
        const float sp = lane < 16 ? ssp[(size_t)m * 16 + lane] : 0.f;
        const float rs = __builtin_amdgcn_rsqf(wave_sum(sp) * (1.f / DM) + RMS_EPS);
        const GAS v2u* ar = (const GAS v2u*)(add + (size_t)m * DM) + lane; const GAS f32x4* gp = (const GAS f32x4*)g_post + lane;
        f32x4 v[4]; float s = 0.f;
#pragma unroll
        for (int j = 0; j < 4; ++j) { f32x4 x;
            if (XF32) x = ((const GAS f32x4*)((const float*)xi + (size_t)m * DM) + lane)[64 * j];
            else { const v2u xb = ((const GAS v2u*)((const bf16*)xi + (size_t)m * DM) + lane)[64 * j]; x = f32x4{bflo(xb.x), bfhi(xb.x), bflo(xb.y), bfhi(xb.y)}; }
            const f32x4 g = gp[64 * j]; const v2u a = ar[64 * j];
            v[j].x = x.x + bflo(a.x) * rs * g.x; v[j].y = x.y + bfhi(a.x) * rs * g.y; v[j].z = x.z + bflo(a.y) * rs * g.z; v[j].w = x.w + bfhi(a.y) * rs * g.w;
            s += (v[j].x * v[j].x + v[j].y * v[j].y) + (v[j].z * v[j].z + v[j].w * v[j].w); }
        GAS v2u* hw = (GAS v2u*)(xo + (size_t)m * DM) + lane;
#pragma unroll
        for (int j = 0; j < 4; ++j) { v2u w; w.x = pk2(v[j].x, v[j].y); w.y = pk2(v[j].z, v[j].w); hw[64 * j] = w; }
        const float r2 = __builtin_amdgcn_rsqf(wave_sum(s) * (1.f / DM) + RMS_EPS);
        if (lane == 0) rso[m] = r2;
    }
}

#define CAS __attribute__((address_space(4)))
__device__ __forceinline__ Args load_args() {
    Args a{};
#if defined(__HIP_DEVICE_COMPILE__)
    const CAS Args* p_ = (const CAS Args*)__builtin_amdgcn_kernarg_segment_ptr(); asm volatile("" : "+s"(p_));
#pragma unroll
    for (int i = 0; i < 19; ++i) a.in[i] = p_->in[i];
    a.out = p_->out; a.ws = p_->ws; a.ph_lo = p_->ph_lo; a.ph_hi = p_->ph_hi; a.li = p_->li; a.pad = 0;
#endif
    return a;
}
__global__ void __launch_bounds__(NWAVES * 64, 2) hyb_fwd(Args args) {
    extern __shared__ __attribute__((aligned(16))) unsigned char lds[];
#define MKCTX() Ctx C; C.lds = (LAS unsigned char*)lds; C.tid = threadIdx.x; C.lane = C.tid & 63; C.wave = __builtin_amdgcn_readfirstlane(C.tid >> 6); \
    C.G = gridDim.x; { const int bx_ = blockIdx.x; C.vcu = (C.G % 8 == 0) ? (bx_ % 8) * (C.G / 8) + bx_ / 8 : bx_; }
    volatile LAS unsigned* MISC = (volatile LAS unsigned*)((LAS unsigned char*)lds + MISC_OFF);
    gu32* ctl = (gu32*)(args.ws + WS_CTL);
    for (int u = threadIdx.x; u < (LDS_BYTES - LDSCTL_OFF) / 4; u += NWAVES * 64) ((LAS unsigned*)((LAS unsigned char*)lds + LDSCTL_OFF))[u] = 0u;
    __syncthreads();
    XcdBarrier bar; bar.bar = (unsigned*)(ctl + CW_BAR); bar.x = 0; bar.st = nullptr;
    if (N_LAUNCHES == 1) bar = xcd_barrier_post((unsigned*)(ctl + CW_BAR), MISC + 8);
    const int lo = args.ph_lo, hi = args.ph_hi;
#ifndef PH_REP
#define PH_REP 0
#endif
#ifndef PH_MASK
#define PH_MASK 0x7ff
#endif
#define IN(k) (((PH_MASK >> (k)) & 1) && lo <= (k) && (k) < hi)
#define SEAM(k) do { if (IN(k) && IN((k) + 1)) xcd_barrier(bar); } while (0)
#define LOAD_ARGS(Av) const Args Av = load_args(); unsigned char* ws = Av.ws; (void)ws

    if (IN(0)) { LOAD_ARGS(a); MKCTX(); LAS unsigned char* ring = C.lds; const int bx = (int)blockIdx.x; (void)ring; (void)bx; p0_prologue(C, a); if ((PH_REP >> 0) & 1) { __syncthreads(); p0_prologue(C, a); } }
    SEAM(0);
    if (IN(1)) { LOAD_ARGS(a); MKCTX(); LAS unsigned char* ring = C.lds; const int bx = (int)blockIdx.x; (void)ring; (void)bx;
        pg8::Gemm g{(const bf16*)((const unsigned char*)a.out + OUT_H), (const bf16*)(ws + WS_WIN), M_TOK, IN_VIRT, DM}; pg8::StaticOrder S; S.init(M_TOK, IN_VIRT, C.G, bx);
        pg8::EpiProj E{(bf16*)ws, ring, (unsigned char*)a.out + 160 * MiB};
#if defined(P1_STAGGER)
        for (int i = 0; i < ((bx >> 3) & 3) * P1_STAGGER; ++i) __builtin_amdgcn_s_sleep(127);
#endif
        pg8::gemm_phase<pg8::EpiProj, pg8::StaticOrder, true, true>(ring, g, S, E);
#if defined(GEMM_PROBE)
        { __syncthreads(); asm volatile("" ::: "memory"); __builtin_amdgcn_sched_barrier(0); pg8::EpiNone EN{ring}; pg8::gemm_phase<pg8::EpiNone, pg8::StaticOrder, true, true>(ring, g, S, EN); }
#else
        if ((PH_REP >> 1) & 1) { __syncthreads(); asm volatile("" ::: "memory"); __builtin_amdgcn_sched_barrier(0); pg8::gemm_phase<pg8::EpiProj, pg8::StaticOrder, true, true>(ring, g, S, E); }
#endif
    }
    SEAM(1);
    if (IN(2)) { LOAD_ARGS(a); MKCTX(); LAS unsigned char* ring = C.lds; const int bx = (int)blockIdx.x; (void)ring; (void)bx; p2_compress(C, a); if ((PH_REP >> 2) & 1) { __syncthreads(); p2_compress(C, a); } }
    SEAM(2);
    if (IN(3)) { LOAD_ARGS(a); MKCTX(); LAS unsigned char* ring = C.lds; const int bx = (int)blockIdx.x; (void)ring; (void)bx; p3_nsa(C, a); if ((PH_REP >> 3) & 1) { __syncthreads(); p3_nsa(C, a); } }
    SEAM(3);
    if (IN(4)) { LOAD_ARGS(a); MKCTX(); LAS unsigned char* ring = C.lds; const int bx = (int)blockIdx.x; (void)ring; (void)bx; p4_retention(C, a); if ((PH_REP >> 4) & 1) { __syncthreads(); p4_retention(C, a); } }
    SEAM(4);
    if (IN(5)) { LOAD_ARGS(a); MKCTX(); LAS unsigned char* ring = C.lds; const int bx = (int)blockIdx.x; (void)ring; (void)bx;
        { pg8::Gemm g{(const bf16*)(ws + WS_MIXIN), (const bf16*)(ws + WS_WOUT), M_TOK, DM, DM}; pg8::StaticOrder S; S.init(M_TOK, DM, C.G, bx);
          pg8::EpiSumsq E{(bf16*)(ws + WS_MIX), (float*)(ws + WS_SSP), ring};
          pg8::gemm_phase<pg8::EpiSumsq, pg8::StaticOrder, true, true>(ring, g, S, E); }
        __syncthreads(); asm volatile("" ::: "memory"); __builtin_amdgcn_sched_barrier(0);
        { pg8::Gemm g{(const bf16*)((const unsigned char*)a.out + OUT_PBF), (const bf16*)(ws + WS_WPLE), M_TOK, DM, PLE_D}; pg8::StaticOrder S; S.init(M_TOK, DM, C.G, bx);
          pg8::EpiPlain E{(bf16*)(ws + WS_PLEO), DM, ring};
          pg8::gemm_phase<pg8::EpiPlain, pg8::StaticOrder, true, true>(ring, g, S, E); }
    }
    SEAM(5);
    if (IN(6)) { LOAD_ARGS(a); MKCTX(); LAS unsigned char* ring = C.lds; const int bx = (int)blockIdx.x; (void)ring; (void)bx; thin_phase<true>(C, a.in[I_X], (const bf16*)(ws + WS_MIX), (const float*)(ws + WS_SSP), a.in[I_NMPOST], (bf16*)(ws + WS_H2), (float*)(ws + WS_RS2));
        if ((PH_REP >> 6) & 1) { __syncthreads(); thin_phase<true>(C, a.in[I_X], (const bf16*)(ws + WS_MIX), (const float*)(ws + WS_SSP), a.in[I_NMPOST], (bf16*)(ws + WS_H2), (float*)(ws + WS_RS2)); } }
    SEAM(6);
    if (IN(7)) { LOAD_ARGS(a); MKCTX(); LAS unsigned char* ring = C.lds; const int bx = (int)blockIdx.x; (void)ring; (void)bx;
        pg8::Gemm g{(const bf16*)(ws + WS_H2), (const bf16*)(ws + WS_WFI), M_TOK, 2 * DFF, DM}; pg8::StaticOrder S; S.init(M_TOK, 2 * DFF, C.G, bx);
        pg8::EpiSwiglu E{(bf16*)(ws + WS_ACT), (const float*)(ws + WS_RS2)};
        pg8::gemm_phase<pg8::EpiSwiglu, pg8::StaticOrder, true, true>(ring, g, S, E);
        if ((PH_REP >> 7) & 1) { __syncthreads(); asm volatile("" ::: "memory"); __builtin_amdgcn_sched_barrier(0); pg8::gemm_phase<pg8::EpiSwiglu, pg8::StaticOrder, true, true>(ring, g, S, E); }
    }
    SEAM(7);
    if (IN(8)) { LOAD_ARGS(a); MKCTX(); LAS unsigned char* ring = C.lds; const int bx = (int)blockIdx.x; (void)ring; (void)bx;
        pg8::Gemm g{(const bf16*)(ws + WS_ACT), (const bf16*)(ws + WS_WFO), M_TOK, DM, DFF}; pg8::StaticOrder S; S.init(M_TOK, DM, C.G, bx);
        pg8::EpiNormRes E{(bf16*)(ws + WS_H2), a.in[I_NFPOST], (float*)(ws + WS_SSP2), (unsigned*)(ws + WS_XBUF), (unsigned*)(ws + WS_CTL + CW_XCNT), ring};
        pg8::gemm_phase<pg8::EpiNormRes, pg8::StaticOrder, true, true>(ring, g, S, E);
    }
    SEAM(8);
    if (IN(10)) { LOAD_ARGS(a); MKCTX(); LAS unsigned char* ring = C.lds; const int bx = (int)blockIdx.x; (void)ring; (void)bx;
        pg8::Gemm g{(const bf16*)(ws + WS_H2), (const bf16*)(ws + WS_WG), M_TOK, DM, DM}; pg8::StaticOrder S; S.init(M_TOK, DM, C.G, bx);
        pg8::EpiFinal E{(const bf16*)(ws + WS_H2), (const bf16*)(ws + WS_PLEO), (const float*)(ws + WS_SSP2), a.out, ring};
#if defined(P10_STAGGER)
        for (int i = 0; i < (bx & (P10_GROUPS - 1)) * P10_STAGGER; ++i) __builtin_amdgcn_s_sleep(127);
#endif
        pg8::gemm_phase<pg8::EpiFinal, pg8::StaticOrder, true, true>(ring, g, S, E);
        if ((PH_REP >> 10) & 1) { __syncthreads(); asm volatile("" ::: "memory"); __builtin_amdgcn_sched_barrier(0); pg8::gemm_phase<pg8::EpiFinal, pg8::StaticOrder, true, true>(ring, g, S, E); }
    }
#undef IN
#undef SEAM
}

static_assert(pg8::EPI_X_END <= LDSCTL_OFF, "fused-epilogue LDS tables fit below the control words");
extern "C" void kernel_launch(void* const* d_in, const int* in_sizes, int n_in, void* d_out, int out_size, void* d_ws, size_t ws_size, hipStream_t stream) {
    static int grid = 0;
    if (grid == 0) {
        if (n_in != 19 || in_sizes[0] != M_TOK * DM || out_size != M_TOK * DM || ws_size < WS_END) {
            fprintf(stderr, "kernel_launch: built for 19 inputs, x/out of %d floats, >= %zu bytes of workspace; got n_in %d, in0 %d, out %d, ws %zu; nothing launched\n", M_TOK * DM, (size_t)WS_END, n_in, n_in > 0 ? in_sizes[0] : -1, out_size, ws_size);
            grid = -1; return; }
        int dev = 0, cus = 0, per_cu = 0;
        if (hipGetDevice(&dev) != hipSuccess || hipDeviceGetAttribute(&cus, hipDeviceAttributeMultiprocessorCount, dev) != hipSuccess) { fprintf(stderr, "kernel_launch: device query failed\n"); grid = -1; return; }
        if (hipFuncSetAttribute((const void*)hyb_fwd, hipFuncAttributeMaxDynamicSharedMemorySize, LDS_BYTES) != hipSuccess) { fprintf(stderr, "kernel_launch: hipFuncSetAttribute failed\n"); grid = -1; return; }
        if (hipOccupancyMaxActiveBlocksPerMultiprocessor(&per_cu, (const void*)hyb_fwd, NWAVES * 64, LDS_BYTES) != hipSuccess || per_cu < 1)
            fprintf(stderr, "kernel_launch: note: occupancy query reports %d workgroups per CU\n", per_cu);
        (void)hipGetLastError();
        grid = cus;
    }
    if (grid < 0) return;
    if (N_LAUNCHES == 1) { if (hipMemsetAsync((char*)d_ws + WS_CTL, 0, CTL_ZERO_BYTES, stream) != hipSuccess) { fprintf(stderr, "kernel_launch: hipMemsetAsync failed\n"); return; } }
    Args a{};
    for (int i = 0; i < 19; ++i) a.in[i] = (const float*)d_in[i];
    a.out = (float*)d_out; a.ws = (unsigned char*)d_ws;
    for (int li = 0; li < N_LAUNCHES; ++li) {
        a.ph_lo = (N_LAUNCHES == 1) ? 0 : li; a.ph_hi = (N_LAUNCHES == 1) ? N_PHASES : li + 1; a.li = li; a.pad = 0;
        hipLaunchKernelGGL(hyb_fwd, dim3(grid), dim3(NWAVES * 64), LDS_BYTES, stream, a);
        const hipError_t le = hipPeekAtLastError();
        if (le != hipSuccess) { fprintf(stderr, "kernel_launch: launch %d failed: %s\n", li, hipGetErrorName(le)); break; }
    }
}
```

```cpp
#include <hip/hip_runtime.h>
#include <cstdio>
#include <cstdint>

#ifndef MK_N_LAUNCHES
#define MK_N_LAUNCHES 1
#endif

constexpr int NB = 16, SEQ = 4096, DM = 1024, M_TOK = NB * SEQ, DFF = 2816, PLE_D = 256;
constexpr int IN_TOTAL = 7664, IN_VIRT = 7680;
constexpr float RMS_EPS = 1e-6f, GN_EPS = 1e-5f, LOG2E = 1.4426950408889634f;
constexpr float QSCALE = 0.10206207261596575f * 1.4426950408889634f;
constexpr size_t MiB = 1u << 20;
constexpr size_t WS_CTL = 0, CTL_ZERO_BYTES = 1 * MiB;
constexpr size_t WS_WIN = 1 * MiB;
constexpr size_t WS_WOUT = 16 * MiB;
constexpr size_t WS_WFI = 18 * MiB;
constexpr size_t WS_WFO = 29 * MiB;
constexpr size_t WS_WPLE = 34 * MiB + 512 * 1024;
constexpr size_t WS_WG = 35 * MiB;
constexpr size_t WS_W1K = 37 * MiB;
constexpr size_t WS_W1V = 37 * MiB + 589824;
constexpr size_t WS_W2K = 38 * MiB, WS_W2V = 38 * MiB + 32768;
constexpr size_t WS_C1K = 38 * MiB + 65536, WS_C1V = 38 * MiB + 65536 + 2048;
constexpr size_t WS_KCMP = 39 * MiB;
constexpr size_t WS_VCMP = 40 * MiB + 512 * 1024;
constexpr size_t WS_SSP = 42 * MiB;
constexpr size_t WS_RS2 = 46 * MiB, WS_RS3 = 46 * MiB + 512 * 1024;
constexpr size_t WS_XBUF = 47 * MiB;
constexpr size_t WS_SSP2 = 420 * MiB;
constexpr size_t CW_XCNT = 65536;
constexpr size_t WS_NQ = 48 * MiB, WS_KC = 240 * MiB, WS_VC = 264 * MiB, WS_KS = 280 * MiB, WS_VS = 304 * MiB, WS_KW = 320 * MiB, WS_VW = 344 * MiB, WS_NG = 360 * MiB;
constexpr size_t WS_RQ = 366 * MiB, WS_RK = 430 * MiB, WS_RV = 494 * MiB, WS_RG = 622 * MiB, WS_MG = 750 * MiB, WS_END = 1006 * MiB;
constexpr size_t WS_MIXIN = WS_NQ;
constexpr size_t WS_MIX = WS_RQ;
constexpr size_t WS_PLEO = WS_RV;
constexpr size_t WS_H2 = WS_RG;
constexpr size_t WS_ACT = WS_NQ;
constexpr size_t OUT_H = 0;
constexpr size_t OUT_PBF = 128 * MiB;
constexpr size_t OUT_NSA = 0;
constexpr size_t OUT_F = 0;

namespace pg8 {
#define PG8_LAS __attribute__((address_space(3)))
typedef unsigned short bf16_t;
typedef short bf16x8 __attribute__((ext_vector_type(8)));
typedef float f32x4 __attribute__((ext_vector_type(4)));
typedef unsigned u32x4 __attribute__((ext_vector_type(4)));
constexpr int BM = 256, BK = 64, HALF = 128, HTB = HALF * BK * 2  , STAGE_BYTES = 8 * HTB, NXCD = 8, WGM = 4;

__host__ __device__ __forceinline__ int lds_byte(int r, int c) { const int st = (r >> 4) * 2 + (c >> 5), rr = r & 15, cc = c & 31, ob = rr * 64 + cc * 2; return st * 1024 + (ob ^ (((ob >> 9) & 1) << 5)); }
__host__ __device__ __forceinline__ void stage_rc(int b, int& R, int& C) { const int st = b / 1024, sb = b % 1024, swz = sb ^ (((sb >> 9) & 1) << 5); R = (st >> 1) * 16 + swz / 64; C = (st & 1) * 32 + (swz % 64) / 2; }
__host__ __device__ __forceinline__ int perm32(int rho) { const int n = rho >> 4, i = rho & 15; return 8 * (i >> 2) + 4 * n + (i & 3); }

struct Unit { int pm, pn; };
struct Gemm { const bf16_t* A; const bf16_t* Bt; int M, N, K; };

struct StaticOrder {
    int nM, nN, nwg, G, c;
    __host__ __device__ void init(int M, int N, int G_, int c_) { nM = M / BM; nN = N / BM; nwg = nM * nN; G = G_; c = c_; }
    __host__ __device__ bool next(int i, Unit& u) const {
        const long L = (long)i * G + c; if (L >= nwg) return false;
        int wgid = (int)L; { const int q = nwg / NXCD, r = nwg % NXCD, xcd = wgid % NXCD, off = wgid / NXCD; wgid = (xcd < r ? xcd * (q + 1) : r * (q + 1) + (xcd - r) * q) + off; }
        const int nig = WGM * nN, gid = wgid / nig, fm = gid * WGM, gsz = (nM - fm) < WGM ? (nM - fm) : WGM;
        u.pm = fm + ((wgid % nig) % gsz); u.pn = (wgid % nig) / gsz; return true;
    }
    __device__ __forceinline__ void a_ready(const Unit&) const {}
    __device__ __forceinline__ void done(const Unit&) const {}
};

struct PanelOrder {
    int nN, pm;
    __device__ __forceinline__ void init(int N, int pm_) { int n_ = N / BM; asm volatile("" : "+s"(n_)); nN = n_; pm = pm_; }
    __device__ __forceinline__ bool next(int i, Unit& u) const { if (i >= nN) return false; u.pm = pm; u.pn = i; return true; }
    __device__ __forceinline__ void a_ready(const Unit&) const {}
    __device__ __forceinline__ void done(const Unit&) const {}
};

typedef float f32x2_t __attribute__((ext_vector_type(2))); typedef __bf16 bf16x2_t __attribute__((ext_vector_type(2)));
__device__ __forceinline__ unsigned cvt_pk_bf16(float lo, float hi) { f32x2_t v = {lo, hi}; bf16x2_t b = __builtin_convertvector(v, bf16x2_t); return __builtin_bit_cast(unsigned, b); }
__device__ __forceinline__ float bf_lo(unsigned w) { return __uint_as_float(w << 16); }
__device__ __forceinline__ float bf_hi(unsigned w) { return __uint_as_float(w & 0xffff0000u); }
__device__ __forceinline__ float fast_sigmoid(float x) { return __builtin_amdgcn_rcpf(1.f + __builtin_amdgcn_exp2f(-x * ::LOG2E)); }

constexpr int EPI_STG_OFF = 131072, EPI_STG_ROW = 144, EPI_STG_WAVE = 16 * EPI_STG_ROW;
__device__ __forceinline__ void stage_store_rows(PG8_LAS unsigned char* stg, int fr, int fq, const u32x4& w0, const u32x4& w1, unsigned char* gblock, size_t pitch, int nchunk) {
    *(PG8_LAS u32x4*)(stg + fr * EPI_STG_ROW + fq * 16) = w0; *(PG8_LAS u32x4*)(stg + fr * EPI_STG_ROW + 64 + fq * 16) = w1;
    const int ln = fq * 16 + fr, r = ln >> 3, c = ln & 7;
#pragma unroll
    for (int h = 0; h < 2; ++h) { const u32x4 v = *(const PG8_LAS u32x4*)(stg + (8 * h + r) * EPI_STG_ROW + c * 16);
        if (c < nchunk) *(u32x4*)(gblock + (size_t)(8 * h + r) * pitch + c * 16) = v; }
}
__device__ __forceinline__ u32x4 pack8(const f32x4& v0, const f32x4& v1) { u32x4 w; w.x = cvt_pk_bf16(v0[0], v0[1]); w.y = cvt_pk_bf16(v0[2], v0[3]); w.z = cvt_pk_bf16(v1[0], v1[1]); w.w = cvt_pk_bf16(v1[2], v1[3]); return w; }

struct EpiProj {
    static constexpr bool PERM = true, AFTER_DRAIN = false;
    bf16_t* ws; PG8_LAS unsigned char* lds; unsigned char* scr;
    __device__ __forceinline__ static void route(int v, size_t& off, int& ld, float& sc, int& nch) {
        sc = 1.f; nch = 8;
        if (v < 512)       { off = ::WS_RQ / 2 + v;            ld = 512; }
        else if (v < 1024) { off = ::WS_RK / 2 + (v - 512);    ld = 512; }
        else if (v < 2048) { off = ::WS_RV / 2 + (v - 1024);   ld = 1024; }
        else if (v < 3072) { off = ::WS_RG / 2 + (v - 2048);   ld = 1024; }
        else if (v < 4608) { off = ::WS_NQ / 2 + (v - 3072);   ld = 1536; sc = ::QSCALE; }
        else if (v < 6656) { off = ::WS_MG / 2 + (v - 4608);   ld = 2048; sc = ::LOG2E; }
        else { const int w = v - 6656;
            if (w < 192)       { off = ::WS_KC / 2 + w;          ld = 192; }
            else if (w < 320)  { off = ::WS_VC / 2 + (w - 192);  ld = 128; }
            else if (w < 512)  { off = ::WS_KS / 2 + (w - 320);  ld = 192; }
            else if (w < 640)  { off = ::WS_VS / 2 + (w - 512);  ld = 128; }
            else if (w < 832)  { off = ::WS_KW / 2 + (w - 640);  ld = 192; }
            else if (w < 960)  { off = ::WS_VW / 2 + (w - 832);  ld = 128; }
            else               { off = ::WS_NG / 2 + (w - 960);  ld = 48; nch = 6; } }
    }
    __device__ __forceinline__ void operator()(const f32x4 (&acc)[2][2][4][2], const Unit& u, int wr, int wc, int fr_in, int fq_in) const {
        int fr = fr_in, fq = fq_in; asm volatile("" : "+v"(fr), "+v"(fq));
        size_t off; int ld, nch; float sc;
        route(u.pn * BM + wc * 64, off, ld, sc, nch);
        PG8_LAS unsigned char* stg = lds + EPI_STG_OFF + (wr * 4 + wc) * EPI_STG_WAVE;
        const int rowb = u.pm * BM + wr * 64;
#pragma unroll
        for (int ai = 0; ai < 2; ++ai)
#pragma unroll
            for (int m = 0; m < 4; ++m) { const size_t row = (size_t)(rowb + ai * HALF + m * 16);
                stage_store_rows(stg, fr, fq, pack8(acc[ai][0][m][0] * sc, acc[ai][0][m][1] * sc), pack8(acc[ai][1][m][0] * sc, acc[ai][1][m][1] * sc), (unsigned char*)(ws + off + row * ld), (size_t)ld * 2, nch);
#if defined(EPI_PROBE) && (EPI_PROBE == 4 || EPI_PROBE == 5)
                { const u32x4 wz = pack8(acc[ai][0][m][0], acc[ai][0][m][1]); const int ln = fq * 16 + fr, k2_ = (ai * 4 + m) * 2;
                  unsigned char* sb = scr + (size_t)blockIdx.x * 131072 + (size_t)(wr * 4 + wc) * 16384;
                  if (EPI_PROBE == 4) { *(volatile __attribute__((address_space(1))) u32x4*)(sb + (size_t)k2_ * 1024 + ln * 16) = wz; *(volatile __attribute__((address_space(1))) u32x4*)(sb + (size_t)(k2_ + 1) * 1024 + ln * 16) = wz; }
                  else { *(volatile __attribute__((address_space(1))) u32x4*)(scr + (size_t)blockIdx.x * 131072 + (size_t)(k2_ * 8 + (ln >> 3)) * 1024 + (wr * 4 + wc) * 128 + (ln & 7) * 16) = wz;
                         *(volatile __attribute__((address_space(1))) u32x4*)(scr + (size_t)blockIdx.x * 131072 + (size_t)((k2_ + 1) * 8 + (ln >> 3)) * 1024 + (wr * 4 + wc) * 128 + (ln & 7) * 16) = wz; } }
#endif
                }
    }
};

#if defined(GEMM_PROBE)
struct EpiNone {
    static constexpr bool PERM = true, AFTER_DRAIN = false;
    PG8_LAS unsigned char* lds;
    __device__ __forceinline__ void operator()(const f32x4 (&acc)[2][2][4][2], const Unit& u, int wr, int wc, int fr_in, int fq_in) const {
#pragma unroll
        for (int ai = 0; ai < 2; ++ai)
#pragma unroll
            for (int bj = 0; bj < 2; ++bj)
#pragma unroll
                for (int m = 0; m < 4; ++m)
#pragma unroll
                    for (int n = 0; n < 2; ++n) asm volatile("" :: "v"(acc[ai][bj][m][n]));
    }
};
#endif

struct EpiPlain {
    static constexpr bool PERM = true, AFTER_DRAIN = false;
    bf16_t* O; int ldc; PG8_LAS unsigned char* lds;
    __device__ __forceinline__ void operator()(const f32x4 (&acc)[2][2][4][2], const Unit& u, int wr, int wc, int fr_in, int fq_in) const {
        int fr = fr_in, fq = fq_in; asm volatile("" : "+v"(fr), "+v"(fq));
        PG8_LAS unsigned char* stg = lds + EPI_STG_OFF + (wr * 4 + wc) * EPI_STG_WAVE;
        const int rowb = u.pm * BM + wr * 64, colb = u.pn * BM + wc * 64;
#pragma unroll
        for (int ai = 0; ai < 2; ++ai)
#pragma unroll
            for (int m = 0; m < 4; ++m) { const size_t row = (size_t)(rowb + ai * HALF + m * 16);
                stage_store_rows(stg, fr, fq, pack8(acc[ai][0][m][0], acc[ai][0][m][1]), pack8(acc[ai][1][m][0], acc[ai][1][m][1]), (unsigned char*)(O + row * ldc + colb), (size_t)ldc * 2, 8); }
    }
};

struct EpiSumsq {
    static constexpr bool PERM = true, AFTER_DRAIN = false;
    bf16_t* O; float* ssp; PG8_LAS unsigned char* lds;
    __device__ __forceinline__ void operator()(const f32x4 (&acc)[2][2][4][2], const Unit& u, int wr, int wc, int fr_in, int fq_in) const {
        int fr = fr_in, fq = fq_in; asm volatile("" : "+v"(fr), "+v"(fq));
        PG8_LAS unsigned char* stg = lds + EPI_STG_OFF + (wr * 4 + wc) * EPI_STG_WAVE;
        const int rowb = u.pm * BM + wr * 64, colb = u.pn * BM + wc * 64;
#pragma unroll
        for (int ai = 0; ai < 2; ++ai)
#pragma unroll
            for (int m = 0; m < 4; ++m) { const int row = rowb + ai * HALF + m * 16; float s = 0.f;
#pragma unroll
                for (int bj = 0; bj < 2; ++bj) { const f32x4 v0 = acc[ai][bj][m][0], v1 = acc[ai][bj][m][1];
                    s += (v0[0] * v0[0] + v0[1] * v0[1]) + (v0[2] * v0[2] + v0[3] * v0[3]); s += (v1[0] * v1[0] + v1[1] * v1[1]) + (v1[2] * v1[2] + v1[3] * v1[3]); }
                stage_store_rows(stg, fr, fq, pack8(acc[ai][0][m][0], acc[ai][0][m][1]), pack8(acc[ai][1][m][0], acc[ai][1][m][1]), (unsigned char*)(O + (size_t)row * 1024 + colb), 2048, 8);
                s += __shfl_xor(s, 16); s += __shfl_xor(s, 32);
                if (fq == 0) ssp[(size_t)(row + fr) * 16 + u.pn * 4 + wc] = s; }
    }
};

constexpr int EPI_P_OFF = EPI_STG_OFF + 8 * EPI_STG_WAVE, EPI_S_OFF = EPI_P_OFF + 4096, EPI_X_END = EPI_S_OFF + 1024;
struct EpiNormRes {
    static constexpr bool PERM = true, AFTER_DRAIN = false;
    bf16_t* X; const float* gpost; float* ssp2; unsigned* xbuf; unsigned* cnt; PG8_LAS unsigned char* lds;
    __device__ __forceinline__ void operator()(const f32x4 (&acc)[2][2][4][2], const Unit& u, int wr, int wc, int fr_in, int fq_in) const {
        int fr = fr_in, fq = fq_in; asm volatile("" : "+v"(fr), "+v"(fq));
        const int tid = threadIdx.x, wid = __builtin_amdgcn_readfirstlane(tid >> 6), lane = tid & 63;
        PG8_LAS float* P = (PG8_LAS float*)(lds + EPI_P_OFF); PG8_LAS float* S = (PG8_LAS float*)(lds + EPI_S_OFF);
        PG8_LAS unsigned char* stg = lds + EPI_STG_OFF + (wr * 4 + wc) * EPI_STG_WAVE;
        const int rowb = u.pm * BM + wr * 64, colb = u.pn * BM + wc * 64;
        constexpr int NPRE = 6;
        u32x4 pre[NPRE][2];
#pragma unroll
        for (int q = 0; q < NPRE; ++q) { const size_t idx = (size_t)(rowb + (q >> 2) * HALF + (q & 3) * 16 + fr) * 1024 + colb + 8 * fq; pre[q][0] = *(const u32x4*)(X + idx); pre[q][1] = *(const u32x4*)(X + idx + 32); }
#pragma unroll
        for (int ai = 0; ai < 2; ++ai)
#pragma unroll
            for (int m = 0; m < 4; ++m) { float s = 0.f;
#pragma unroll
                for (int bj = 0; bj < 2; ++bj) { const f32x4 v0 = acc[ai][bj][m][0], v1 = acc[ai][bj][m][1];
                    s += (v0[0] * v0[0] + v0[1] * v0[1]) + (v0[2] * v0[2] + v0[3] * v0[3]); s += (v1[0] * v1[0] + v1[1] * v1[1]) + (v1[2] * v1[2] + v1[3] * v1[3]); }
                s += __shfl_xor(s, 16); s += __shfl_xor(s, 32);
                if (fq == 0) P[(ai * HALF + wr * 64 + m * 16 + fr) * 4 + wc] = s; }
        asm volatile("s_waitcnt lgkmcnt(0)" ::: "memory"); __builtin_amdgcn_s_barrier(); asm volatile("" ::: "memory");
        if (tid < 256) { const f32x4 p4 = *(const PG8_LAS f32x4*)(P + tid * 4);
            __hip_atomic_store(xbuf + (size_t)(u.pm * BM + tid) * 4 + u.pn, __float_as_uint((p4[0] + p4[1]) + (p4[2] + p4[3])), __ATOMIC_RELAXED, __HIP_MEMORY_SCOPE_AGENT); }
        asm volatile("s_waitcnt vmcnt(0)" ::: "memory");
        if (tid < 256 && lane == 0) __hip_atomic_fetch_add(cnt + 64 * u.pm, 1u, __ATOMIC_RELAXED, __HIP_MEMORY_SCOPE_AGENT);
        if (wid == 0) { unsigned sp = 0u;
            while ((unsigned)__builtin_amdgcn_readfirstlane(__hip_atomic_load(cnt + 64 * u.pm, __ATOMIC_RELAXED, __HIP_MEMORY_SCOPE_AGENT)) < 16u) { __builtin_amdgcn_s_sleep(2); if (++sp > (1u << 21)) break; } }
        asm volatile("s_waitcnt vmcnt(0) lgkmcnt(0)" ::: "memory"); __builtin_amdgcn_s_barrier(); asm volatile("" ::: "memory");
        if (tid < 256) { const unsigned long long* sl = (const unsigned long long*)(xbuf + (size_t)(u.pm * BM + tid) * 4);
            const unsigned long long a = __hip_atomic_load(sl, __ATOMIC_RELAXED, __HIP_MEMORY_SCOPE_AGENT), b = __hip_atomic_load(sl + 1, __ATOMIC_RELAXED, __HIP_MEMORY_SCOPE_AGENT);
            const float t = (__uint_as_float((unsigned)a) + __uint_as_float((unsigned)(a >> 32))) + (__uint_as_float((unsigned)b) + __uint_as_float((unsigned)(b >> 32)));
            S[tid] = __builtin_amdgcn_rsqf(t * (1.f / 1024.f) + ::RMS_EPS); }
        asm volatile("s_waitcnt lgkmcnt(0)" ::: "memory"); __builtin_amdgcn_s_barrier(); asm volatile("" ::: "memory");
        f32x4 gp[2][2];
#pragma unroll
        for (int bj = 0; bj < 2; ++bj)
#pragma unroll
            for (int n = 0; n < 2; ++n) gp[bj][n] = *(const f32x4*)(gpost + colb + 32 * bj + 8 * fq + 4 * n);
#pragma unroll
        for (int ai = 0; ai < 2; ++ai)
#pragma unroll
            for (int m = 0; m < 4; ++m) { const int rl = ai * HALF + wr * 64 + m * 16 + fr, row = u.pm * BM + rl; const float rs = S[rl];
                const size_t idx = (size_t)row * 1024 + colb + 8 * fq;
                const u32x4 xw0 = (ai * 4 + m) < NPRE ? pre[(ai * 4 + m) < NPRE ? ai * 4 + m : 0][0] : *(const u32x4*)(X + idx), xw1 = (ai * 4 + m) < NPRE ? pre[(ai * 4 + m) < NPRE ? ai * 4 + m : 0][1] : *(const u32x4*)(X + idx + 32);
                f32x4 o[2][2]; float s2 = 0.f;
#pragma unroll
                for (int bj = 0; bj < 2; ++bj) { const u32x4 xw = bj ? xw1 : xw0;
                    const f32x4 x0 = {bf_lo(xw.x), bf_hi(xw.x), bf_lo(xw.y), bf_hi(xw.y)}, x1v = {bf_lo(xw.z), bf_hi(xw.z), bf_lo(xw.w), bf_hi(xw.w)};
                    o[bj][0] = x0 + acc[ai][bj][m][0] * rs * gp[bj][0]; o[bj][1] = x1v + acc[ai][bj][m][1] * rs * gp[bj][1];
                    s2 += (o[bj][0][0] * o[bj][0][0] + o[bj][0][1] * o[bj][0][1]) + (o[bj][0][2] * o[bj][0][2] + o[bj][0][3] * o[bj][0][3]);
                    s2 += (o[bj][1][0] * o[bj][1][0] + o[bj][1][1] * o[bj][1][1]) + (o[bj][1][2] * o[bj][1][2] + o[bj][1][3] * o[bj][1][3]); }
                stage_store_rows(stg, fr, fq, pack8(o[0][0], o[0][1]), pack8(o[1][0], o[1][1]), (unsigned char*)(X + (size_t)(row - fr) * 1024 + colb), 2048, 8);
                s2 += __shfl_xor(s2, 16); s2 += __shfl_xor(s2, 32);
                if (fq == 0) ssp2[(size_t)row * 16 + u.pn * 4 + wc] = s2; }
    }
};

struct EpiSwiglu {
    static constexpr bool PERM = true, AFTER_DRAIN = false;
    bf16_t* O; const float* rs;
    __device__ __forceinline__ void operator()(const f32x4 (&acc)[2][2][4][2], const Unit& u, int wr, int wc, int fr_in, int fq_in) const {
        int fr = fr_in, fq = fq_in; asm volatile("" : "+v"(fr), "+v"(fq));
        const int row0 = u.pm * BM + wr * 64 + fr, col0 = u.pn * HALF + wc * 32 + 8 * fq;
#pragma unroll
        for (int ai = 0; ai < 2; ++ai)
#pragma unroll
            for (int m = 0; m < 4; ++m) { const int row = row0 + ai * HALF + m * 16; bf16_t* rowp = O + (size_t)row * ::DFF + col0; float r[8]; const float rsv = rs[row];
#pragma unroll
                for (int n = 0; n < 2; ++n)
#pragma unroll
                    for (int k = 0; k < 4; ++k) { const float a = acc[ai][0][m][n][k] * rsv, b = acc[ai][1][m][n][k] * rsv; r[4 * n + k] = a * fast_sigmoid(a) * b; }
                u32x4 w; w.x = cvt_pk_bf16(r[0], r[1]); w.y = cvt_pk_bf16(r[2], r[3]); w.z = cvt_pk_bf16(r[4], r[5]); w.w = cvt_pk_bf16(r[6], r[7]);
                *(u32x4*)rowp = w; }
    }
};

struct EpiFinal {
    static constexpr bool PERM = true, AFTER_DRAIN = false;
    const bf16_t* x2; const bf16_t* ple; const float* ssp2; float* out; PG8_LAS unsigned char* lds;
    struct In { f32x4 pp[4]; u32x4 xw[2], pw[2]; };
    __device__ __forceinline__ In load(int row, int colb, int fq) const { In r; const f32x4* p = (const f32x4*)(ssp2 + (size_t)row * 16);
#pragma unroll
        for (int q = 0; q < 4; ++q) r.pp[q] = p[q];
#pragma unroll
        for (int bj = 0; bj < 2; ++bj) { const size_t idx = (size_t)row * 1024 + colb + 32 * bj + 8 * fq; r.xw[bj] = *(const u32x4*)(x2 + idx); r.pw[bj] = *(const u32x4*)(ple + idx); }
        return r; }
    __device__ __forceinline__ void operator()(const f32x4 (&acc)[2][2][4][2], const Unit& u, int wr, int wc, int fr_in, int fq_in) const {
        int fr = fr_in, fq = fq_in; asm volatile("" : "+v"(fr), "+v"(fq));
        PG8_LAS unsigned char* stg = lds + EPI_STG_OFF + (wr * 4 + wc) * EPI_STG_WAVE;
        const int rowb = u.pm * BM + wr * 64, colb = u.pn * BM + wc * 64;
        const int ln = fq * 16 + fr, r8 = ln >> 3, c8 = ln & 7;
        In cur = load(rowb + fr, colb, fq);
#pragma unroll
        for (int g = 0; g < 8; ++g) { const int ai = g >> 2, m = g & 3; const int rowblk = rowb + ai * HALF + m * 16;
            In nxt = cur; if (g < 7) nxt = load(rowb + ((g + 1) >> 2) * HALF + ((g + 1) & 3) * 16 + fr, colb, fq);
            const f32x4 p0 = cur.pp[0], p1 = cur.pp[1], p2 = cur.pp[2], p3 = cur.pp[3];
            const float t = (((p0[0] + p0[1]) + (p0[2] + p0[3])) + ((p1[0] + p1[1]) + (p1[2] + p1[3]))) + (((p2[0] + p2[1]) + (p2[2] + p2[3])) + ((p3[0] + p3[1]) + (p3[2] + p3[3])));
            const float rsv = __builtin_amdgcn_rsqf(t * (1.f / 1024.f) + ::RMS_EPS);
#pragma unroll
            for (int bj = 0; bj < 2; ++bj) { const u32x4 xw = cur.xw[bj], pw = cur.pw[bj];
                const f32x4 a0 = acc[ai][bj][m][0] * rsv, a1 = acc[ai][bj][m][1] * rsv; u32x4 o0, o1;
                o0.x = __float_as_uint(bf_lo(xw.x) + fast_sigmoid(a0[0]) * bf_lo(pw.x)); o0.y = __float_as_uint(bf_hi(xw.x) + fast_sigmoid(a0[1]) * bf_hi(pw.x));
                o0.z = __float_as_uint(bf_lo(xw.y) + fast_sigmoid(a0[2]) * bf_lo(pw.y)); o0.w = __float_as_uint(bf_hi(xw.y) + fast_sigmoid(a0[3]) * bf_hi(pw.y));
                o1.x = __float_as_uint(bf_lo(xw.z) + fast_sigmoid(a1[0]) * bf_lo(pw.z)); o1.y = __float_as_uint(bf_hi(xw.z) + fast_sigmoid(a1[1]) * bf_hi(pw.z));
                o1.z = __float_as_uint(bf_lo(xw.w) + fast_sigmoid(a1[2]) * bf_lo(pw.w)); o1.w = __float_as_uint(bf_hi(xw.w) + fast_sigmoid(a1[3]) * bf_hi(pw.w));
                *(PG8_LAS u32x4*)(stg + fr * EPI_STG_ROW + fq * 32) = o0; *(PG8_LAS u32x4*)(stg + fr * EPI_STG_ROW + fq * 32 + 16) = o1;
#pragma unroll
                for (int h = 0; h < 2; ++h) { const u32x4 v = *(const PG8_LAS u32x4*)(stg + (8 * h + r8) * EPI_STG_ROW + c8 * 16);
                    *(u32x4*)((unsigned char*)out + ((size_t)(rowblk + 8 * h + r8) * 1024 + colb + 32 * bj) * 4 + c8 * 16) = v; } }
            cur = nxt; }
    }
};

template <class E> struct ProbeTraits { static constexpr bool no_stage = false, no_lds = false; };
#if defined(GEMM_PROBE)
template <> struct ProbeTraits<EpiNone> { static constexpr bool no_stage = (GEMM_PROBE == 2 || GEMM_PROBE == 4), no_lds = (GEMM_PROBE == 3 || GEMM_PROBE == 4); };
#endif
template <class Epi, class Sched, bool ALIGN_EPI = false, bool SP2 = false>
__device__ __forceinline__ void gemm_phase(PG8_LAS unsigned char* lds, const Gemm g, const Sched& S, const Epi& E) {
    const int tid = threadIdx.x, wid = __builtin_amdgcn_readfirstlane(tid >> 6), lane = tid & 63, wr = wid >> 2, wc = wid & 3, fr = lane & 15, fq = lane >> 4;
    const int K = g.K, nt = K / BK;
    unsigned voffA[2], voffB[2];
#pragma unroll
    for (int i = 0; i < 2; ++i) { int R, C; stage_rc(tid * 16 + i * 8192, R, C); const int Rb = Epi::PERM ? ((R & ~31) + perm32(R & 31)) : R;
        voffA[i] = (unsigned)(R * K + C) * 2u; voffB[i] = (unsigned)(Rb * K + C) * 2u; }
    const size_t kstep = (size_t)(BK * 2);
    const size_t hstep = (size_t)HALF * K * 2;
    const size_t tstep = 2 * hstep;
    const unsigned ldsw = (unsigned)wid * 1024u;
    const int aoff = lds_byte(wr * 64 + fr, fq * 8), boff = lds_byte(wc * 32 + fr, fq * 8);
#define PG8_SA(b, h) (((b) * 2 + (h)) * HTB)
#define PG8_SB(b, h) ((4 + (b) * 2 + (h)) * HTB)
#if !defined(PG8_GLOBAL_DMA)
    const __amdgpu_buffer_rsrc_t rsrcA = __builtin_amdgcn_make_buffer_rsrc((void*)g.A, 0, 0x7fffffff, 0x00020000), rsrcB = __builtin_amdgcn_make_buffer_rsrc((void*)g.Bt, 0, 0x7fffffff, 0x00020000);
#define PG8_STAGE(bufoff, gbase, voff) do { if constexpr (!ProbeTraits<Epi>::no_stage) { const bool isA_ = ((const void*)(voff) == (const void*)voffA); \
        const int so_ = (int)((const char*)(gbase) - (isA_ ? (const char*)g.A : (const char*)g.Bt)); _Pragma("unroll") for (int _i = 0; _i < 2; ++_i) { \
        if (isA_) __builtin_amdgcn_raw_ptr_buffer_load_lds(rsrcA, (PG8_LAS unsigned*)(lds + (bufoff) + ldsw + _i * 8192), 16, (int)(voff)[_i], so_, 0, 0); \
        else      __builtin_amdgcn_raw_ptr_buffer_load_lds(rsrcB, (PG8_LAS unsigned*)(lds + (bufoff) + ldsw + _i * 8192), 16, (int)(voff)[_i], so_, 0, 0); } } } while (0)
#else
#define PG8_STAGE(bufoff, gbase, voff) do { if constexpr (!ProbeTraits<Epi>::no_stage) _Pragma("unroll") for (int _i = 0; _i < 2; ++_i) \
        __builtin_amdgcn_global_load_lds((const unsigned*)((const char*)(gbase) + (voff)[_i]), (PG8_LAS unsigned*)(lds + (bufoff) + ldsw + _i * 8192), 16, 0, 0); } while (0)
#endif
#define PG8_LDA(dst, b, h) do { if constexpr (!ProbeTraits<Epi>::no_lds) _Pragma("unroll") for (int m = 0; m < 4; ++m) _Pragma("unroll") for (int k = 0; k < 2; ++k) dst[m][k] = *(const PG8_LAS bf16x8*)(lds + PG8_SA(b, h) + aoff + m * 2048 + k * 1024); } while (0)
#define PG8_LDB(dst, b, h) do { if constexpr (!ProbeTraits<Epi>::no_lds) _Pragma("unroll") for (int n = 0; n < 2; ++n) _Pragma("unroll") for (int k = 0; k < 2; ++k) dst[n][k] = *(const PG8_LAS bf16x8*)(lds + PG8_SB(b, h) + boff + n * 2048 + k * 1024); } while (0)
#if defined(PG8_NO_PRIO)
#define PG8_PRIO(x) do { } while (0)
#else
#if defined(PG8_PRIO_HI)
#define PG8_PRIO(x) __builtin_amdgcn_s_setprio((x) ? PG8_PRIO_HI : 0)
#else
#define PG8_PRIO(x) __builtin_amdgcn_s_setprio(x)
#endif
#endif
#define PG8_MMA(ai, bj, At, Bt) do { PG8_PRIO(1); _Pragma("unroll") for (int m = 0; m < 4; ++m) _Pragma("unroll") for (int n = 0; n < 2; ++n) _Pragma("unroll") for (int k = 0; k < 2; ++k) \
        acc[ai][bj][m][n] = __builtin_amdgcn_mfma_f32_16x16x32_bf16(Bt[n][k], At[m][k], acc[ai][bj][m][n], 0, 0, 0); PG8_PRIO(0); } while (0)
#define PG8_MMA_H(ai, bj, At, Bt, mlo, mhi) do { __builtin_amdgcn_s_setprio(1); _Pragma("unroll") for (int m = mlo; m < mhi; ++m) _Pragma("unroll") for (int n = 0; n < 2; ++n) _Pragma("unroll") for (int k = 0; k < 2; ++k) \
        acc[ai][bj][m][n] = __builtin_amdgcn_mfma_f32_16x16x32_bf16(Bt[n][k], At[m][k], acc[ai][bj][m][n], 0, 0, 0); __builtin_amdgcn_s_setprio(0); } while (0)
#define PG8_WAIT_V(n) asm volatile("s_waitcnt vmcnt(" #n ")" ::: "memory")
#define PG8_WAIT_L(n) asm volatile("s_waitcnt lgkmcnt(" #n ")" ::: "memory")
#define PG8_BAR __builtin_amdgcn_s_barrier()
#define PG8_SCHED __builtin_amdgcn_sched_barrier(0)
    Unit cur, nxt; int ui = 0;
    if (!S.next(0, cur)) return;
    f32x4 acc[2][2][4][2];
#pragma unroll
    for (int a = 0; a < 2; ++a)
#pragma unroll
        for (int b = 0; b < 2; ++b)
#pragma unroll
            for (int m = 0; m < 4; ++m)
#pragma unroll
                for (int n = 0; n < 2; ++n) acc[a][b][m][n] = (f32x4){0.f, 0.f, 0.f, 0.f};
    bf16x8 At[4][2], B0[2][2], B1[2][2];
    if constexpr (ProbeTraits<Epi>::no_lds) { _Pragma("unroll") for (int m = 0; m < 4; ++m) _Pragma("unroll") for (int k = 0; k < 2; ++k) { _Pragma("unroll") for (int e = 0; e < 8; ++e) At[m][k][e] = (short)(0x3e00 | ((tid * 2654435761u + (m * 2 + k) * 40503u + e * 9176u) >> 16 & 0x81ff)); } _Pragma("unroll") for (int n = 0; n < 2; ++n) _Pragma("unroll") for (int k = 0; k < 2; ++k) { _Pragma("unroll") for (int e = 0; e < 8; ++e) { B0[n][k][e] = (short)(0x3e00 | ((tid * 40503u + (n * 2 + k) * 2654435761u + e * 7919u) >> 13 & 0x81ff)); B1[n][k][e] = (short)(0x3e00 | ((tid * 9973u + (n * 2 + k) * 1234577u + e * 7919u) >> 11 & 0x81ff)); } } }
    const char* cA = (const char*)g.A + (size_t)cur.pm * tstep; const char* cB = (const char*)g.Bt + (size_t)cur.pn * tstep;
    S.a_ready(cur);
    if constexpr (SP2) {
        PG8_STAGE(PG8_SB(0, 0), cB, voffB); PG8_STAGE(PG8_SB(0, 1), cB + hstep, voffB); PG8_STAGE(PG8_SA(0, 0), cA, voffA); PG8_STAGE(PG8_SA(0, 1), cA + hstep, voffA);
        if (wr == 1) PG8_BAR;
        PG8_WAIT_V(2); PG8_BAR;
#if defined(PG8_BAL_DMA)
        PG8_STAGE(PG8_SB(1, 0), cB + kstep, voffB); PG8_STAGE(PG8_SA(1, 0), cA + kstep, voffA);
        PG8_WAIT_V(4); PG8_BAR;
#else
        PG8_STAGE(PG8_SB(1, 0), cB + kstep, voffB); PG8_STAGE(PG8_SA(1, 0), cA + kstep, voffA); PG8_STAGE(PG8_SB(1, 1), cB + hstep + kstep, voffB);
        PG8_WAIT_V(6); PG8_BAR;
#endif
    } else {
        PG8_STAGE(PG8_SB(0, 0), cB, voffB); PG8_STAGE(PG8_SA(0, 0), cA, voffA); PG8_STAGE(PG8_SB(0, 1), cB + hstep, voffB); PG8_STAGE(PG8_SA(0, 1), cA + hstep, voffA);
        if (wr == 1) PG8_BAR;
        PG8_WAIT_V(4); PG8_BAR;
        PG8_STAGE(PG8_SB(1, 0), cB + kstep, voffB); PG8_STAGE(PG8_SA(1, 0), cA + kstep, voffA); PG8_STAGE(PG8_SB(1, 1), cB + hstep + kstep, voffB);
        PG8_WAIT_V(6); PG8_BAR;
    }
    for (;;) {
        const bool has_next = S.next(ui + 1, nxt);
        const char* nA = has_next ? (const char*)g.A + (size_t)nxt.pm * tstep : cA; const char* nB = has_next ? (const char*)g.Bt + (size_t)nxt.pn * tstep : cB;
#pragma unroll 1
        for (int t = 0; t < nt; t += 2) {
            const bool last = (t == nt - 2);
            const char* a1 = cA + (size_t)(t + 1) * kstep;
            const char* b1 = cB + (size_t)(t + 1) * kstep; (void)b1;
            const char* a2 = last ? nA : cA + (size_t)(t + 2) * kstep; const char* b2 = last ? nB : cB + (size_t)(t + 2) * kstep;
            const char* a3 = a2 + kstep; const char* b3 = b2 + kstep;
            if (last && has_next) S.a_ready(nxt);
            if constexpr (SP2) {
#if defined(PG8_BAL_DMA)
            PG8_LDB(B0, 0, 0); PG8_LDB(B1, 0, 1); PG8_SCHED; PG8_LDA(At, 0, 0); PG8_STAGE(PG8_SB(1, 1), b1 + hstep, voffB); PG8_STAGE(PG8_SA(1, 1), a1 + hstep, voffA);
            PG8_WAIT_V(8); PG8_WAIT_L(0); PG8_BAR; PG8_MMA(0, 0, At, B0); PG8_MMA(0, 1, At, B1); PG8_BAR; PG8_SCHED;
            PG8_LDA(At, 0, 1); PG8_STAGE(PG8_SB(0, 0), b2, voffB); PG8_STAGE(PG8_SA(0, 0), a2, voffA);
            PG8_WAIT_V(6); PG8_WAIT_L(0); PG8_BAR; PG8_MMA(1, 0, At, B0); PG8_MMA(1, 1, At, B1); PG8_BAR; PG8_SCHED;
            PG8_LDB(B0, 1, 0); PG8_LDB(B1, 1, 1); PG8_SCHED; PG8_LDA(At, 1, 0); PG8_STAGE(PG8_SB(0, 1), b2 + hstep, voffB); PG8_STAGE(PG8_SA(0, 1), a2 + hstep, voffA);
            PG8_WAIT_V(8); PG8_WAIT_L(0); PG8_BAR; PG8_MMA(0, 0, At, B0); PG8_MMA(0, 1, At, B1); PG8_BAR; PG8_SCHED;
            PG8_LDA(At, 1, 1); PG8_STAGE(PG8_SB(1, 0), b3, voffB); PG8_STAGE(PG8_SA(1, 0), a3, voffA);
            PG8_WAIT_V(6); PG8_WAIT_L(0); PG8_BAR; PG8_MMA(1, 0, At, B0); PG8_MMA(1, 1, At, B1); PG8_BAR; PG8_SCHED;
#elif defined(PG8_STAGE_IN_MMA)
            PG8_LDB(B0, 0, 0); PG8_LDB(B1, 0, 1); PG8_SCHED; PG8_LDA(At, 0, 0);
            PG8_WAIT_V(6); PG8_WAIT_L(0); PG8_BAR; PG8_MMA_H(0, 0, At, B0, 0, 2); PG8_SCHED; PG8_STAGE(PG8_SA(1, 1), a1 + hstep, voffA); PG8_SCHED; PG8_MMA_H(0, 0, At, B0, 2, 4); PG8_MMA(0, 1, At, B1); PG8_BAR; PG8_SCHED;
            PG8_LDA(At, 0, 1);
            PG8_WAIT_V(2); PG8_WAIT_L(0); PG8_BAR; PG8_MMA_H(1, 0, At, B0, 0, 2); PG8_SCHED; PG8_STAGE(PG8_SB(0, 0), b2, voffB); PG8_SCHED; PG8_MMA_H(1, 0, At, B0, 2, 4); PG8_SCHED; PG8_STAGE(PG8_SB(0, 1), b2 + hstep, voffB); PG8_SCHED;
            PG8_MMA_H(1, 1, At, B1, 0, 2); PG8_SCHED; PG8_STAGE(PG8_SA(0, 0), a2, voffA); PG8_SCHED; PG8_MMA_H(1, 1, At, B1, 2, 4); PG8_BAR; PG8_SCHED;
            PG8_LDB(B0, 1, 0); PG8_LDB(B1, 1, 1); PG8_SCHED; PG8_LDA(At, 1, 0);
            PG8_WAIT_V(6); PG8_WAIT_L(0); PG8_BAR; PG8_MMA_H(0, 0, At, B0, 0, 2); PG8_SCHED; PG8_STAGE(PG8_SA(0, 1), a2 + hstep, voffA); PG8_SCHED; PG8_MMA_H(0, 0, At, B0, 2, 4); PG8_MMA(0, 1, At, B1); PG8_BAR; PG8_SCHED;
            PG8_LDA(At, 1, 1);
            PG8_WAIT_V(2); PG8_WAIT_L(0); PG8_BAR; PG8_MMA_H(1, 0, At, B0, 0, 2); PG8_SCHED; PG8_STAGE(PG8_SB(1, 0), b3, voffB); PG8_SCHED; PG8_MMA_H(1, 0, At, B0, 2, 4); PG8_SCHED; PG8_STAGE(PG8_SB(1, 1), b3 + hstep, voffB); PG8_SCHED;
            PG8_MMA_H(1, 1, At, B1, 0, 2); PG8_SCHED; PG8_STAGE(PG8_SA(1, 0), a3, voffA); PG8_SCHED; PG8_MMA_H(1, 1, At, B1, 2, 4); PG8_BAR; PG8_SCHED;
#else
            PG8_LDB(B0, 0, 0); PG8_LDB(B1, 0, 1); PG8_SCHED; PG8_LDA(At, 0, 0); PG8_STAGE(PG8_SA(1, 1), a1 + hstep, voffA);
            PG8_WAIT_V(8); PG8_WAIT_L(0); PG8_BAR; PG8_MMA(0, 0, At, B0); PG8_MMA(0, 1, At, B1); PG8_BAR; PG8_SCHED;
            PG8_LDA(At, 0, 1); PG8_STAGE(PG8_SB(0, 0), b2, voffB); PG8_STAGE(PG8_SB(0, 1), b2 + hstep, voffB); PG8_STAGE(PG8_SA(0, 0), a2, voffA);
            PG8_WAIT_V(8); PG8_WAIT_L(0); PG8_BAR; PG8_MMA(1, 0, At, B0); PG8_MMA(1, 1, At, B1); PG8_BAR; PG8_SCHED;
            PG8_LDB(B0, 1, 0); PG8_LDB(B1, 1, 1); PG8_SCHED; PG8_LDA(At, 1, 0); PG8_STAGE(PG8_SA(0, 1), a2 + hstep, voffA);
            PG8_WAIT_V(8); PG8_WAIT_L(0); PG8_BAR; PG8_MMA(0, 0, At, B0); PG8_MMA(0, 1, At, B1); PG8_BAR; PG8_SCHED;
            PG8_LDA(At, 1, 1); PG8_STAGE(PG8_SB(1, 0), b3, voffB); PG8_STAGE(PG8_SB(1, 1), b3 + hstep, voffB); PG8_STAGE(PG8_SA(1, 0), a3, voffA);
            PG8_WAIT_V(8); PG8_WAIT_L(0); PG8_BAR; PG8_MMA(1, 0, At, B0); PG8_MMA(1, 1, At, B1); PG8_BAR; PG8_SCHED;
#endif
            } else {
            PG8_LDB(B0, 0, 0); PG8_SCHED; PG8_LDA(At, 0, 0); PG8_STAGE(PG8_SA(1, 1), a1 + hstep, voffA);
            PG8_WAIT_L(8); PG8_BAR; PG8_WAIT_L(0); PG8_MMA(0, 0, At, B0); PG8_BAR; PG8_SCHED;
            PG8_LDB(B1, 0, 1); PG8_STAGE(PG8_SB(0, 0), b2, voffB);
            PG8_BAR; PG8_WAIT_L(0); PG8_MMA(0, 1, At, B1); PG8_BAR;
            PG8_LDA(At, 0, 1); PG8_STAGE(PG8_SA(0, 0), a2, voffA);
            PG8_BAR; PG8_WAIT_L(0); PG8_MMA(1, 0, At, B0); PG8_BAR; PG8_SCHED;
            PG8_STAGE(PG8_SB(0, 1), b2 + hstep, voffB);
            PG8_WAIT_V(6); PG8_BAR; PG8_MMA(1, 1, At, B1); PG8_BAR;
            PG8_LDB(B0, 1, 0); PG8_SCHED; PG8_LDA(At, 1, 0); PG8_STAGE(PG8_SA(0, 1), a2 + hstep, voffA);
            PG8_WAIT_L(8); PG8_BAR; PG8_WAIT_L(0); PG8_MMA(0, 0, At, B0); PG8_BAR; PG8_SCHED;
            PG8_LDB(B1, 1, 1); PG8_STAGE(PG8_SB(1, 0), b3, voffB);
            PG8_BAR; PG8_WAIT_L(0); PG8_MMA(0, 1, At, B1); PG8_BAR;
            PG8_LDA(At, 1, 1); PG8_STAGE(PG8_SA(1, 0), a3, voffA);
            PG8_BAR; PG8_WAIT_L(0); PG8_MMA(1, 0, At, B0); PG8_BAR; PG8_SCHED;
            PG8_STAGE(PG8_SB(1, 1), b3 + hstep, voffB);
            PG8_WAIT_V(6); PG8_BAR; PG8_MMA(1, 1, At, B1); PG8_BAR;
            }
        }
        if constexpr (ALIGN_EPI) { if (wr == 0) PG8_BAR; }
        if constexpr (!Epi::AFTER_DRAIN) { E(acc, cur, wr, wc, fr, fq); S.done(cur); }
        if (!has_next) break;
#pragma unroll
        for (int a = 0; a < 2; ++a)
#pragma unroll
            for (int b = 0; b < 2; ++b)
#pragma unroll
                for (int m = 0; m < 4; ++m)
#pragma unroll
                    for (int n = 0; n < 2; ++n) acc[a][b][m][n] = (f32x4){0.f, 0.f, 0.f, 0.f};
        cur = nxt; cA = nA; cB = nB; ++ui;
        if constexpr (ALIGN_EPI) { if (wr == 1) PG8_BAR; }
    }
    PG8_WAIT_V(0);
    if constexpr (!ALIGN_EPI) { if (wr == 0) PG8_BAR; }
    PG8_BAR;
    if constexpr (Epi::AFTER_DRAIN) { E.fused(acc, cur, wr, wc, fr, fq, lds, wid, lane); S.done(cur); }
#undef PG8_SA
#undef PG8_SB
#undef PG8_STAGE
#undef PG8_LDA
#undef PG8_LDB
#undef PG8_MMA
#undef PG8_WAIT_V
#undef PG8_WAIT_L
#undef PG8_BAR
#undef PG8_SCHED
}
}

constexpr int NWAVES = 8;
constexpr int N_PHASES = 11;
constexpr int N_LAUNCHES = MK_N_LAUNCHES;
constexpr int LDS_BYTES = 155648;
constexpr int RING_BYTES = 131072, LDSCTL_OFF = LDS_BYTES - 512, MISC_OFF = LDSCTL_OFF + 320;
constexpr int CW_BAR = 4096;
#define GAS __attribute__((address_space(1)))
#define LAS __attribute__((address_space(3)))
typedef unsigned short bf16;
typedef unsigned v4u __attribute__((ext_vector_type(4)));
typedef unsigned v2u __attribute__((ext_vector_type(2)));
typedef float f32x4 __attribute__((ext_vector_type(4)));
typedef float f32x16 __attribute__((ext_vector_type(16)));
typedef short bf16x8 __attribute__((ext_vector_type(8)));
typedef short s16x4 __attribute__((ext_vector_type(4)));
typedef short v4i16_t __attribute__((ext_vector_type(4)));
typedef GAS unsigned gu32;
#define LDS_WAIT() asm volatile("s_waitcnt lgkmcnt(0)" ::: "memory")
#define VM_WAIT() asm volatile("s_waitcnt vmcnt(0)" ::: "memory")
__device__ __forceinline__ unsigned pk2(float lo, float hi) { return pg8::cvt_pk_bf16(lo, hi); }
__device__ __forceinline__ float bflo(unsigned w) { return __uint_as_float(w << 16); }
__device__ __forceinline__ float bfhi(unsigned w) { return __uint_as_float(w & 0xffff0000u); }
__device__ __forceinline__ float bf1(bf16 h) { return __uint_as_float((unsigned)h << 16); }
__device__ __forceinline__ float ex2(float x) { return __builtin_amdgcn_exp2f(x); }
__device__ __forceinline__ float sigm(float x) { return __builtin_amdgcn_rcpf(1.f + __builtin_amdgcn_exp2f(-x * LOG2E)); }
__device__ __forceinline__ float wave_sum(float v) {
#pragma unroll
    for (int o = 1; o < 64; o <<= 1) v += __shfl_xor(v, o);
    return v;
}
__device__ __forceinline__ float swap32f(float v) {
    auto rr = __builtin_amdgcn_permlane32_swap(__float_as_uint(v), __float_as_uint(v), false, false);
    return (threadIdx.x & 32) ? __uint_as_float(rr[0]) : __uint_as_float(rr[1]);
}
__device__ __forceinline__ s16x4 trrd(const LAS char* p) { return __builtin_bit_cast(s16x4, __builtin_amdgcn_ds_read_tr16_b64_v4i16((LAS v4i16_t*)p)); }
#define MK8(lo, hi) (bf16x8){lo[0], lo[1], lo[2], lo[3], hi[0], hi[1], hi[2], hi[3]}

#define XB_TMO      128
#define XB_XCNT(j)  (256  + 64 * (j))
#define XB_XSUB(j)  (1280 + 64 * (j))
#define XB_XGEN(j)  (2304 + 64 * (j))
#define XB_TOP      3328
#define XB_TOPGEN   3392
#define XCD_BAR_WORDS 3456
#define XB_SPIN_CAP (1u << 18)

__device__ __forceinline__ unsigned xb_ld(unsigned* p)              { return __hip_atomic_load(p, __ATOMIC_RELAXED, __HIP_MEMORY_SCOPE_AGENT); }
__device__ __forceinline__ unsigned xb_add(unsigned* p, unsigned v) { return __hip_atomic_fetch_add(p, v, __ATOMIC_RELAXED, __HIP_MEMORY_SCOPE_AGENT); }
__device__ __forceinline__ unsigned xb_xcc_id() { return (unsigned)__builtin_amdgcn_s_getreg((3 << 11) | 20) & 0xFu; }
#define XB_SPIN(cond, bar) do { unsigned _sp = 0; while (cond) { __builtin_amdgcn_s_sleep(1); \
    if ((++_sp & 255u) == 0u) { if (xb_ld(&(bar)[XB_TMO])) break; if (_sp > XB_SPIN_CAP) { atomicAdd(&(bar)[XB_TMO], 1u); break; } } } } while (0)

struct XcdBarrier {
    unsigned* bar; unsigned x;
    volatile LAS unsigned* st;
};

__device__ __forceinline__ XcdBarrier xcd_barrier_post(unsigned* bar, volatile LAS unsigned* st) {
    XcdBarrier b; b.bar = bar; b.x = xb_xcc_id(); b.st = st;
    if (threadIdx.x == 0) (void)xb_add(&bar[XB_XCNT(b.x)], 1u);
    return b;
}
__device__ __forceinline__ void xcd_barrier_complete(unsigned* bar, unsigned x, unsigned& nloc, unsigned& nx) {
    const unsigned G = gridDim.x * gridDim.y * gridDim.z;
    unsigned sum, cnt, mine, sp = 0u;
    for (;;) {
        sum = 0u; cnt = 0u; mine = 0u;
#pragma unroll
        for (unsigned j = 0; j < 16; ++j) { const unsigned c = xb_ld(&bar[XB_XCNT(j)]); sum += c; cnt += (c > 0u) ? 1u : 0u; mine = (j == x) ? c : mine; }
        if (sum == G) break;
        __builtin_amdgcn_s_sleep(1);
        if ((++sp & 255u) == 0u) { if (xb_ld(&bar[XB_TMO])) break; if (sp > XB_SPIN_CAP) { atomicAdd(&bar[XB_TMO], 1u); break; } }
    }
    nloc = mine > 0u ? mine : 1u; nx = cnt > 0u ? cnt : 1u;
}

__device__ __forceinline__ void xcd_barrier(const XcdBarrier& b) {
    asm volatile("s_waitcnt vmcnt(0)" ::: "memory");
    __syncthreads();
    if (threadIdx.x == 0) {
        unsigned* bar = b.bar;
        __builtin_amdgcn_s_waitcnt(0);
        unsigned nloc = b.st[0], nx = b.st[1];
        if (nloc == 0u) { xcd_barrier_complete(bar, b.x, nloc, nx); b.st[0] = nloc; b.st[1] = nx; }
        const unsigned old = xb_add(&bar[XB_XSUB(b.x)], 1u);
        const unsigned gen = old / nloc;
        if (old + 1u == (gen + 1u) * nloc) {
            __builtin_amdgcn_fence(__ATOMIC_RELEASE, "agent");
            asm volatile("s_waitcnt vmcnt(0)" ::: "memory");
            const unsigned og = xb_add(&bar[XB_TOP], 1u);
            const unsigned tg = og / nx;
            if (og + 1u == (tg + 1u) * nx) xb_add(&bar[XB_TOPGEN], 1u);
            else XB_SPIN(xb_ld(&bar[XB_TOPGEN]) == tg, bar);
            __builtin_amdgcn_fence(__ATOMIC_ACQUIRE, "agent");
            xb_add(&bar[XB_XGEN(b.x)], 1u);
            asm volatile("s_waitcnt vmcnt(0)" ::: "memory");
        } else {
            XB_SPIN(xb_ld(&bar[XB_XGEN(b.x)]) == gen, bar);
            __builtin_amdgcn_fence(__ATOMIC_ACQUIRE, "agent");
            asm volatile("s_waitcnt vmcnt(0)" ::: "memory");
        }
    }
    __syncthreads();
}

struct Args { const float* in[19]; float* out; unsigned char* ws; int ph_lo, ph_hi, li, pad; };
enum { I_X = 0, I_P, I_NMPRE, I_NMPOST, I_NFPRE, I_NFPOST, I_WIN, I_GNG, I_PEK, I_W1K, I_W2K, I_PEV, I_W1V, I_W2V, I_WOUT, I_WFI, I_WFO, I_WPLE, I_WGATE };
struct Ctx { LAS unsigned char* lds; int tid, lane, wave, vcu, G; };

struct MapId { __device__ __forceinline__ int operator()(int v) const { return v; } };
struct MapWin { __device__ __forceinline__ int operator()(int v) const { return v < 4608 ? v : (v < 6656 ? v - 4608 + 5616 : (v < 7664 ? v - 6656 + 4608 : -1)); } };
struct MapFfn { __device__ __forceinline__ int operator()(int v) const { const int pn = v >> 8, r = v & 255, ch = pn * 128 + 32 * (r >> 6) + (r & 31); return ((r >> 5) & 1) ? DFF + ch : ch; } };
__device__ __forceinline__ int tile_logical(int v) { return (v & ~255) | (64 * ((v >> 5) & 3) + 32 * ((v >> 7) & 1) + (v & 31)); }
template <class MAP>
__device__ __forceinline__ void p0_transpose_item(const float* W, int K, int N, int Nv, bf16* WT, LAS float* scr, int item, int lane, const MAP& map, bool tperm, const float* kscale = nullptr) {
    const int nblk = Nv / 32, kb = item / nblk, nb = item % nblk, k0 = 64 * kb, n0 = 32 * nb;
    const int ac = map(tperm ? tile_logical(n0 + (lane & 31)) : n0 + (lane & 31));
#pragma unroll 16
    for (int i = 0; i < 32; ++i) { const int kk = 2 * i + (lane >> 5); const float ks = kscale ? kscale[k0 + kk] : 1.f; scr[kk * 33 + (lane & 31)] = ac >= 0 ? W[(size_t)(k0 + kk) * N + ac] * ks : 0.f; }
    LDS_WAIT(); asm volatile("" ::: "memory");
    const int c = lane & 7;
#pragma unroll
    for (int j = 0; j < 4; ++j) { const int n = (lane >> 3) + 8 * j; const LAS float* s = scr + (8 * c) * 33 + n;
        v4u o; o.x = pk2(s[0 * 33], s[1 * 33]); o.y = pk2(s[2 * 33], s[3 * 33]); o.z = pk2(s[4 * 33], s[5 * 33]); o.w = pk2(s[6 * 33], s[7 * 33]);
        *(GAS v4u*)(WT + (size_t)(n0 + n) * K + k0 + 8 * c) = o; }
    LDS_WAIT(); asm volatile("" ::: "memory");
}
template <int NR>
__device__ __forceinline__ void rms_rows_to_bf16(const float* x, const float* p, const f32x4 (&gg)[4], bf16* H, bf16* PB, int m0, int stride, int lane) {
    f32x4 v[NR][4], pv[NR];
#pragma unroll
    for (int r = 0; r < NR; ++r) { const GAS f32x4* xr = (const GAS f32x4*)(x + (size_t)(m0 + r * stride) * DM) + lane;
#pragma unroll
        for (int j = 0; j < 4; ++j) v[r][j] = __builtin_nontemporal_load(xr + 64 * j);
        pv[r] = __builtin_nontemporal_load((const GAS f32x4*)(p + (size_t)(m0 + r * stride) * PLE_D) + lane); }
#pragma unroll
    for (int r = 0; r < NR; ++r) { float s = 0.f;
#pragma unroll
        for (int j = 0; j < 4; ++j) s += (v[r][j].x * v[r][j].x + v[r][j].y * v[r][j].y) + (v[r][j].z * v[r][j].z + v[r][j].w * v[r][j].w);
        const float rstd = __builtin_amdgcn_rsqf(wave_sum(s) * (1.f / DM) + RMS_EPS);
        GAS v2u* o8 = (GAS v2u*)(H + (size_t)(m0 + r * stride) * DM) + lane;
#pragma unroll
        for (int j = 0; j < 4; ++j) { v2u w; w.x = pk2(v[r][j].x * rstd * gg[j].x, v[r][j].y * rstd * gg[j].y); w.y = pk2(v[r][j].z * rstd * gg[j].z, v[r][j].w * rstd * gg[j].w); o8[64 * j] = w; }
        v2u w; w.x = pk2(pv[r].x, pv[r].y); w.y = pk2(pv[r].z, pv[r].w); *((GAS v2u*)(PB + (size_t)(m0 + r * stride) * PLE_D) + lane) = w; }
}
__device__ __forceinline__ void p0_prologue(const Ctx& C, const Args& A) {
    LAS float* scr = (LAS float*)(C.lds + C.wave * 16384);
    const int gw = C.vcu * NWAVES + C.wave, NGW = C.G * NWAVES, lane = C.lane;
    unsigned char* ws = A.ws;
    constexpr int I_IN = 16 * (IN_VIRT / 32), I_OUT = 16 * 32, I_FI = 16 * (2 * DFF / 32), I_FO = (DFF / 64) * 32, I_PL = 4 * 32, I_GT = 16 * 32, I_1K = 48 * 3, I_1V = 32 * 2;
    constexpr int NITEMS = I_IN + I_OUT + I_FI + I_FO + I_PL + I_GT + I_1K + I_1V;
#if defined(P0_PROBE)
    for (int it2 = gw; it2 < 2 * NITEMS; it2 += NGW) {
        const int it = it2 >= NITEMS ? it2 - NITEMS : it2;
        int r = it;
#else
    for (int it = gw; it < NITEMS; it += NGW) {
        int r = it;
#endif
        if (r < I_IN) { p0_transpose_item(A.in[I_WIN], DM, IN_TOTAL, IN_VIRT, (bf16*)(ws + WS_WIN), scr, r, lane, MapWin(), true); continue; } r -= I_IN;
        if (r < I_OUT) { p0_transpose_item(A.in[I_WOUT], DM, DM, DM, (bf16*)(ws + WS_WOUT), scr, r, lane, MapId(), true); continue; } r -= I_OUT;
        if (r < I_FI) { p0_transpose_item(A.in[I_WFI], DM, 2 * DFF, 2 * DFF, (bf16*)(ws + WS_WFI), scr, r, lane, MapFfn(), true, A.in[I_NFPRE]); continue; } r -= I_FI;
        if (r < I_FO) { p0_transpose_item(A.in[I_WFO], DFF, DM, DM, (bf16*)(ws + WS_WFO), scr, r, lane, MapId(), true); continue; } r -= I_FO;
        if (r < I_PL) { p0_transpose_item(A.in[I_WPLE], PLE_D, DM, DM, (bf16*)(ws + WS_WPLE), scr, r, lane, MapId(), true); continue; } r -= I_PL;
        if (r < I_GT) { p0_transpose_item(A.in[I_WGATE], DM, DM, DM, (bf16*)(ws + WS_WG), scr, r, lane, MapId(), true); continue; } r -= I_GT;
        if (r < I_1K) { p0_transpose_item(A.in[I_W1K], 3072, 96, 96, (bf16*)(ws + WS_W1K), scr, r, lane, MapId(), false); continue; } r -= I_1K;
        p0_transpose_item(A.in[I_W1V], 2048, 64, 64, (bf16*)(ws + WS_W1V), scr, r, lane, MapId(), false);
    }
    { const int gt = (C.vcu * NWAVES + C.wave) * 64 + lane, NGT = NGW * 64;
      for (int i = gt; i < 96 * 96; i += NGT) { const int n = i / 96, k = i % 96; ((bf16*)(ws + WS_W2K))[i] = (bf16)(pk2(A.in[I_W2K][k * 96 + n], 0.f) & 0xffffu); }
      for (int i = gt; i < 64 * 64; i += NGT) { const int n = i / 64, k = i % 64; ((bf16*)(ws + WS_W2V))[i] = (bf16)(pk2(A.in[I_W2V][k * 64 + n], 0.f) & 0xffffu); } }
    { constexpr int W0 = (NITEMS % (256 * NWAVES)) + 640 <= 256 * NWAVES ? NITEMS % (256 * NWAVES) : 0;
      const int o4 = gw - W0;
      if (o4 >= 0 && o4 < 640) {
        const int o = o4 >> 2, sl = o4 & 3; const bool isk = o < 96; const int j = isk ? o : o - 96, J = isk ? 96 : 64, KQ = isk ? 768 : 512;
        const GAS float* pe = (const GAS float*)A.in[isk ? I_PEK : I_PEV] + sl * KQ; const GAS float* w1 = (const GAS float*)A.in[isk ? I_W1K : I_W1V] + (size_t)sl * KQ * J;
        float s = 0.f;
#pragma unroll 4
        for (int k = lane; k < KQ; k += 64) s += pe[k] * w1[(size_t)k * J + j];
        s = wave_sum(s);
        if (lane == 0) ((GAS float*)(ws + (isk ? WS_C1K : WS_C1V)))[4 * j + sl] = s;
      } }
    bf16* H = (bf16*)((unsigned char*)A.out + OUT_H); bf16* PB = (bf16*)((unsigned char*)A.out + OUT_PBF);
    { f32x4 gg[4];
#pragma unroll
      for (int j = 0; j < 4; ++j) gg[j] = *((const GAS f32x4*)A.in[I_NMPRE] + lane + 64 * j);
      static_assert(M_TOK % (4 * 256 * NWAVES) == 0, "four rows per wave per step");
      for (int m = gw; m < M_TOK; m += 4 * NGW) rms_rows_to_bf16<4>(A.in[I_X], A.in[I_P], gg, H, PB, m, NGW, lane); }
}


__device__ __forceinline__ int crow(int r, int hi) { return (r & 3) + 8 * (r >> 2) + 4 * hi; }
template <int DD, int NJT>
__device__ __forceinline__ void cmp_unit(const Ctx& C, const bf16* src, const bf16* w1t, const bf16* w2t, const float* c1, bf16* dst, int bg, int nt) {
    constexpr int J = DD, KK = 32 * DD, HS = J + 8;
    const int lane = C.lane, w = C.wave, r32 = lane & 31, hi = lane >> 5;
    const int b = bg >> 1, g = bg & 1, n0 = 32 * nt;
    LAS float* red = (LAS float*)C.lds;
    LAS bf16* hidg = (LAS bf16*)(C.lds + 8 * 32 * J * 4);
    f32x16 acc[NJT];
#pragma unroll
    for (int jt = 0; jt < NJT; ++jt) acc[jt] = f32x16{};
    const int n = n0 + r32;
#pragma unroll 1
    for (int li = 0; li < 4; ++li) {
        const int l = 4 * w + li;
        int tok = 16 * n + l; tok = tok < SEQ ? tok : SEQ - 1;
        const bf16* ap = src + ((size_t)(b * SEQ + tok)) * (2 * DD) + g * DD + hi * 8;
        const bf16* bp = w1t + (size_t)r32 * KK + l * DD + hi * 8;
#pragma unroll
        for (int s = 0; s < DD / 16; ++s) {
            const bf16x8 af = *(const bf16x8*)(ap + 16 * s);
#pragma unroll
            for (int jt = 0; jt < NJT; ++jt) { const bf16x8 bfr = *(const bf16x8*)(bp + (size_t)(32 * jt) * KK + 16 * s);
                acc[jt] = __builtin_amdgcn_mfma_f32_32x32x16_bf16(af, bfr, acc[jt], 0, 0, 0); }
        }
    }
#pragma unroll
    for (int jt = 0; jt < NJT; ++jt)
#pragma unroll
        for (int r = 0; r < 16; ++r) red[(w * 32 + crow(r, hi)) * J + 32 * jt + r32] = acc[jt][r];
    __syncthreads();
    for (int e = C.tid; e < 32 * J; e += NWAVES * 64) { const int nn = e / J, j = e % J; const f32x4 c4 = *(const GAS f32x4*)(c1 + 4 * j); float s = (c4.x + c4.y) + (c4.z + c4.w);
#pragma unroll
        for (int ww = 0; ww < 8; ++ww) s += red[(ww * 32 + nn) * J + j];
        const float u = 0.7978845608028654f * (s + 0.044715f * s * s * s);
        const float th = 1.f - 2.f * __builtin_amdgcn_rcpf(1.f + ex2(2.f * LOG2E * u));
        hidg[nn * HS + j] = (bf16)(pk2(0.5f * s * (1.f + th), 0.f) & 0xffffu); }
    __syncthreads();
    if (w < NJT) {
        f32x16 a2 = f32x16{};
#pragma unroll
        for (int s = 0; s < J / 16; ++s) { const bf16x8 af = *(const LAS bf16x8*)(hidg + r32 * HS + 16 * s + 8 * hi); const bf16x8 bfr = *(const bf16x8*)(w2t + (size_t)(32 * w + r32) * J + 16 * s + 8 * hi);
            a2 = __builtin_amdgcn_mfma_f32_32x32x16_bf16(af, bfr, a2, 0, 0, 0); }
#pragma unroll
        for (int r = 0; r < 16; ++r) { const int nn = n0 + crow(r, hi); dst[((size_t)bg * 256 + nn) * J + 32 * w + r32] = (bf16)(pk2(nn < 255 ? a2[r] : 0.f, 0.f) & 0xffffu); }
    }
    __syncthreads();
}
__device__ __forceinline__ void p2_compress(const Ctx& C, const Args& A) {
    unsigned char* ws = A.ws;
#if defined(DBG_CMP_ZERO)
    { v4u z = v4u{0u, 0u, 0u, 0u}; v4u* o = (v4u*)(ws + WS_KCMP);
      for (size_t i = (size_t)C.vcu * 512 + C.tid; i < (size_t)(WS_SSP - WS_KCMP) / 16; i += (size_t)C.G * 512) o[i] = z; }
    return;
#endif
    for (int u = C.vcu; u < 512; u += C.G) {
        const int idx = u & 255, bg = idx >> 3, nt = idx & 7;
        if (u < 256) cmp_unit<96, 3>(C, (const bf16*)(ws + WS_KC), (const bf16*)(ws + WS_W1K), (const bf16*)(ws + WS_W2K), (const float*)(ws + WS_C1K), (bf16*)(ws + WS_KCMP), bg, nt);
        else         cmp_unit<64, 2>(C, (const bf16*)(ws + WS_VC), (const bf16*)(ws + WS_W1V), (const bf16*)(ws + WS_W2V), (const float*)(ws + WS_C1V), (bf16*)(ws + WS_VCMP), bg, nt);
    }
}


constexpr int NSA_KSTR = 208;
constexpr int NSA_KB = 64 * NSA_KSTR;
constexpr int NSA_K0 = 0, NSA_K1 = NSA_KB, NSA_V0 = 2 * NSA_KB, NSA_V1 = NSA_V0 + 8192, NSA_IMPG = NSA_V1 + 8192, NSA_IMPL = NSA_IMPG + 64 * 32 * 4, NSA_WM = NSA_IMPL + 65 * 32 * 4, NSA_END = NSA_WM + 64, NSA_OUT = 61440, NSA_OUT_END = NSA_OUT + 8 * 10240, NSA_IMPS_END = NSA_OUT_END;
static_assert(NSA_END <= NSA_OUT && NSA_IMPS_END <= LDSCTL_OFF && NSA_OUT_END <= LDSCTL_OFF && (NSA_WM % 16) == 0, "NSA LDS map");
constexpr float NEGBIG = -1e30f, M_INIT = -5e29f;

constexpr float NSA_THR = 8.f;
template <int MODE, bool SEL, bool IMPS = false>
__device__ __forceinline__ void nsa_branch(const Ctx& C, const GAS bf16* Kg, int kp, const GAS bf16* Vg, int vp, unsigned long long tilemask,
                                           const bf16x8 (&qf)[6], float& mref, bool& has, float& l, f32x16& o0, f32x16& o1,
                                           int t, int lo, int hq, bool lane_en, unsigned long long selmask, unsigned long long wavemask,
                                           int wlo, int whi, int wlo_in, int whi_in, float slope2, int ka, int kb, float invl, int qi) {
    constexpr bool LOADV = (MODE == 0);
    const int tid = C.tid, lane = C.lane, r32 = lane & 31, hi = lane >> 5;
    LAS char* lds = (LAS char*)C.lds;
    const int wv_ = C.wave;
    const int kc_a = wv_ * 64 + lane, kc_b = kc_a + 512;
    const bool kv_a = (kc_a % 13) < 12, kv_b = (wv_ + 8 < 13) && (kc_b % 13) < 12;
    const int ko_a = (kc_a / 13) * kp * 2 + (kc_a % 13) * 16, ko_b = (kc_b / 13) * kp * 2 + (kc_b % 13) * 16;
    const int vo_ = wv_ * 1024 + lane * 16;
    const int vo_g = ((vo_ & 4095) >> 6) * vp * 2 + ((vo_ >> 12) * 4 + ((vo_ & 63) >> 4)) * 16;
    const __amdgpu_buffer_rsrc_t rsK = __builtin_amdgcn_make_buffer_rsrc((void*)Kg, 0, 0x7fffffff, 0x00020000), rsV = __builtin_amdgcn_make_buffer_rsrc((void*)Vg, 0, 0x7fffffff, 0x00020000);
#define NSA_DMA(bb, jj) do { const int ks_ = 64 * (jj) * kp * 2, vs_ = 64 * (jj) * vp * 2; \
        if (kv_a) __builtin_amdgcn_raw_ptr_buffer_load_lds(rsK, (LAS unsigned*)(lds + ((bb) ? NSA_K1 : NSA_K0) + wv_ * 1024), 16, ko_a, ks_, 0, 0); \
        if (kv_b) __builtin_amdgcn_raw_ptr_buffer_load_lds(rsK, (LAS unsigned*)(lds + ((bb) ? NSA_K1 : NSA_K0) + (wv_ + 8) * 1024), 16, ko_b, ks_, 0, 0); \
        if (LOADV) __builtin_amdgcn_raw_ptr_buffer_load_lds(rsV, (LAS unsigned*)(lds + ((bb) ? NSA_V1 : NSA_V0) + wv_ * 1024), 16, vo_g, vs_, 0, 0); } while (0)
#define NSA_DMA_WAIT() asm volatile("s_waitcnt vmcnt(0)" ::: "memory")
#define NSA_TOPBIT(x) (63 - __builtin_clzll(x))
    unsigned long long rem = tilemask;
    if (rem == 0ull) return;
    int j = NSA_TOPBIT(rem); rem &= ~(1ull << j);
    NSA_DMA(0, j); NSA_DMA_WAIT(); __syncthreads();
    int buf = 0;
    const float sa = slope2 * (float)ka;
    const unsigned span = (unsigned)(hq - lo);
    for (;;) {
        const bool more = rem != 0ull; int jn = 0;
        if (more) { jn = NSA_TOPBIT(rem); rem &= ~(1ull << jn); NSA_DMA(buf ^ 1, jn); }
        const bool wneed = SEL ? (((wavemask >> j) & 1ull) != 0ull) : true;
        if (wneed) {
            const bool en = lane_en && (SEL ? (((selmask >> j) & 1ull) != 0ull) : true);
            const bool do1 = (64 * j + 32 <= whi) && (64 * j + 63 >= wlo), do0 = (64 * j <= whi) && (64 * j + 31 >= wlo);
            const LAS char* kt_ = lds + (buf ? NSA_K1 : NSA_K0) + r32 * NSA_KSTR + hi * 16;
            const LAS char* vt_ = lds + (buf ? NSA_V1 : NSA_V0) + ((lane >> 4) & 1) * 32 + (lane & 3) * 8 + (4 * hi + ((lane & 15) >> 2)) * 64;
            bf16x8 kfA[6], kfB[6]; s16x4 vA[8], vB[8];
            if (do1) {
#pragma unroll
                for (int s = 0; s < 6; ++s) kfA[s] = *(const LAS bf16x8*)(kt_ + 32 * NSA_KSTR + 32 * s);
                if (MODE == 0) {
#pragma unroll
                    for (int q = 0; q < 4; ++q) { vA[2 * q] = trrd(vt_ + 2048 + (q >> 1) * 4096 + (q & 1) * 1024); vA[2 * q + 1] = trrd(vt_ + 2048 + (q >> 1) * 4096 + (q & 1) * 1024 + 512); }
                }
            }
            if (do0) {
#pragma unroll
                for (int s = 0; s < 6; ++s) kfB[s] = *(const LAS bf16x8*)(kt_ + 32 * s);
                if (MODE == 0) {
#pragma unroll
                    for (int q = 0; q < 4; ++q) { vB[2 * q] = trrd(vt_ + (q >> 1) * 4096 + (q & 1) * 1024); vB[2 * q + 1] = trrd(vt_ + (q >> 1) * 4096 + (q & 1) * 1024 + 512); }
                }
            }
#pragma unroll
            for (int sb = 0; sb < 2; ++sb) {
                const int sub = 1 - sb;
                const int i0 = 64 * j + 32 * sub;
                if (sub ? do1 : do0) {
                    const int ib = i0 + 4 * hi;
                    const float bias0 = en ? (-slope2 * (float)(t - (ka * ib + kb)) - mref) : NEGBIG;
                    f32x16 p;
                    if (i0 >= wlo_in && i0 + 31 <= whi_in) {
#pragma unroll
                        for (int r = 0; r < 16; ++r) { const int ci = (r & 3) + 8 * (r >> 2); p[r] = bias0 + sa * (float)ci; }
                    } else {
#pragma unroll
                        for (int r = 0; r < 16; ++r) { const int ci = (r & 3) + 8 * (r >> 2); const bool v = ((unsigned)(ib + ci - lo) <= span); p[r] = v ? (bias0 + sa * (float)ci) : NEGBIG; }
                    }
#pragma unroll
                    for (int s = 0; s < 6; ++s) p = __builtin_amdgcn_mfma_f32_32x32x16_bf16(sub ? kfA[s] : kfB[s], qf[s], p, 0, 0, 0);
                    if (MODE == 0) {
                        float mx = __builtin_fmaxf(__builtin_fmaxf(p[0], p[1]), p[2]);
#pragma unroll
                        for (int r = 3; r < 15; r += 2) mx = __builtin_fmaxf(__builtin_fmaxf(mx, p[r]), p[r + 1]);
                        mx = __builtin_fmaxf(mx, p[15]);
                        { auto rr = __builtin_amdgcn_permlane32_swap(__float_as_uint(mx), __float_as_uint(mx), false, false); mx = __builtin_fmaxf(__uint_as_float(rr[0]), __uint_as_float(rr[1])); }
                        const bool valid = mx > -1e29f;
                        const bool mv = valid && (!has || mx > NSA_THR);
                        if (__any(mv)) {
                            const float delta = mv ? mx : 0.f, f = (mv && has) ? ex2(-delta) : 1.f;
                            mref += delta; has = has || valid;
#pragma unroll
                            for (int r = 0; r < 16; ++r) p[r] -= delta;
                            l *= f; o0 = o0 * f; o1 = o1 * f;
                        }
#pragma unroll
                        for (int r = 0; r < 16; ++r) p[r] = ex2(p[r]);
                        const float g0_ = (p[0] + p[1]) + (p[2] + p[3]), g1_ = (p[4] + p[5]) + (p[6] + p[7]), g2_ = (p[8] + p[9]) + (p[10] + p[11]), g3_ = (p[12] + p[13]) + (p[14] + p[15]);
                        l += (g0_ + g1_) + (g2_ + g3_);
                        v4u w0, w1; w0.x = pk2(p[0], p[1]); w0.y = pk2(p[2], p[3]); w0.z = pk2(p[4], p[5]); w0.w = pk2(p[6], p[7]);
                        w1.x = pk2(p[8], p[9]); w1.y = pk2(p[10], p[11]); w1.z = pk2(p[12], p[13]); w1.w = pk2(p[14], p[15]);
                        const bf16x8 pa0 = __builtin_bit_cast(bf16x8, w0), pa1 = __builtin_bit_cast(bf16x8, w1);
                        if (IMPS) {
                            LAS unsigned* ip = (LAS unsigned*)(lds + NSA_OUT + ((C.wave * 8 + (i0 >> 5)) * 320 + lane) * 4);
                            ip[0] = pk2(g0_, g1_); ip[64] = pk2(g2_, g3_); ip[128] = __builtin_amdgcn_perm(w0.w, w0.y, 0x07060302u); ip[192] = __builtin_amdgcn_perm(w1.w, w1.y, 0x07060302u); ip[256] = __float_as_uint(mref); }
                        if (sub) {
                            o0 = __builtin_amdgcn_mfma_f32_32x32x16_bf16(MK8(vA[0], vA[1]), pa0, o0, 0, 0, 0); o1 = __builtin_amdgcn_mfma_f32_32x32x16_bf16(MK8(vA[4], vA[5]), pa0, o1, 0, 0, 0);
                            o0 = __builtin_amdgcn_mfma_f32_32x32x16_bf16(MK8(vA[2], vA[3]), pa1, o0, 0, 0, 0); o1 = __builtin_amdgcn_mfma_f32_32x32x16_bf16(MK8(vA[6], vA[7]), pa1, o1, 0, 0, 0);
                        } else {
                            o0 = __builtin_amdgcn_mfma_f32_32x32x16_bf16(MK8(vB[0], vB[1]), pa0, o0, 0, 0, 0); o1 = __builtin_amdgcn_mfma_f32_32x32x16_bf16(MK8(vB[4], vB[5]), pa0, o1, 0, 0, 0);
                            o0 = __builtin_amdgcn_mfma_f32_32x32x16_bf16(MK8(vB[2], vB[3]), pa1, o0, 0, 0, 0); o1 = __builtin_amdgcn_mfma_f32_32x32x16_bf16(MK8(vB[6], vB[7]), pa1, o1, 0, 0, 0);
                        }
                    } else {
                        LAS float* impG = (LAS float*)(lds + NSA_IMPG); LAS float* impL = (LAS float*)(lds + NSA_IMPL);
#pragma unroll
                        for (int r = 0; r < 16; ++r) p[r] = ex2(p[r]);
#pragma unroll
                        for (int k = 0; k < 4; ++k) { float G = ((p[4 * k] + p[4 * k + 1]) + (p[4 * k + 2] + p[4 * k + 3])) * invl, L = p[4 * k + 3] * invl;
                            G += __shfl_xor(G, 1); L += __shfl_xor(L, 1); G += __shfl_xor(G, 2); L += __shfl_xor(L, 2); G += __shfl_xor(G, 4); L += __shfl_xor(L, 4);
                            if ((r32 & 7) == 0) { const int jb = (i0 >> 2) + 2 * k + hi; impG[jb * 32 + qi] = G; impL[(jb + 1) * 32 + qi] = L; } }
                    }
                }
            }
        }
        NSA_DMA_WAIT();
        __syncthreads();
        if (!more) break;
        j = jn; buf ^= 1;
    }
#undef NSA_DMA
#undef NSA_DMA_WAIT
#undef NSA_TOPBIT
}

__device__ __forceinline__ void nsa_unit(const Ctx& C, const Args& A, int b, int g, int c) {
    unsigned long long wsu = (unsigned long long)A.ws, outu = (unsigned long long)A.out;
    asm volatile("" : "+s"(wsu), "+s"(outu));
    const GAS unsigned char* ws = (const GAS unsigned char*)wsu; GAS unsigned char* outb = (GAS unsigned char*)outu;
    const int tid = C.tid, lane = C.lane, w = C.wave, r32 = lane & 31, hi = lane >> 5, q4 = r32 >> 3, hh = r32 & 7;
    LAS char* lds = (LAS char*)C.lds;
    const int qi = 4 * w + q4, t = 32 * c + qi, head = g * 8 + hh;
    const size_t row = (size_t)b * SEQ + t;
    const float slope2 = ex2(-0.5f * (float)(head + 1)) * LOG2E;
    const int tmin = 32 * c + 4 * w, tmax = tmin + 3;
    for (int i = tid; i < (64 + 65) * 32; i += NWAVES * 64) ((LAS float*)(lds + NSA_IMPG))[i] = 0.f;
    bf16x8 qf[6];
    { const GAS bf16* qp = (const GAS bf16*)(ws + WS_NQ) + row * 1536 + head * 96 + hi * 8;
#pragma unroll
      for (int s = 0; s < 6; ++s) qf[s] = *(const GAS bf16x8*)(qp + 16 * s); }
    const GAS bf16* ng = (const GAS bf16*)(ws + WS_NG) + row * 48;
    const float g_c = sigm(bf1(ng[head])), g_s = sigm(bf1(ng[16 + head])), g_w = sigm(bf1(ng[32 + head]));
    LAS float* ost = (LAS float*)(lds + NSA_OUT) + w * 2560 + lane;
    const size_t bg = (size_t)(b * 2 + g);
    __syncthreads();
    const int nmax = (t - 31) >> 4;
    const int wnmax = (tmax - 31) >> 4;
    const unsigned long long cmask = (2ull << ((2 * c) >> 6)) - 1ull;
    float m_c = 0.f, l_c = 0.f, invl_c; bool has_c = false;
    const int wnmin = (tmin - 31) >> 4;
    {
        f32x16 o0 = f32x16{}, o1 = f32x16{};
        nsa_branch<0, false, true>(C, (const GAS bf16*)(ws + WS_KCMP) + bg * 256 * 96, 96, (const GAS bf16*)(ws + WS_VCMP) + bg * 256 * 64, 64, cmask, qf, m_c, has_c, l_c, o0, o1,
                             t, 0, nmax, nmax >= 0, 0ull, 0ull, 0, wnmax, 0, wnmin, slope2, 16, 31, 0.f, qi);
        { auto rr = __builtin_amdgcn_permlane32_swap(__float_as_uint(l_c), __float_as_uint(l_c), false, false); l_c = __uint_as_float(rr[0]) + __uint_as_float(rr[1]); }
        invl_c = l_c > 0.f ? __builtin_amdgcn_rcpf(l_c) : 0.f;
        { LAS float* impG = (LAS float*)(lds + NSA_IMPG); LAS float* impL = (LAS float*)(lds + NSA_IMPL);
          const int nslot = wnmax >= 0 ? (wnmax >> 5) + 1 : 0;
          for (int slot = 0; slot < nslot; ++slot) {
              const LAS unsigned* ip = (const LAS unsigned*)(lds + NSA_OUT + ((w * 8 + slot) * 320 + lane) * 4);
              const unsigned g01 = ip[0], g23 = ip[64], l01 = ip[128], l23 = ip[192];
              const float scl = ex2(__builtin_fminf(__uint_as_float(ip[256]) - m_c, 0.f)) * invl_c;
              const float Gv[4] = {bflo(g01), bfhi(g01), bflo(g23), bfhi(g23)}, Lv[4] = {bflo(l01), bfhi(l01), bflo(l23), bfhi(l23)};
#pragma unroll
              for (int k = 0; k < 4; ++k) { float G = Gv[k] * scl, L = Lv[k] * scl;
                  G += __shfl_xor(G, 1); L += __shfl_xor(L, 1); G += __shfl_xor(G, 2); L += __shfl_xor(L, 2); G += __shfl_xor(G, 4); L += __shfl_xor(L, 4);
                  if ((r32 & 7) == 0) { const int jb = 8 * slot + 2 * k + hi; impG[jb * 32 + qi] = G; impL[(jb + 1) * 32 + qi] = L; } } } }
        const float sc = g_c * invl_c;
#pragma unroll
        for (int r = 0; r < 16; ++r) { ost[64 * r] = o0[r] * sc; ost[64 * (16 + r)] = o1[r] * sc; }
    }
    unsigned long long mymask = 0ull, wmask = 0ull;
    {
        const LAS float* impG = (const LAS float*)(lds + NSA_IMPG); const LAS float* impL = (const LAS float*)(lds + NSA_IMPL);
#pragma unroll
        for (int qq = 0; qq < 4; ++qq) {
            const int qx = 4 * w + qq, tq = 32 * c + qx, cur = tq >> 6, jj = lane;
            const float imp = impG[jj * 32 + qx] + impL[jj * 32 + qx];
            const bool forced = (jj == 0) | (jj == cur) | (jj == cur - 1);
            const int key = forced ? (0x7f000000 | (63 - jj)) : (jj <= cur ? ((__float_as_int(imp) & ~63) | (63 - jj)) : (-1 - jj));
            int rank = 0;
#pragma unroll
            for (int i = 0; i < 64; ++i) { const int ki = __builtin_amdgcn_readlane(key, i); rank += (ki > key) ? 1 : 0; }
            const unsigned long long sm = __ballot(rank < 16);
            wmask |= sm; if (q4 == qq) mymask = sm;
        }
        if (lane == 0) *(LAS unsigned long long*)(lds + NSA_WM + 8 * w) = wmask;
    }
    __syncthreads();
    unsigned long long umask = 0ull;
#pragma unroll
    for (int i = 0; i < 8; ++i) umask |= *(const LAS unsigned long long*)(lds + NSA_WM + 8 * i);
    const int curmax = (32 * c + 31) >> 6;
    umask &= (2ull << curmax) - 1ull;
    { const unsigned ulo = __builtin_amdgcn_readfirstlane((unsigned)umask), uhi = __builtin_amdgcn_readfirstlane((unsigned)(umask >> 32)); umask = ((unsigned long long)uhi << 32) | ulo; }
    { const unsigned wlo_ = __builtin_amdgcn_readfirstlane((unsigned)wmask), whi_ = __builtin_amdgcn_readfirstlane((unsigned)(wmask >> 32)); wmask = ((unsigned long long)whi_ << 32) | wlo_; }
    {
        float m_s = 0.f, l_s = 0.f; bool has_s = false; f32x16 o0 = f32x16{}, o1 = f32x16{};
        nsa_branch<0, true>(C, (const GAS bf16*)(ws + WS_KS) + ((size_t)b * SEQ) * 192 + g * 96, 192, (const GAS bf16*)(ws + WS_VS) + ((size_t)b * SEQ) * 128 + g * 64, 128, umask, qf, m_s, has_s, l_s, o0, o1,
                            t, 0, t, true, mymask, wmask, 0, tmax, 0, tmin, slope2, 1, 0, 0.f, qi);
        { auto rr = __builtin_amdgcn_permlane32_swap(__float_as_uint(l_s), __float_as_uint(l_s), false, false); l_s = __uint_as_float(rr[0]) + __uint_as_float(rr[1]); }
        const float sc = g_s * (l_s > 0.f ? __builtin_amdgcn_rcpf(l_s) : 0.f);
#pragma unroll
        for (int r = 0; r < 16; ++r) { ost[64 * r] += o0[r] * sc; ost[64 * (16 + r)] += o1[r] * sc; }
    }
    {
        const int plo = 32 * c - 511 > 0 ? 32 * c - 511 : 0;
        const int jlo = plo >> 6, jhi = (32 * c + 31) >> 6;
        const unsigned long long wm_ = ((2ull << jhi) - 1ull) & ~((1ull << jlo) - 1ull);
        float m_w = 0.f, l_w = 0.f; bool has_w = false; f32x16 o0 = f32x16{}, o1 = f32x16{};
        nsa_branch<0, false>(C, (const GAS bf16*)(ws + WS_KW) + ((size_t)b * SEQ) * 192 + g * 96, 192, (const GAS bf16*)(ws + WS_VW) + ((size_t)b * SEQ) * 128 + g * 64, 128, wm_, qf, m_w, has_w, l_w, o0, o1,
                             t, t - 511, t, true, 0ull, 0ull, tmin - 511, tmax, tmax - 511, tmin, slope2, 1, 0, 0.f, qi);
        { auto rr = __builtin_amdgcn_permlane32_swap(__float_as_uint(l_w), __float_as_uint(l_w), false, false); l_w = __uint_as_float(rr[0]) + __uint_as_float(rr[1]); }
        const float sc = g_w * (l_w > 0.f ? __builtin_amdgcn_rcpf(l_w) : 0.f);
        f32x16 out0, out1;
#pragma unroll
        for (int r = 0; r < 16; ++r) { out0[r] = ost[64 * r] + o0[r] * sc; out1[r] = ost[64 * (16 + r)] + o1[r] * sc; }
        LAS char* ot = lds + NSA_K0 + w * 4096;
#pragma unroll
        for (int k = 0; k < 4; ++k) { v2u w0; w0.x = pk2(out0[4 * k], out0[4 * k + 1]); w0.y = pk2(out0[4 * k + 2], out0[4 * k + 3]); *(LAS v2u*)(ot + q4 * 1024 + hh * 128 + (8 * k + 4 * hi) * 2) = w0;
            v2u w1; w1.x = pk2(out1[4 * k], out1[4 * k + 1]); w1.y = pk2(out1[4 * k + 2], out1[4 * k + 3]); *(LAS v2u*)(ot + q4 * 1024 + hh * 128 + (32 + 8 * k + 4 * hi) * 2) = w1; }
        GAS unsigned char* ob = outb + OUT_NSA + ((size_t)b * SEQ + 32 * c + 4 * w) * 2048 + g * 1024;
#pragma unroll
        for (int i = 0; i < 4; ++i) { const v4u v = *(const LAS v4u*)(ot + i * 1024 + lane * 16); *(GAS v4u*)(ob + (size_t)i * 2048 + lane * 16) = v; }
    }
}
__device__ __forceinline__ void p3_nsa(const Ctx& C, const Args& A) {
#if defined(DBG_COPY_OFF)
    { const bf16* src = (const bf16*)(A.ws + (size_t)DBG_COPY_OFF * MiB); bf16* o = (bf16*)((unsigned char*)A.out + OUT_NSA);
      for (size_t i = (size_t)C.vcu * 512 + C.tid; i < (size_t)M_TOK * 1024; i += (size_t)C.G * 512) { const size_t r = (i >> 10) & DBG_COPY_RMASK, c = i & 1023; o[i] = src[r * DBG_COPY_LD + (c % DBG_COPY_LD)]; } }
    return;
#endif
#if defined(DBG_NSA_ZERO)
    { v4u z = v4u{0u, 0u, 0u, 0u}; v4u* o = (v4u*)((unsigned char*)A.out + OUT_NSA);
      for (size_t i = (size_t)C.vcu * 512 + C.tid; i < (size_t)M_TOK * 1024 * 2 / 16; i += (size_t)C.G * 512) o[i] = z; }
    return;
#endif
    for (int u = C.vcu; u < 4096; u += C.G) {
        const int bg = (u & 255) >> 3, c = (u & 7) + 8 * (u >> 8);
        nsa_unit(C, A, bg >> 1, bg & 1, c);
    }
}


constexpr int RT_KZ = 0, RT_KZS = 144, RT_V = 128 * RT_KZS, RT_R = RT_V + 32768, RT_Y = RT_R + 128 * RT_KZS, RT_YS = 528, RT_END = RT_Y + 8 * 16 * RT_YS;
static_assert(RT_END <= LDSCTL_OFF, "retention LDS map");
typedef float f32x4v __attribute__((ext_vector_type(4)));
#ifndef RT_SPLIT
#define RT_SPLIT 18
#endif
#define RT_BAR() asm volatile("s_waitcnt lgkmcnt(0)\n\ts_barrier" ::: "memory")

__device__ __forceinline__ void ret_unit(const Ctx& C, const Args& A, int b, int h, int seg) {
    unsigned char* ws = A.ws;
    const int tid = C.tid, lane = C.lane, w = C.wave, i_in = lane & 15, fq = lane >> 4;
    LAS char* lds = (LAS char*)C.lds;
    const float eps_g = ex2(-5.f - (float)h);
    const float lg = -eps_g * (1.f + eps_g * (0.5f + eps_g * (0.33333334f + eps_g * (0.25f + eps_g * (0.2f + eps_g * 0.16666667f))))) * LOG2E;
    const float dec128 = ex2(128.f * lg);
    const int ic = 16 * w + i_in;
    const float gi = ex2((float)(ic - 127) * lg), xi = ex2((float)(ic + 1) * lg);
    unsigned long long wsu = (unsigned long long)ws, nsu = (unsigned long long)((const unsigned char*)A.out + OUT_NSA);
    const GAS bf16* wsb = (const GAS bf16*)wsu; const GAS bf16* nsb = (const GAS bf16*)nsu;
#define RT_OPAQUE() do { asm volatile("" : "+s"(wsu), "+s"(nsu)); wsb = (const GAS bf16*)wsu; nsb = (const GAS bf16*)nsu; } while (0)
    constexpr unsigned O_RQ = (unsigned)(WS_RQ / 2), O_RK = (unsigned)(WS_RK / 2), O_RV = (unsigned)(WS_RV / 2), O_RG = (unsigned)(WS_RG / 2), O_MG = (unsigned)(WS_MG / 2), O_MX = (unsigned)(WS_MIXIN / 2);
    const int ec = 8 * (lane & 15), er = lane >> 4;
    const f32x4 gnA = *(const f32x4*)(A.in[I_GNG] + h * 128 + ec), gnB = *(const f32x4*)(A.in[I_GNG] + h * 128 + ec + 4);
    f32x4v R[4];
#pragma unroll
    for (int dt = 0; dt < 4; ++dt) R[dt] = f32x4v{0.f, 0.f, 0.f, 0.f};
    const int tq = i_in >> 2, tp = i_in & 3;
    const int c_first = seg ? RT_SPLIT : 0, n_total = seg ? 32 : RT_SPLIT;
    if (c_first == 0) {
#pragma unroll
        for (int dt = 0; dt < 4; ++dt)
#pragma unroll
            for (int r = 0; r < 4; ++r) *(LAS bf16*)(lds + RT_R + (16 * w + 4 * fq + r) * RT_KZS + (16 * dt + i_in) * 2) = (bf16)0;
    }
    v4u sK[2], sV[4]; bf16x8 qn[2] = {bf16x8{}, bf16x8{}};
#define RT_LOADKV(chn) do { const unsigned T_ = (unsigned)(b * SEQ + (chn) * 128); \
        _Pragma("unroll") for (int i_ = 0; i_ < 2; ++i_) { const unsigned x_ = tid + 512 * i_; sK[i_] = *(const GAS v4u*)(wsb + (O_RK + (T_ + (x_ >> 3)) * 512u + h * 64 + (x_ & 7) * 8)); } \
        _Pragma("unroll") for (int i_ = 0; i_ < 4; ++i_) { const unsigned x_ = tid + 512 * i_; sV[i_] = *(const GAS v4u*)(wsb + (O_RV + (T_ + (x_ >> 4)) * 1024u + h * 128 + (x_ & 15) * 8)); } } while (0)
#define RT_LOADQ(chn) do { const unsigned qo_ = O_RQ + (unsigned)(b * SEQ + (chn) * 128 + ic) * 512u + h * 64 + 8 * fq; qn[0] = *(const GAS bf16x8*)(wsb + qo_); qn[1] = *(const GAS bf16x8*)(wsb + qo_ + 32); } while (0)
    RT_LOADKV(0); if (c_first == 0) RT_LOADQ(0);
#pragma unroll 1
    for (int ch = 0; ch < n_total; ++ch) {
        RT_OPAQUE();
        const bool full = ch >= c_first;
        const unsigned T0 = (unsigned)(b * SEQ + ch * 128);
#pragma unroll
        for (int i = 0; i < 2; ++i) { const int x = tid + 512 * i, rr = x >> 3, cc = x & 7; const v4u kv = sK[i];
            const float z = ex2((float)(127 - rr) * lg) * 0.125f;
            v4u o; o.x = pk2(bflo(kv.x) * z, bfhi(kv.x) * z); o.y = pk2(bflo(kv.y) * z, bfhi(kv.y) * z); o.z = pk2(bflo(kv.z) * z, bfhi(kv.z) * z); o.w = pk2(bflo(kv.w) * z, bfhi(kv.w) * z);
            *(LAS v4u*)(lds + RT_KZ + rr * RT_KZS + cc * 16) = o; }
#pragma unroll
        for (int i = 0; i < 4; ++i) { const int x = tid + 512 * i, rr = x >> 4, cc = x & 15;
            *(LAS v4u*)(lds + RT_V + (cc >> 1) * 4096 + rr * 32 + (cc & 1) * 16) = sV[i]; }
        const bf16x8 qf0 = qn[0], qf1 = qn[1];
        RT_BAR();
        if (ch + 1 < n_total) { RT_LOADKV(ch + 1); if (ch + 1 >= c_first) RT_LOADQ(ch + 1); }
        v4u eRG[4], eGA[4], eGB[4], eNS[4];
        if (full) {
#pragma unroll
            for (int k = 0; k < 4; ++k) { const unsigned rw = T0 + 16 * w + 4 * k + er; const unsigned e0 = h * 128 + ec;
                eRG[k] = *(const GAS v4u*)(wsb + (O_RG + rw * 1024u + e0)); eGA[k] = *(const GAS v4u*)(wsb + (O_MG + rw * 2048u + e0));
#if defined(RT_PROBE) && RT_PROBE == 2
                eGB[k] = *(const GAS v4u*)(wsb + (O_MG + rw * 2048u + 1024u + e0)); eNS[k] = *(const GAS v4u*)(nsb + (rw * 1024u + e0));
#endif
                }
        }
        if (full) {
            f32x4v acc[8];
#pragma unroll
            for (int et = 0; et < 8; ++et) { const LAS char* rp = lds + RT_R + (16 * et + i_in) * RT_KZS + fq * 16;
                f32x4v a = f32x4v{0.f, 0.f, 0.f, 0.f};
                a = __builtin_amdgcn_mfma_f32_16x16x32_bf16(*(const LAS bf16x8*)rp, qf0, a, 0, 0, 0);
                a = __builtin_amdgcn_mfma_f32_16x16x32_bf16(*(const LAS bf16x8*)(rp + 64), qf1, a, 0, 0, 0);
                acc[et] = a * xi; }
            bf16x8 pf[4];
#pragma unroll
            for (int a = 0; a < 4; ++a) {
                v4u pw = v4u{0u, 0u, 0u, 0u};
                if (2 * a <= w) {
#pragma unroll
                    for (int hf = 0; hf < 2; ++hf) { const int jt = 2 * a + hf;
                        if (jt <= w) { const LAS char* kp = lds + RT_KZ + (16 * jt + i_in) * RT_KZS + fq * 16;
                            f32x4v s = f32x4v{0.f, 0.f, 0.f, 0.f};
                            s = __builtin_amdgcn_mfma_f32_16x16x32_bf16(*(const LAS bf16x8*)kp, qf0, s, 0, 0, 0);
                            s = __builtin_amdgcn_mfma_f32_16x16x32_bf16(*(const LAS bf16x8*)(kp + 64), qf1, s, 0, 0, 0);
                            float pv[4];
#pragma unroll
                            for (int r = 0; r < 4; ++r) pv[r] = (jt < w || (4 * fq + r) <= i_in) ? s[r] * gi : 0.f;
                            if (hf == 0) { pw.x = pk2(pv[0], pv[1]); pw.y = pk2(pv[2], pv[3]); } else { pw.z = pk2(pv[0], pv[1]); pw.w = pk2(pv[2], pv[3]); } } }
                }
                pf[a] = __builtin_bit_cast(bf16x8, pw);
            }
#if !defined(RT_PROBE) || RT_PROBE != 2
#pragma unroll
            for (int k = 0; k < 4; ++k) { const unsigned rw = T0 + 16 * w + 4 * k + er; const unsigned e0 = h * 128 + ec;
                eGB[k] = *(const GAS v4u*)(wsb + (O_MG + rw * 2048u + 1024u + e0)); eNS[k] = *(const GAS v4u*)(nsb + (rw * 1024u + e0)); }
#endif
#pragma unroll
            for (int a = 0; a < 4; ++a) {
                if (2 * a <= w) {
#pragma unroll
                    for (int et = 0; et < 8; ++et) { const LAS char* vp = lds + RT_V + et * 4096 + (32 * a + 4 * fq + tq) * 32 + tp * 8;
                        const s16x4 lo_ = trrd(vp), hi_ = trrd(vp + 16 * 32);
                        acc[et] = __builtin_amdgcn_mfma_f32_16x16x32_bf16(MK8(lo_, hi_), pf[a], acc[et], 0, 0, 0); }
                }
            }
            float s1 = 0.f;
#pragma unroll
            for (int et = 0; et < 8; ++et) s1 += (acc[et][0] + acc[et][1]) + (acc[et][2] + acc[et][3]);
            s1 += __shfl_xor(s1, 16); s1 += __shfl_xor(s1, 32);
            const float mu = s1 * (1.f / 128.f);
            float s2 = 0.f;
#pragma unroll
            for (int et = 0; et < 8; ++et) { const f32x4v dlt = acc[et] - mu; s2 += (dlt[0] * dlt[0] + dlt[1] * dlt[1]) + (dlt[2] * dlt[2] + dlt[3] * dlt[3]); }
            s2 += __shfl_xor(s2, 16); s2 += __shfl_xor(s2, 32);
            const float rstd = __builtin_amdgcn_rsqf(s2 * (1.f / 128.f) + GN_EPS);
            LAS char* yw = lds + RT_Y + w * (16 * RT_YS);
#pragma unroll
            for (int et = 0; et < 8; ++et) *(LAS f32x4v*)(yw + i_in * RT_YS + (16 * et + 4 * fq) * 4) = (acc[et] - mu) * rstd;
            LDS_WAIT();
#pragma unroll
            for (int k = 0; k < 4; ++k) { const f32x4v ya = *(const LAS f32x4v*)(yw + (4 * k + er) * RT_YS + ec * 4), yb = *(const LAS f32x4v*)(yw + (4 * k + er) * RT_YS + ec * 4 + 16);
                const float yf_[8] = {ya[0], ya[1], ya[2], ya[3], yb[0], yb[1], yb[2], yb[3]};
                const unsigned rg_[4] = {eRG[k].x, eRG[k].y, eRG[k].z, eRG[k].w}, ga_[4] = {eGA[k].x, eGA[k].y, eGA[k].z, eGA[k].w};
                const unsigned gb_[4] = {eGB[k].x, eGB[k].y, eGB[k].z, eGB[k].w}, ns_[4] = {eNS[k].x, eNS[k].y, eNS[k].z, eNS[k].w};
                const float gn_[8] = {gnA.x, gnA.y, gnA.z, gnA.w, gnB.x, gnB.y, gnB.z, gnB.w};
                unsigned ow[4];
#pragma unroll
                for (int q = 0; q < 4; ++q) { float o2[2];
#pragma unroll
                    for (int hh = 0; hh < 2; ++hh) { const float y = yf_[2 * q + hh] * gn_[2 * q + hh], rg = hh ? bfhi(rg_[q]) : bflo(rg_[q]), ga = hh ? bfhi(ga_[q]) : bflo(ga_[q]);
                        const float gb = hh ? bfhi(gb_[q]) : bflo(gb_[q]), nsv = hh ? bfhi(ns_[q]) : bflo(ns_[q]);
                        const float den = (1.f + ex2(-rg * LOG2E)) * (1.f + ex2(-ga));
                        o2[hh] = rg * __builtin_amdgcn_rcpf(den) * y + __builtin_amdgcn_rcpf(1.f + ex2(-gb)) * nsv; }
                    ow[q] = pk2(o2[0], o2[1]); }
                v4u ov; ov.x = ow[0]; ov.y = ow[1]; ov.z = ow[2]; ov.w = ow[3];
                *(GAS v4u*)((GAS bf16*)wsb + (O_MX + (T0 + 16 * w + 4 * k + er) * 1024u + h * 128 + ec)) = ov; }
        }
#pragma unroll
        for (int dt = 0; dt < 4; ++dt) R[dt] = R[dt] * dec128;
#pragma unroll
        for (int a = 0; a < 4; ++a) { const LAS char* vp = lds + RT_V + w * 4096 + (32 * a + 4 * fq + tq) * 32 + tp * 8;
            const s16x4 vlo = trrd(vp), vhi = trrd(vp + 16 * 32); const bf16x8 vf = MK8(vlo, vhi);
#pragma unroll
            for (int dt = 0; dt < 4; ++dt) { const LAS char* kp = lds + RT_KZ + (32 * a + 4 * fq + tq) * RT_KZS + (16 * dt + 4 * tp) * 2;
                const s16x4 klo = trrd(kp), khi = trrd(kp + 16 * RT_KZS);
                R[dt] = __builtin_amdgcn_mfma_f32_16x16x32_bf16(vf, MK8(klo, khi), R[dt], 0, 0, 0); } }
        RT_BAR();
        if (ch + 1 >= c_first && ch + 1 < n_total) {
#pragma unroll
            for (int dt = 0; dt < 4; ++dt)
#pragma unroll
                for (int r = 0; r < 4; ++r) *(LAS bf16*)(lds + RT_R + (16 * w + 4 * fq + r) * RT_KZS + (16 * dt + i_in) * 2) = (bf16)(pk2(R[dt][r], 0.f) & 0xffffu);
        }
    }
    __syncthreads();
#undef RT_LOADKV
#undef RT_OPAQUE
#undef RT_LOADQ
}
__device__ __forceinline__ void p4_retention(const Ctx& C, const Args& A) {
    for (int u = C.vcu; u < 256; u += C.G) ret_unit(C, A, u >> 4, (u >> 1) & 7, u & 1);
}


template <bool XF32>
__device__ __forceinline__ void thin_phase(const Ctx& C, const void* xi, const bf16* add, const float* ssp, const float* g_post, bf16* xo, float* rso) {
    const int gw = C.vcu * NWAVES + C.wave, NGW = C.G * NWAVES, lane = C.lane;
    for (int m = gw; m < M_TOK; m += NGW) {
        const float sp = lane < 16 ? ssp[(size_t)m * 16 + lane] : 0.f;
        const float rs = __builtin_amdgcn_rsqf(wave_sum(sp) * (1.f / DM) + RMS_EPS);
        const GAS v2u* ar = (const GAS v2u*)(add + (size_t)m * DM) + lane; const GAS f32x4* gp = (const GAS f32x4*)g_post + lane;
        f32x4 v[4]; float s = 0.f;
#pragma unroll
        for (int j = 0; j < 4; ++j) { f32x4 x;
            if (XF32) x = ((const GAS f32x4*)((const float*)xi + (size_t)m * DM) + lane)[64 * j];
            else { const v2u xb = ((const GAS v2u*)((const bf16*)xi + (size_t)m * DM) + lane)[64 * j]; x = f32x4{bflo(xb.x), bfhi(xb.x), bflo(xb.y), bfhi(xb.y)}; }
            const f32x4 g = gp[64 * j]; const v2u a = ar[64 * j];
            v[j].x = x.x + bflo(a.x) * rs * g.x; v[j].y = x.y + bfhi(a.x) * rs * g.y; v[j].z = x.z + bflo(a.y) * rs * g.z; v[j].w = x.w + bfhi(a.y) * rs * g.w;
            s += (v[j].x * v[j].x + v[j].y * v[j].y) + (v[j].z * v[j].z + v[j].w * v[j].w); }
        GAS v2u* hw = (GAS v2u*)(xo + (size_t)m * DM) + lane;
#pragma unroll
        for (int j = 0; j < 4; ++j) { v2u w; w.x = pk2(v[j].x, v[j].y); w.y = pk2(v[j].z, v[j].w); hw[64 * j] = w; }
        const float r2 = __builtin_amdgcn_rsqf(wave_sum(s) * (1.f / DM) + RMS_EPS);
        if (lane == 0) rso[m] = r2;
    }
}

#define CAS __attribute__((address_space(4)))
__device__ __forceinline__ Args load_args() {
    Args a{};
#if defined(__HIP_DEVICE_COMPILE__)
    const CAS Args* p_ = (const CAS Args*)__builtin_amdgcn_kernarg_segment_ptr(); asm volatile("" : "+s"(p_));
#pragma unroll
    for (int i = 0; i < 19; ++i) a.in[i] = p_->in[i];
    a.out = p_->out; a.ws = p_->ws; a.ph_lo = p_->ph_lo; a.ph_hi = p_->ph_hi; a.li = p_->li; a.pad = 0;
#endif
    return a;
}
__global__ void __launch_bounds__(NWAVES * 64, 2) hyb_fwd(Args args) {
    extern __shared__ __attribute__((aligned(16))) unsigned char lds[];
#define MKCTX() Ctx C; C.lds = (LAS unsigned char*)lds; C.tid = threadIdx.x; C.lane = C.tid & 63; C.wave = __builtin_amdgcn_readfirstlane(C.tid >> 6); \
    C.G = gridDim.x; { const int bx_ = blockIdx.x; C.vcu = (C.G % 8 == 0) ? (bx_ % 8) * (C.G / 8) + bx_ / 8 : bx_; }
    volatile LAS unsigned* MISC = (volatile LAS unsigned*)((LAS unsigned char*)lds + MISC_OFF);
    gu32* ctl = (gu32*)(args.ws + WS_CTL);
    for (int u = threadIdx.x; u < (LDS_BYTES - LDSCTL_OFF) / 4; u += NWAVES * 64) ((LAS unsigned*)((LAS unsigned char*)lds + LDSCTL_OFF))[u] = 0u;
    __syncthreads();
    XcdBarrier bar; bar.bar = (unsigned*)(ctl + CW_BAR); bar.x = 0; bar.st = nullptr;
    if (N_LAUNCHES == 1) bar = xcd_barrier_post((unsigned*)(ctl + CW_BAR), MISC + 8);
    const int lo = args.ph_lo, hi = args.ph_hi;
#ifndef PH_REP
#define PH_REP 0
#endif
#ifndef PH_MASK
#define PH_MASK 0x7ff
#endif
#define IN(k) (((PH_MASK >> (k)) & 1) && lo <= (k) && (k) < hi)
#define SEAM(k) do { if (IN(k) && IN((k) + 1)) xcd_barrier(bar); } while (0)
#define LOAD_ARGS(Av) const Args Av = load_args(); unsigned char* ws = Av.ws; (void)ws

    if (IN(0)) { LOAD_ARGS(a); MKCTX(); LAS unsigned char* ring = C.lds; const int bx = (int)blockIdx.x; (void)ring; (void)bx; p0_prologue(C, a); if ((PH_REP >> 0) & 1) { __syncthreads(); p0_prologue(C, a); } }
    SEAM(0);
    if (IN(1)) { LOAD_ARGS(a); MKCTX(); LAS unsigned char* ring = C.lds; const int bx = (int)blockIdx.x; (void)ring; (void)bx;
        pg8::Gemm g{(const bf16*)((const unsigned char*)a.out + OUT_H), (const bf16*)(ws + WS_WIN), M_TOK, IN_VIRT, DM}; pg8::StaticOrder S; S.init(M_TOK, IN_VIRT, C.G, bx);
        pg8::EpiProj E{(bf16*)ws, ring, (unsigned char*)a.out + 160 * MiB};
#if defined(P1_STAGGER)
        for (int i = 0; i < ((bx >> 3) & 3) * P1_STAGGER; ++i) __builtin_amdgcn_s_sleep(127);
#endif
        pg8::gemm_phase<pg8::EpiProj, pg8::StaticOrder, true, true>(ring, g, S, E);
#if defined(GEMM_PROBE)
        { __syncthreads(); asm volatile("" ::: "memory"); __builtin_amdgcn_sched_barrier(0); pg8::EpiNone EN{ring}; pg8::gemm_phase<pg8::EpiNone, pg8::StaticOrder, true, true>(ring, g, S, EN); }
#else
        if ((PH_REP >> 1) & 1) { __syncthreads(); asm volatile("" ::: "memory"); __builtin_amdgcn_sched_barrier(0); pg8::gemm_phase<pg8::EpiProj, pg8::StaticOrder, true, true>(ring, g, S, E); }
#endif
    }
    SEAM(1);
    if (IN(2)) { LOAD_ARGS(a); MKCTX(); LAS unsigned char* ring = C.lds; const int bx = (int)blockIdx.x; (void)ring; (void)bx; p2_compress(C, a); if ((PH_REP >> 2) & 1) { __syncthreads(); p2_compress(C, a); } }
    SEAM(2);
    if (IN(3)) { LOAD_ARGS(a); MKCTX(); LAS unsigned char* ring = C.lds; const int bx = (int)blockIdx.x; (void)ring; (void)bx; p3_nsa(C, a); if ((PH_REP >> 3) & 1) { __syncthreads(); p3_nsa(C, a); } }
    SEAM(3);
    if (IN(4)) { LOAD_ARGS(a); MKCTX(); LAS unsigned char* ring = C.lds; const int bx = (int)blockIdx.x; (void)ring; (void)bx; p4_retention(C, a); if ((PH_REP >> 4) & 1) { __syncthreads(); p4_retention(C, a); } }
    SEAM(4);
    if (IN(5)) { LOAD_ARGS(a); MKCTX(); LAS unsigned char* ring = C.lds; const int bx = (int)blockIdx.x; (void)ring; (void)bx;
        { pg8::Gemm g{(const bf16*)(ws + WS_MIXIN), (const bf16*)(ws + WS_WOUT), M_TOK, DM, DM}; pg8::StaticOrder S; S.init(M_TOK, DM, C.G, bx);
          pg8::EpiSumsq E{(bf16*)(ws + WS_MIX), (float*)(ws + WS_SSP), ring};
          pg8::gemm_phase<pg8::EpiSumsq, pg8::StaticOrder, true, true>(ring, g, S, E); }
        __syncthreads(); asm volatile("" ::: "memory"); __builtin_amdgcn_sched_barrier(0);
        { pg8::Gemm g{(const bf16*)((const unsigned char*)a.out + OUT_PBF), (const bf16*)(ws + WS_WPLE), M_TOK, DM, PLE_D}; pg8::StaticOrder S; S.init(M_TOK, DM, C.G, bx);
          pg8::EpiPlain E{(bf16*)(ws + WS_PLEO), DM, ring};
          pg8::gemm_phase<pg8::EpiPlain, pg8::StaticOrder, true, true>(ring, g, S, E); }
    }
    SEAM(5);
    if (IN(6)) { LOAD_ARGS(a); MKCTX(); LAS unsigned char* ring = C.lds; const int bx = (int)blockIdx.x; (void)ring; (void)bx; thin_phase<true>(C, a.in[I_X], (const bf16*)(ws + WS_MIX), (const float*)(ws + WS_SSP), a.in[I_NMPOST], (bf16*)(ws + WS_H2), (float*)(ws + WS_RS2));
        if ((PH_REP >> 6) & 1) { __syncthreads(); thin_phase<true>(C, a.in[I_X], (const bf16*)(ws + WS_MIX), (const float*)(ws + WS_SSP), a.in[I_NMPOST], (bf16*)(ws + WS_H2), (float*)(ws + WS_RS2)); } }
    SEAM(6);
    if (IN(7)) { LOAD_ARGS(a); MKCTX(); LAS unsigned char* ring = C.lds; const int bx = (int)blockIdx.x; (void)ring; (void)bx;
        pg8::Gemm g{(const bf16*)(ws + WS_H2), (const bf16*)(ws + WS_WFI), M_TOK, 2 * DFF, DM}; pg8::StaticOrder S; S.init(M_TOK, 2 * DFF, C.G, bx);
        pg8::EpiSwiglu E{(bf16*)(ws + WS_ACT), (const float*)(ws + WS_RS2)};
        pg8::gemm_phase<pg8::EpiSwiglu, pg8::StaticOrder, true, true>(ring, g, S, E);
        if ((PH_REP >> 7) & 1) { __syncthreads(); asm volatile("" ::: "memory"); __builtin_amdgcn_sched_barrier(0); pg8::gemm_phase<pg8::EpiSwiglu, pg8::StaticOrder, true, true>(ring, g, S, E); }
    }
    SEAM(7);
    if (IN(8)) { LOAD_ARGS(a); MKCTX(); LAS unsigned char* ring = C.lds; const int bx = (int)blockIdx.x; (void)ring; (void)bx;
        pg8::Gemm g{(const bf16*)(ws + WS_ACT), (const bf16*)(ws + WS_WFO), M_TOK, DM, DFF}; pg8::StaticOrder S; S.init(M_TOK, DM, C.G, bx);
        pg8::EpiNormRes E{(bf16*)(ws + WS_H2), a.in[I_NFPOST], (float*)(ws + WS_SSP2), (unsigned*)(ws + WS_XBUF), (unsigned*)(ws + WS_CTL + CW_XCNT), ring};
        pg8::gemm_phase<pg8::EpiNormRes, pg8::StaticOrder, true, true>(ring, g, S, E);
    }
    SEAM(8);
    if (IN(10)) { LOAD_ARGS(a); MKCTX(); LAS unsigned char* ring = C.lds; const int bx = (int)blockIdx.x; (void)ring; (void)bx;
        pg8::Gemm g{(const bf16*)(ws + WS_H2), (const bf16*)(ws + WS_WG), M_TOK, DM, DM}; pg8::StaticOrder S; S.init(M_TOK, DM, C.G, bx);
        pg8::EpiFinal E{(const bf16*)(ws + WS_H2), (const bf16*)(ws + WS_PLEO), (const float*)(ws + WS_SSP2), a.out, ring};
#if defined(P10_STAGGER)
        for (int i = 0; i < (bx & (P10_GROUPS - 1)) * P10_STAGGER; ++i) __builtin_amdgcn_s_sleep(127);
#endif
        pg8::gemm_phase<pg8::EpiFinal, pg8::StaticOrder, true, true>(ring, g, S, E);
        if ((PH_REP >> 10) & 1) { __syncthreads(); asm volatile("" ::: "memory"); __builtin_amdgcn_sched_barrier(0); pg8::gemm_phase<pg8::EpiFinal, pg8::StaticOrder, true, true>(ring, g, S, E); }
    }
#undef IN
#undef SEAM
}

static_assert(pg8::EPI_X_END <= LDSCTL_OFF, "fused-epilogue LDS tables fit below the control words");
extern "C" void kernel_launch(void* const* d_in, const int* in_sizes, int n_in, void* d_out, int out_size, void* d_ws, size_t ws_size, hipStream_t stream) {
    static int grid = 0;
    if (grid == 0) {
        if (n_in != 19 || in_sizes[0] != M_TOK * DM || out_size != M_TOK * DM || ws_size < WS_END) {
            fprintf(stderr, "kernel_launch: built for 19 inputs, x/out of %d floats, >= %zu bytes of workspace; got n_in %d, in0 %d, out %d, ws %zu; nothing launched\n", M_TOK * DM, (size_t)WS_END, n_in, n_in > 0 ? in_sizes[0] : -1, out_size, ws_size);
            grid = -1; return; }
        int dev = 0, cus = 0, per_cu = 0;
        if (hipGetDevice(&dev) != hipSuccess || hipDeviceGetAttribute(&cus, hipDeviceAttributeMultiprocessorCount, dev) != hipSuccess) { fprintf(stderr, "kernel_launch: device query failed\n"); grid = -1; return; }
        if (hipFuncSetAttribute((const void*)hyb_fwd, hipFuncAttributeMaxDynamicSharedMemorySize, LDS_BYTES) != hipSuccess) { fprintf(stderr, "kernel_launch: hipFuncSetAttribute failed\n"); grid = -1; return; }
        if (hipOccupancyMaxActiveBlocksPerMultiprocessor(&per_cu, (const void*)hyb_fwd, NWAVES * 64, LDS_BYTES) != hipSuccess || per_cu < 1)
            fprintf(stderr, "kernel_launch: note: occupancy query reports %d workgroups per CU\n", per_cu);
        (void)hipGetLastError();
        grid = cus;
    }
    if (grid < 0) return;
    if (N_LAUNCHES == 1) { if (hipMemsetAsync((char*)d_ws + WS_CTL, 0, CTL_ZERO_BYTES, stream) != hipSuccess) { fprintf(stderr, "kernel_launch: hipMemsetAsync failed\n"); return; } }
    Args a{};
    for (int i = 0; i < 19; ++i) a.in[i] = (const float*)d_in[i];
    a.out = (float*)d_out; a.ws = (unsigned char*)d_ws;
    for (int li = 0; li < N_LAUNCHES; ++li) {
        a.ph_lo = (N_LAUNCHES == 1) ? 0 : li; a.ph_hi = (N_LAUNCHES == 1) ? N_PHASES : li + 1; a.li = li; a.pad = 0;
        hipLaunchKernelGGL(hyb_fwd, dim3(grid), dim3(NWAVES * 64), LDS_BYTES, stream, a);
        const hipError_t le = hipPeekAtLastError();
        if (le != hipSuccess) { fprintf(stderr, "kernel_launch: launch %d failed: %s\n", li, hipGetErrorName(le)); break; }
    }
}
```

```cpp
#include <hip/hip_runtime.h>
#include <cstdio>
#include <cstdint>

#ifndef MK_N_LAUNCHES
#define MK_N_LAUNCHES 1
#endif

constexpr int NB = 16, SEQ = 4096, DM = 1024, M_TOK = NB * SEQ, DFF = 2816, PLE_D = 256;
constexpr int IN_TOTAL = 7664, IN_VIRT = 7680;
constexpr float RMS_EPS = 1e-6f, GN_EPS = 1e-5f, LOG2E = 1.4426950408889634f;
constexpr float QSCALE = 0.10206207261596575f * 1.4426950408889634f;
constexpr size_t MiB = 1u << 20;
constexpr size_t WS_CTL = 0, CTL_ZERO_BYTES = 1 * MiB;
constexpr size_t WS_WIN = 1 * MiB;
constexpr size_t WS_WOUT = 16 * MiB;
constexpr size_t WS_WFI = 18 * MiB;
constexpr size_t WS_WFO = 29 * MiB;
constexpr size_t WS_WPLE = 34 * MiB + 512 * 1024;
constexpr size_t WS_WG = 35 * MiB;
constexpr size_t WS_W1K = 37 * MiB;
constexpr size_t WS_W1V = 37 * MiB + 589824;
constexpr size_t WS_W2K = 38 * MiB, WS_W2V = 38 * MiB + 32768;
constexpr size_t WS_C1K = 38 * MiB + 65536, WS_C1V = 38 * MiB + 65536 + 2048;
constexpr size_t WS_KCMP = 39 * MiB;
constexpr size_t WS_VCMP = 40 * MiB + 512 * 1024;
constexpr size_t WS_SSP = 42 * MiB;
constexpr size_t WS_RS2 = 46 * MiB, WS_RS3 = 46 * MiB + 512 * 1024;
constexpr size_t WS_XBUF = 47 * MiB;
constexpr size_t WS_SSP2 = 420 * MiB;
constexpr size_t CW_XCNT2 = 131072;
constexpr size_t CW_XCNT = 65536;
constexpr size_t WS_NQ = 48 * MiB, WS_KC = 240 * MiB, WS_VC = 264 * MiB, WS_KS = 280 * MiB, WS_VS = 304 * MiB, WS_KW = 320 * MiB, WS_VW = 344 * MiB, WS_NG = 360 * MiB;
constexpr size_t WS_RQ = 366 * MiB, WS_RK = 430 * MiB, WS_RV = 494 * MiB, WS_RG = 622 * MiB, WS_MG = 750 * MiB, WS_END = 1006 * MiB;
constexpr size_t WS_MIXIN = WS_NQ;
constexpr size_t WS_MIX = WS_RQ;
constexpr size_t WS_PLEO = WS_RV;
constexpr size_t WS_H2 = WS_RG;
constexpr size_t WS_ACT = WS_NQ;
constexpr size_t OUT_H = 0;
constexpr size_t OUT_PBF = 128 * MiB;
constexpr size_t OUT_NSA = 0;
constexpr size_t OUT_F = 0;

namespace pg8 {
#define PG8_LAS __attribute__((address_space(3)))
typedef unsigned short bf16_t;
typedef short bf16x8 __attribute__((ext_vector_type(8)));
typedef float f32x4 __attribute__((ext_vector_type(4)));
typedef unsigned u32x4 __attribute__((ext_vector_type(4)));
constexpr int BM = 256, BK = 64, HALF = 128, HTB = HALF * BK * 2  , STAGE_BYTES = 8 * HTB, NXCD = 8, WGM = 4;

__host__ __device__ __forceinline__ int lds_byte(int r, int c) { const int st = (r >> 4) * 2 + (c >> 5), rr = r & 15, cc = c & 31, ob = rr * 64 + cc * 2; return st * 1024 + (ob ^ (((ob >> 9) & 1) << 5)); }
__host__ __device__ __forceinline__ void stage_rc(int b, int& R, int& C) { const int st = b / 1024, sb = b % 1024, swz = sb ^ (((sb >> 9) & 1) << 5); R = (st >> 1) * 16 + swz / 64; C = (st & 1) * 32 + (swz % 64) / 2; }
__host__ __device__ __forceinline__ int perm32(int rho) { const int n = rho >> 4, i = rho & 15; return 8 * (i >> 2) + 4 * n + (i & 3); }

struct Unit { int pm, pn; };
struct Gemm { const bf16_t* A; const bf16_t* Bt; int M, N, K; };

struct StaticOrder {
    int nM, nN, nwg, G, c;
    __host__ __device__ void init(int M, int N, int G_, int c_) { nM = M / BM; nN = N / BM; nwg = nM * nN; G = G_; c = c_; }
    __host__ __device__ bool next(int i, Unit& u) const {
        const long L = (long)i * G + c; if (L >= nwg) return false;
        int wgid = (int)L; { const int q = nwg / NXCD, r = nwg % NXCD, xcd = wgid % NXCD, off = wgid / NXCD; wgid = (xcd < r ? xcd * (q + 1) : r * (q + 1) + (xcd - r) * q) + off; }
        const int nig = WGM * nN, gid = wgid / nig, fm = gid * WGM, gsz = (nM - fm) < WGM ? (nM - fm) : WGM;
        u.pm = fm + ((wgid % nig) % gsz); u.pn = (wgid % nig) / gsz; return true;
    }
    __device__ __forceinline__ void a_ready(const Unit&) const {}
    __device__ __forceinline__ void done(const Unit&) const {}
};

struct PanelOrder {
    int nN, pm;
    __device__ __forceinline__ void init(int N, int pm_) { int n_ = N / BM; asm volatile("" : "+s"(n_)); nN = n_; pm = pm_; }
    __device__ __forceinline__ bool next(int i, Unit& u) const { if (i >= nN) return false; u.pm = pm; u.pn = i; return true; }
    __device__ __forceinline__ void a_ready(const Unit&) const {}
    __device__ __forceinline__ void done(const Unit&) const {}
};

typedef float f32x2_t __attribute__((ext_vector_type(2))); typedef __bf16 bf16x2_t __attribute__((ext_vector_type(2)));
__device__ __forceinline__ unsigned cvt_pk_bf16(float lo, float hi) { f32x2_t v = {lo, hi}; bf16x2_t b = __builtin_convertvector(v, bf16x2_t); return __builtin_bit_cast(unsigned, b); }
__device__ __forceinline__ float bf_lo(unsigned w) { return __uint_as_float(w << 16); }
__device__ __forceinline__ float bf_hi(unsigned w) { return __uint_as_float(w & 0xffff0000u); }
__device__ __forceinline__ float fast_sigmoid(float x) { return __builtin_amdgcn_rcpf(1.f + __builtin_amdgcn_exp2f(-x * ::LOG2E)); }

constexpr int EPI_STG_OFF = 131072, EPI_STG_ROW = 144, EPI_STG_WAVE = 16 * EPI_STG_ROW;
__device__ __forceinline__ void stage_store_rows(PG8_LAS unsigned char* stg, int fr, int fq, const u32x4& w0, const u32x4& w1, unsigned char* gblock, size_t pitch, int nchunk) {
    *(PG8_LAS u32x4*)(stg + fr * EPI_STG_ROW + fq * 16) = w0; *(PG8_LAS u32x4*)(stg + fr * EPI_STG_ROW + 64 + fq * 16) = w1;
    const int ln = fq * 16 + fr, r = ln >> 3, c = ln & 7;
#pragma unroll
    for (int h = 0; h < 2; ++h) { const u32x4 v = *(const PG8_LAS u32x4*)(stg + (8 * h + r) * EPI_STG_ROW + c * 16);
        if (c < nchunk) *(u32x4*)(gblock + (size_t)(8 * h + r) * pitch + c * 16) = v; }
}
__device__ __forceinline__ u32x4 pack8(const f32x4& v0, const f32x4& v1) { u32x4 w; w.x = cvt_pk_bf16(v0[0], v0[1]); w.y = cvt_pk_bf16(v0[2], v0[3]); w.z = cvt_pk_bf16(v1[0], v1[1]); w.w = cvt_pk_bf16(v1[2], v1[3]); return w; }

struct EpiProj {
    static constexpr bool PERM = true, AFTER_DRAIN = false;
    bf16_t* ws; PG8_LAS unsigned char* lds; unsigned char* scr;
    __device__ __forceinline__ static void route(int v, size_t& off, int& ld, float& sc, int& nch) {
        sc = 1.f; nch = 8;
        if (v < 512)       { off = ::WS_RQ / 2 + v;            ld = 512; }
        else if (v < 1024) { off = ::WS_RK / 2 + (v - 512);    ld = 512; }
        else if (v < 2048) { off = ::WS_RV / 2 + (v - 1024);   ld = 1024; }
        else if (v < 3072) { off = ::WS_RG / 2 + (v - 2048);   ld = 1024; }
        else if (v < 4608) { off = ::WS_NQ / 2 + (v - 3072);   ld = 1536; sc = ::QSCALE; }
        else if (v < 6656) { off = ::WS_MG / 2 + (v - 4608);   ld = 2048; sc = ::LOG2E; }
        else { const int w = v - 6656;
            if (w < 192)       { off = ::WS_KC / 2 + w;          ld = 192; }
            else if (w < 320)  { off = ::WS_VC / 2 + (w - 192);  ld = 128; }
            else if (w < 512)  { off = ::WS_KS / 2 + (w - 320);  ld = 192; }
            else if (w < 640)  { off = ::WS_VS / 2 + (w - 512);  ld = 128; }
            else if (w < 832)  { off = ::WS_KW / 2 + (w - 640);  ld = 192; }
            else if (w < 960)  { off = ::WS_VW / 2 + (w - 832);  ld = 128; }
            else               { off = ::WS_NG / 2 + (w - 960);  ld = 48; nch = 6; } }
    }
    __device__ __forceinline__ void operator()(const f32x4 (&acc)[2][2][4][2], const Unit& u, int wr, int wc, int fr_in, int fq_in) const {
        int fr = fr_in, fq = fq_in; asm volatile("" : "+v"(fr), "+v"(fq));
        size_t off; int ld, nch; float sc;
        route(u.pn * BM + wc * 64, off, ld, sc, nch);
        PG8_LAS unsigned char* stg = lds + EPI_STG_OFF + (wr * 4 + wc) * EPI_STG_WAVE;
        const int rowb = u.pm * BM + wr * 64;
#pragma unroll
        for (int ai = 0; ai < 2; ++ai)
#pragma unroll
            for (int m = 0; m < 4; ++m) { const size_t row = (size_t)(rowb + ai * HALF + m * 16);
                stage_store_rows(stg, fr, fq, pack8(acc[ai][0][m][0] * sc, acc[ai][0][m][1] * sc), pack8(acc[ai][1][m][0] * sc, acc[ai][1][m][1] * sc), (unsigned char*)(ws + off + row * ld), (size_t)ld * 2, nch);
#if defined(EPI_PROBE) && (EPI_PROBE == 4 || EPI_PROBE == 5)
                { const u32x4 wz = pack8(acc[ai][0][m][0], acc[ai][0][m][1]); const int ln = fq * 16 + fr, k2_ = (ai * 4 + m) * 2;
                  unsigned char* sb = scr + (size_t)blockIdx.x * 131072 + (size_t)(wr * 4 + wc) * 16384;
                  if (EPI_PROBE == 4) { *(volatile __attribute__((address_space(1))) u32x4*)(sb + (size_t)k2_ * 1024 + ln * 16) = wz; *(volatile __attribute__((address_space(1))) u32x4*)(sb + (size_t)(k2_ + 1) * 1024 + ln * 16) = wz; }
                  else { *(volatile __attribute__((address_space(1))) u32x4*)(scr + (size_t)blockIdx.x * 131072 + (size_t)(k2_ * 8 + (ln >> 3)) * 1024 + (wr * 4 + wc) * 128 + (ln & 7) * 16) = wz;
                         *(volatile __attribute__((address_space(1))) u32x4*)(scr + (size_t)blockIdx.x * 131072 + (size_t)((k2_ + 1) * 8 + (ln >> 3)) * 1024 + (wr * 4 + wc) * 128 + (ln & 7) * 16) = wz; } }
#endif
                }
    }
};

#if defined(GEMM_PROBE)
struct EpiNone {
    static constexpr bool PERM = true, AFTER_DRAIN = false;
    PG8_LAS unsigned char* lds;
    __device__ __forceinline__ void operator()(const f32x4 (&acc)[2][2][4][2], const Unit& u, int wr, int wc, int fr_in, int fq_in) const {
#pragma unroll
        for (int ai = 0; ai < 2; ++ai)
#pragma unroll
            for (int bj = 0; bj < 2; ++bj)
#pragma unroll
                for (int m = 0; m < 4; ++m)
#pragma unroll
                    for (int n = 0; n < 2; ++n) asm volatile("" :: "v"(acc[ai][bj][m][n]));
    }
};
#endif

struct EpiPlain {
    static constexpr bool PERM = true, AFTER_DRAIN = false;
    bf16_t* O; int ldc; PG8_LAS unsigned char* lds;
    __device__ __forceinline__ void operator()(const f32x4 (&acc)[2][2][4][2], const Unit& u, int wr, int wc, int fr_in, int fq_in) const {
        int fr = fr_in, fq = fq_in; asm volatile("" : "+v"(fr), "+v"(fq));
        PG8_LAS unsigned char* stg = lds + EPI_STG_OFF + (wr * 4 + wc) * EPI_STG_WAVE;
        const int rowb = u.pm * BM + wr * 64, colb = u.pn * BM + wc * 64;
#pragma unroll
        for (int ai = 0; ai < 2; ++ai)
#pragma unroll
            for (int m = 0; m < 4; ++m) { const size_t row = (size_t)(rowb + ai * HALF + m * 16);
                stage_store_rows(stg, fr, fq, pack8(acc[ai][0][m][0], acc[ai][0][m][1]), pack8(acc[ai][1][m][0], acc[ai][1][m][1]), (unsigned char*)(O + row * ldc + colb), (size_t)ldc * 2, 8); }
    }
};

struct EpiSumsq {
    static constexpr bool PERM = true, AFTER_DRAIN = false;
    bf16_t* O; float* ssp; PG8_LAS unsigned char* lds;
    __device__ __forceinline__ void operator()(const f32x4 (&acc)[2][2][4][2], const Unit& u, int wr, int wc, int fr_in, int fq_in) const {
        int fr = fr_in, fq = fq_in; asm volatile("" : "+v"(fr), "+v"(fq));
        PG8_LAS unsigned char* stg = lds + EPI_STG_OFF + (wr * 4 + wc) * EPI_STG_WAVE;
        const int rowb = u.pm * BM + wr * 64, colb = u.pn * BM + wc * 64;
#pragma unroll
        for (int ai = 0; ai < 2; ++ai)
#pragma unroll
            for (int m = 0; m < 4; ++m) { const int row = rowb + ai * HALF + m * 16; float s = 0.f;
#pragma unroll
                for (int bj = 0; bj < 2; ++bj) { const f32x4 v0 = acc[ai][bj][m][0], v1 = acc[ai][bj][m][1];
                    s += (v0[0] * v0[0] + v0[1] * v0[1]) + (v0[2] * v0[2] + v0[3] * v0[3]); s += (v1[0] * v1[0] + v1[1] * v1[1]) + (v1[2] * v1[2] + v1[3] * v1[3]); }
                stage_store_rows(stg, fr, fq, pack8(acc[ai][0][m][0], acc[ai][0][m][1]), pack8(acc[ai][1][m][0], acc[ai][1][m][1]), (unsigned char*)(O + (size_t)row * 1024 + colb), 2048, 8);
                s += __shfl_xor(s, 16); s += __shfl_xor(s, 32);
                if (fq == 0) ssp[(size_t)(row + fr) * 16 + u.pn * 4 + wc] = s; }
    }
};

constexpr int EPI_P_OFF = EPI_STG_OFF + 8 * EPI_STG_WAVE, EPI_S_OFF = EPI_P_OFF + 4096, EPI_X_END = EPI_S_OFF + 1024;
template <bool XF32>
struct EpiNormRes {
    static constexpr bool PERM = true, AFTER_DRAIN = false;
    const void* Xin; bf16_t* X; const float* gpost; float* ssp2; unsigned* xbuf; unsigned* cnt; PG8_LAS unsigned char* lds;
    static constexpr int NPRE = XF32 ? 3 : 6;
    struct Res { f32x4 v[2][2]; };
    __device__ __forceinline__ static void ld(const void* Xin, size_t idx, u32x4 (&raw)[XF32 ? 4 : 2]) {
        if constexpr (XF32) { const float* p = (const float*)Xin + idx;
            raw[0] = *(const u32x4*)(p); raw[1] = *(const u32x4*)(p + 4); raw[2] = *(const u32x4*)(p + 32); raw[3] = *(const u32x4*)(p + 36); }
        else { const bf16_t* p = (const bf16_t*)Xin + idx; raw[0] = *(const u32x4*)(p); raw[1] = *(const u32x4*)(p + 32); }
    }
    __device__ __forceinline__ static Res cvt(const u32x4 (&raw)[XF32 ? 4 : 2]) { Res r;
        if constexpr (XF32) {
#pragma unroll
            for (int q = 0; q < 4; ++q) r.v[q >> 1][q & 1] = (f32x4){__uint_as_float(raw[q].x), __uint_as_float(raw[q].y), __uint_as_float(raw[q].z), __uint_as_float(raw[q].w)}; }
        else {
#pragma unroll
            for (int bj = 0; bj < 2; ++bj) { const u32x4 xw = raw[bj]; r.v[bj][0] = (f32x4){bf_lo(xw.x), bf_hi(xw.x), bf_lo(xw.y), bf_hi(xw.y)}; r.v[bj][1] = (f32x4){bf_lo(xw.z), bf_hi(xw.z), bf_lo(xw.w), bf_hi(xw.w)}; } }
        return r; }
    __device__ __forceinline__ void operator()(const f32x4 (&acc)[2][2][4][2], const Unit& u, int wr, int wc, int fr_in, int fq_in) const {
        int fr = fr_in, fq = fq_in; asm volatile("" : "+v"(fr), "+v"(fq));
        const int tid = threadIdx.x, wid = __builtin_amdgcn_readfirstlane(tid >> 6), lane = tid & 63;
        PG8_LAS float* P = (PG8_LAS float*)(lds + EPI_P_OFF); PG8_LAS float* S = (PG8_LAS float*)(lds + EPI_S_OFF);
        PG8_LAS unsigned char* stg = lds + EPI_STG_OFF + (wr * 4 + wc) * EPI_STG_WAVE;
        const int rowb = u.pm * BM + wr * 64, colb = u.pn * BM + wc * 64;
        u32x4 pre[NPRE][XF32 ? 4 : 2];
#pragma unroll
        for (int q = 0; q < NPRE; ++q) ld(Xin, (size_t)(rowb + (q >> 2) * HALF + (q & 3) * 16 + fr) * 1024 + colb + 8 * fq, pre[q]);
#pragma unroll
        for (int ai = 0; ai < 2; ++ai)
#pragma unroll
            for (int m = 0; m < 4; ++m) { float s = 0.f;
#pragma unroll
                for (int bj = 0; bj < 2; ++bj) { const f32x4 v0 = acc[ai][bj][m][0], v1 = acc[ai][bj][m][1];
                    s += (v0[0] * v0[0] + v0[1] * v0[1]) + (v0[2] * v0[2] + v0[3] * v0[3]); s += (v1[0] * v1[0] + v1[1] * v1[1]) + (v1[2] * v1[2] + v1[3] * v1[3]); }
                s += __shfl_xor(s, 16); s += __shfl_xor(s, 32);
                if (fq == 0) P[(ai * HALF + wr * 64 + m * 16 + fr) * 4 + wc] = s; }
        asm volatile("s_waitcnt lgkmcnt(0)" ::: "memory"); __builtin_amdgcn_s_barrier(); asm volatile("" ::: "memory");
        if (tid < 256) { const f32x4 p4 = *(const PG8_LAS f32x4*)(P + tid * 4);
            __hip_atomic_store(xbuf + (size_t)(u.pm * BM + tid) * 4 + u.pn, __float_as_uint((p4[0] + p4[1]) + (p4[2] + p4[3])), __ATOMIC_RELAXED, __HIP_MEMORY_SCOPE_AGENT); }
        asm volatile("s_waitcnt vmcnt(0)" ::: "memory");
        if (tid < 256 && lane == 0) __hip_atomic_fetch_add(cnt + 64 * u.pm, 1u, __ATOMIC_RELAXED, __HIP_MEMORY_SCOPE_AGENT);
        if (wid == 0) { unsigned sp = 0u;
            while ((unsigned)__builtin_amdgcn_readfirstlane(__hip_atomic_load(cnt + 64 * u.pm, __ATOMIC_RELAXED, __HIP_MEMORY_SCOPE_AGENT)) < 16u) { __builtin_amdgcn_s_sleep(2); if (++sp > (1u << 21)) break; } }
        asm volatile("s_waitcnt vmcnt(0) lgkmcnt(0)" ::: "memory"); __builtin_amdgcn_s_barrier(); asm volatile("" ::: "memory");
        if (tid < 256) { const unsigned long long* sl = (const unsigned long long*)(xbuf + (size_t)(u.pm * BM + tid) * 4);
            const unsigned long long a = __hip_atomic_load(sl, __ATOMIC_RELAXED, __HIP_MEMORY_SCOPE_AGENT), b = __hip_atomic_load(sl + 1, __ATOMIC_RELAXED, __HIP_MEMORY_SCOPE_AGENT);
            const float t = (__uint_as_float((unsigned)a) + __uint_as_float((unsigned)(a >> 32))) + (__uint_as_float((unsigned)b) + __uint_as_float((unsigned)(b >> 32)));
            S[tid] = __builtin_amdgcn_rsqf(t * (1.f / 1024.f) + ::RMS_EPS); }
        asm volatile("s_waitcnt lgkmcnt(0)" ::: "memory"); __builtin_amdgcn_s_barrier(); asm volatile("" ::: "memory");
        f32x4 gp[2][2];
#pragma unroll
        for (int bj = 0; bj < 2; ++bj)
#pragma unroll
            for (int n = 0; n < 2; ++n) gp[bj][n] = *(const f32x4*)(gpost + colb + 32 * bj + 8 * fq + 4 * n);
#pragma unroll
        for (int ai = 0; ai < 2; ++ai)
#pragma unroll
            for (int m = 0; m < 4; ++m) { const int rl = ai * HALF + wr * 64 + m * 16 + fr, row = u.pm * BM + rl; const float rs = S[rl];
                Res x;
                if (ai * 4 + m < NPRE) x = cvt(pre[ai * 4 + m < NPRE ? ai * 4 + m : 0]);
                else { u32x4 raw[XF32 ? 4 : 2]; ld(Xin, (size_t)row * 1024 + colb + 8 * fq, raw); x = cvt(raw); }
                f32x4 o[2][2]; float s2 = 0.f;
#pragma unroll
                for (int bj = 0; bj < 2; ++bj) {
                    o[bj][0] = x.v[bj][0] + acc[ai][bj][m][0] * rs * gp[bj][0]; o[bj][1] = x.v[bj][1] + acc[ai][bj][m][1] * rs * gp[bj][1];
                    s2 += (o[bj][0][0] * o[bj][0][0] + o[bj][0][1] * o[bj][0][1]) + (o[bj][0][2] * o[bj][0][2] + o[bj][0][3] * o[bj][0][3]);
                    s2 += (o[bj][1][0] * o[bj][1][0] + o[bj][1][1] * o[bj][1][1]) + (o[bj][1][2] * o[bj][1][2] + o[bj][1][3] * o[bj][1][3]); }
                stage_store_rows(stg, fr, fq, pack8(o[0][0], o[0][1]), pack8(o[1][0], o[1][1]), (unsigned char*)(X + (size_t)(row - fr) * 1024 + colb), 2048, 8);
                s2 += __shfl_xor(s2, 16); s2 += __shfl_xor(s2, 32);
                if (fq == 0) ssp2[(size_t)row * 16 + u.pn * 4 + wc] = s2; }
    }
};

struct EpiSwiglu {
    static constexpr bool PERM = true, AFTER_DRAIN = false;
    bf16_t* O; const float* ssp;
    __device__ __forceinline__ void operator()(const f32x4 (&acc)[2][2][4][2], const Unit& u, int wr, int wc, int fr_in, int fq_in) const {
        int fr = fr_in, fq = fq_in; asm volatile("" : "+v"(fr), "+v"(fq));
        const int row0 = u.pm * BM + wr * 64 + fr, col0 = u.pn * HALF + wc * 32 + 8 * fq;
#pragma unroll
        for (int ai = 0; ai < 2; ++ai)
#pragma unroll
            for (int m = 0; m < 4; ++m) { const int row = row0 + ai * HALF + m * 16; bf16_t* rowp = O + (size_t)row * ::DFF + col0; float r[8];
                float rsv; { const f32x4* pp = (const f32x4*)(ssp + (size_t)row * 16); const f32x4 p0 = pp[0], p1 = pp[1], p2 = pp[2], p3 = pp[3];
                  const float t = (((p0[0] + p0[1]) + (p0[2] + p0[3])) + ((p1[0] + p1[1]) + (p1[2] + p1[3]))) + (((p2[0] + p2[1]) + (p2[2] + p2[3])) + ((p3[0] + p3[1]) + (p3[2] + p3[3])));
                  rsv = __builtin_amdgcn_rsqf(t * (1.f / 1024.f) + ::RMS_EPS); }
#pragma unroll
                for (int n = 0; n < 2; ++n)
#pragma unroll
                    for (int k = 0; k < 4; ++k) { const float a = acc[ai][0][m][n][k] * rsv, b = acc[ai][1][m][n][k] * rsv; r[4 * n + k] = a * fast_sigmoid(a) * b; }
                u32x4 w; w.x = cvt_pk_bf16(r[0], r[1]); w.y = cvt_pk_bf16(r[2], r[3]); w.z = cvt_pk_bf16(r[4], r[5]); w.w = cvt_pk_bf16(r[6], r[7]);
                *(u32x4*)rowp = w; }
    }
};

struct EpiFinal {
    static constexpr bool PERM = true, AFTER_DRAIN = false;
    const bf16_t* x2; const bf16_t* ple; const float* ssp2; float* out; PG8_LAS unsigned char* lds;
    struct In { f32x4 pp[4]; u32x4 xw[2], pw[2]; };
    __device__ __forceinline__ In load(int row, int colb, int fq) const { In r; const f32x4* p = (const f32x4*)(ssp2 + (size_t)row * 16);
#pragma unroll
        for (int q = 0; q < 4; ++q) r.pp[q] = p[q];
#pragma unroll
        for (int bj = 0; bj < 2; ++bj) { const size_t idx = (size_t)row * 1024 + colb + 32 * bj + 8 * fq; r.xw[bj] = *(const u32x4*)(x2 + idx); r.pw[bj] = *(const u32x4*)(ple + idx); }
        return r; }
    __device__ __forceinline__ void operator()(const f32x4 (&acc)[2][2][4][2], const Unit& u, int wr, int wc, int fr_in, int fq_in) const {
        int fr = fr_in, fq = fq_in; asm volatile("" : "+v"(fr), "+v"(fq));
        PG8_LAS unsigned char* stg = lds + EPI_STG_OFF + (wr * 4 + wc) * EPI_STG_WAVE;
        const int rowb = u.pm * BM + wr * 64, colb = u.pn * BM + wc * 64;
        const int ln = fq * 16 + fr, r8 = ln >> 3, c8 = ln & 7;
        In cur = load(rowb + fr, colb, fq);
#pragma unroll
        for (int g = 0; g < 8; ++g) { const int ai = g >> 2, m = g & 3; const int rowblk = rowb + ai * HALF + m * 16;
            In nxt = cur; if (g < 7) nxt = load(rowb + ((g + 1) >> 2) * HALF + ((g + 1) & 3) * 16 + fr, colb, fq);
            const f32x4 p0 = cur.pp[0], p1 = cur.pp[1], p2 = cur.pp[2], p3 = cur.pp[3];
            const float t = (((p0[0] + p0[1]) + (p0[2] + p0[3])) + ((p1[0] + p1[1]) + (p1[2] + p1[3]))) + (((p2[0] + p2[1]) + (p2[2] + p2[3])) + ((p3[0] + p3[1]) + (p3[2] + p3[3])));
            const float rsv = __builtin_amdgcn_rsqf(t * (1.f / 1024.f) + ::RMS_EPS);
#pragma unroll
            for (int bj = 0; bj < 2; ++bj) { const u32x4 xw = cur.xw[bj], pw = cur.pw[bj];
                const f32x4 a0 = acc[ai][bj][m][0] * rsv, a1 = acc[ai][bj][m][1] * rsv; u32x4 o0, o1;
                o0.x = __float_as_uint(bf_lo(xw.x) + fast_sigmoid(a0[0]) * bf_lo(pw.x)); o0.y = __float_as_uint(bf_hi(xw.x) + fast_sigmoid(a0[1]) * bf_hi(pw.x));
                o0.z = __float_as_uint(bf_lo(xw.y) + fast_sigmoid(a0[2]) * bf_lo(pw.y)); o0.w = __float_as_uint(bf_hi(xw.y) + fast_sigmoid(a0[3]) * bf_hi(pw.y));
                o1.x = __float_as_uint(bf_lo(xw.z) + fast_sigmoid(a1[0]) * bf_lo(pw.z)); o1.y = __float_as_uint(bf_hi(xw.z) + fast_sigmoid(a1[1]) * bf_hi(pw.z));
                o1.z = __float_as_uint(bf_lo(xw.w) + fast_sigmoid(a1[2]) * bf_lo(pw.w)); o1.w = __float_as_uint(bf_hi(xw.w) + fast_sigmoid(a1[3]) * bf_hi(pw.w));
                *(PG8_LAS u32x4*)(stg + fr * EPI_STG_ROW + fq * 32) = o0; *(PG8_LAS u32x4*)(stg + fr * EPI_STG_ROW + fq * 32 + 16) = o1;
#pragma unroll
                for (int h = 0; h < 2; ++h) { const u32x4 v = *(const PG8_LAS u32x4*)(stg + (8 * h + r8) * EPI_STG_ROW + c8 * 16);
                    *(u32x4*)((unsigned char*)out + ((size_t)(rowblk + 8 * h + r8) * 1024 + colb + 32 * bj) * 4 + c8 * 16) = v; } }
            cur = nxt; }
    }
};

template <class E> struct ProbeTraits { static constexpr bool no_stage = false, no_lds = false; };
#if defined(GEMM_PROBE)
template <> struct ProbeTraits<EpiNone> { static constexpr bool no_stage = (GEMM_PROBE == 2 || GEMM_PROBE == 4), no_lds = (GEMM_PROBE == 3 || GEMM_PROBE == 4); };
#endif
template <class Epi, class Sched, bool ALIGN_EPI = false, bool SP2 = false>
__device__ __forceinline__ void gemm_phase(PG8_LAS unsigned char* lds, const Gemm g, const Sched& S, const Epi& E) {
    const int tid = threadIdx.x, wid = __builtin_amdgcn_readfirstlane(tid >> 6), lane = tid & 63, wr = wid >> 2, wc = wid & 3, fr = lane & 15, fq = lane >> 4;
    const int K = g.K, nt = K / BK;
    unsigned voffA[2], voffB[2];
#pragma unroll
    for (int i = 0; i < 2; ++i) { int R, C; stage_rc(tid * 16 + i * 8192, R, C); const int Rb = Epi::PERM ? ((R & ~31) + perm32(R & 31)) : R;
        voffA[i] = (unsigned)(R * K + C) * 2u; voffB[i] = (unsigned)(Rb * K + C) * 2u; }
    const size_t kstep = (size_t)(BK * 2);
    const size_t hstep = (size_t)HALF * K * 2;
    const size_t tstep = 2 * hstep;
    const unsigned ldsw = (unsigned)wid * 1024u;
    const int aoff = lds_byte(wr * 64 + fr, fq * 8), boff = lds_byte(wc * 32 + fr, fq * 8);
#define PG8_SA(b, h) (((b) * 2 + (h)) * HTB)
#define PG8_SB(b, h) ((4 + (b) * 2 + (h)) * HTB)
#if !defined(PG8_GLOBAL_DMA)
    const __amdgpu_buffer_rsrc_t rsrcA = __builtin_amdgcn_make_buffer_rsrc((void*)g.A, 0, 0x7fffffff, 0x00020000), rsrcB = __builtin_amdgcn_make_buffer_rsrc((void*)g.Bt, 0, 0x7fffffff, 0x00020000);
#define PG8_STAGE(bufoff, gbase, voff) do { if constexpr (!ProbeTraits<Epi>::no_stage) { const bool isA_ = ((const void*)(voff) == (const void*)voffA); \
        const int so_ = (int)((const char*)(gbase) - (isA_ ? (const char*)g.A : (const char*)g.Bt)); _Pragma("unroll") for (int _i = 0; _i < 2; ++_i) { \
        if (isA_) __builtin_amdgcn_raw_ptr_buffer_load_lds(rsrcA, (PG8_LAS unsigned*)(lds + (bufoff) + ldsw + _i * 8192), 16, (int)(voff)[_i], so_, 0, 0); \
        else      __builtin_amdgcn_raw_ptr_buffer_load_lds(rsrcB, (PG8_LAS unsigned*)(lds + (bufoff) + ldsw + _i * 8192), 16, (int)(voff)[_i], so_, 0, 0); } } } while (0)
#else
#define PG8_STAGE(bufoff, gbase, voff) do { if constexpr (!ProbeTraits<Epi>::no_stage) _Pragma("unroll") for (int _i = 0; _i < 2; ++_i) \
        __builtin_amdgcn_global_load_lds((const unsigned*)((const char*)(gbase) + (voff)[_i]), (PG8_LAS unsigned*)(lds + (bufoff) + ldsw + _i * 8192), 16, 0, 0); } while (0)
#endif
#define PG8_LDA(dst, b, h) do { if constexpr (!ProbeTraits<Epi>::no_lds) _Pragma("unroll") for (int m = 0; m < 4; ++m) _Pragma("unroll") for (int k = 0; k < 2; ++k) dst[m][k] = *(const PG8_LAS bf16x8*)(lds + PG8_SA(b, h) + aoff + m * 2048 + k * 1024); } while (0)
#define PG8_LDB(dst, b, h) do { if constexpr (!ProbeTraits<Epi>::no_lds) _Pragma("unroll") for (int n = 0; n < 2; ++n) _Pragma("unroll") for (int k = 0; k < 2; ++k) dst[n][k] = *(const PG8_LAS bf16x8*)(lds + PG8_SB(b, h) + boff + n * 2048 + k * 1024); } while (0)
#if defined(PG8_NO_PRIO)
#define PG8_PRIO(x) do { } while (0)
#else
#if defined(PG8_PRIO_HI)
#define PG8_PRIO(x) __builtin_amdgcn_s_setprio((x) ? PG8_PRIO_HI : 0)
#else
#define PG8_PRIO(x) __builtin_amdgcn_s_setprio(x)
#endif
#endif
#define PG8_MMA(ai, bj, At, Bt) do { PG8_PRIO(1); _Pragma("unroll") for (int m = 0; m < 4; ++m) _Pragma("unroll") for (int n = 0; n < 2; ++n) _Pragma("unroll") for (int k = 0; k < 2; ++k) \
        acc[ai][bj][m][n] = __builtin_amdgcn_mfma_f32_16x16x32_bf16(Bt[n][k], At[m][k], acc[ai][bj][m][n], 0, 0, 0); PG8_PRIO(0); } while (0)
#define PG8_MMA_H(ai, bj, At, Bt, mlo, mhi) do { __builtin_amdgcn_s_setprio(1); _Pragma("unroll") for (int m = mlo; m < mhi; ++m) _Pragma("unroll") for (int n = 0; n < 2; ++n) _Pragma("unroll") for (int k = 0; k < 2; ++k) \
        acc[ai][bj][m][n] = __builtin_amdgcn_mfma_f32_16x16x32_bf16(Bt[n][k], At[m][k], acc[ai][bj][m][n], 0, 0, 0); __builtin_amdgcn_s_setprio(0); } while (0)
#define PG8_WAIT_V(n) asm volatile("s_waitcnt vmcnt(" #n ")" ::: "memory")
#define PG8_WAIT_L(n) asm volatile("s_waitcnt lgkmcnt(" #n ")" ::: "memory")
#define PG8_BAR __builtin_amdgcn_s_barrier()
#define PG8_SCHED __builtin_amdgcn_sched_barrier(0)
    Unit cur, nxt; int ui = 0;
    if (!S.next(0, cur)) return;
    f32x4 acc[2][2][4][2];
#pragma unroll
    for (int a = 0; a < 2; ++a)
#pragma unroll
        for (int b = 0; b < 2; ++b)
#pragma unroll
            for (int m = 0; m < 4; ++m)
#pragma unroll
                for (int n = 0; n < 2; ++n) acc[a][b][m][n] = (f32x4){0.f, 0.f, 0.f, 0.f};
    bf16x8 At[4][2], B0[2][2], B1[2][2];
    if constexpr (ProbeTraits<Epi>::no_lds) { _Pragma("unroll") for (int m = 0; m < 4; ++m) _Pragma("unroll") for (int k = 0; k < 2; ++k) { _Pragma("unroll") for (int e = 0; e < 8; ++e) At[m][k][e] = (short)(0x3e00 | ((tid * 2654435761u + (m * 2 + k) * 40503u + e * 9176u) >> 16 & 0x81ff)); } _Pragma("unroll") for (int n = 0; n < 2; ++n) _Pragma("unroll") for (int k = 0; k < 2; ++k) { _Pragma("unroll") for (int e = 0; e < 8; ++e) { B0[n][k][e] = (short)(0x3e00 | ((tid * 40503u + (n * 2 + k) * 2654435761u + e * 7919u) >> 13 & 0x81ff)); B1[n][k][e] = (short)(0x3e00 | ((tid * 9973u + (n * 2 + k) * 1234577u + e * 7919u) >> 11 & 0x81ff)); } } }
    const char* cA = (const char*)g.A + (size_t)cur.pm * tstep; const char* cB = (const char*)g.Bt + (size_t)cur.pn * tstep;
    S.a_ready(cur);
    if constexpr (SP2) {
        PG8_STAGE(PG8_SB(0, 0), cB, voffB); PG8_STAGE(PG8_SB(0, 1), cB + hstep, voffB); PG8_STAGE(PG8_SA(0, 0), cA, voffA); PG8_STAGE(PG8_SA(0, 1), cA + hstep, voffA);
        if (wr == 1) PG8_BAR;
        PG8_WAIT_V(2); PG8_BAR;
#if defined(PG8_BAL_DMA)
        PG8_STAGE(PG8_SB(1, 0), cB + kstep, voffB); PG8_STAGE(PG8_SA(1, 0), cA + kstep, voffA);
        PG8_WAIT_V(4); PG8_BAR;
#else
        PG8_STAGE(PG8_SB(1, 0), cB + kstep, voffB); PG8_STAGE(PG8_SA(1, 0), cA + kstep, voffA); PG8_STAGE(PG8_SB(1, 1), cB + hstep + kstep, voffB);
        PG8_WAIT_V(6); PG8_BAR;
#endif
    } else {
        PG8_STAGE(PG8_SB(0, 0), cB, voffB); PG8_STAGE(PG8_SA(0, 0), cA, voffA); PG8_STAGE(PG8_SB(0, 1), cB + hstep, voffB); PG8_STAGE(PG8_SA(0, 1), cA + hstep, voffA);
        if (wr == 1) PG8_BAR;
        PG8_WAIT_V(4); PG8_BAR;
        PG8_STAGE(PG8_SB(1, 0), cB + kstep, voffB); PG8_STAGE(PG8_SA(1, 0), cA + kstep, voffA); PG8_STAGE(PG8_SB(1, 1), cB + hstep + kstep, voffB);
        PG8_WAIT_V(6); PG8_BAR;
    }
    for (;;) {
        const bool has_next = S.next(ui + 1, nxt);
        const char* nA = has_next ? (const char*)g.A + (size_t)nxt.pm * tstep : cA; const char* nB = has_next ? (const char*)g.Bt + (size_t)nxt.pn * tstep : cB;
#pragma unroll 1
        for (int t = 0; t < nt; t += 2) {
            const bool last = (t == nt - 2);
            const char* a1 = cA + (size_t)(t + 1) * kstep;
            const char* b1 = cB + (size_t)(t + 1) * kstep; (void)b1;
            const char* a2 = last ? nA : cA + (size_t)(t + 2) * kstep; const char* b2 = last ? nB : cB + (size_t)(t + 2) * kstep;
            const char* a3 = a2 + kstep; const char* b3 = b2 + kstep;
            if (last && has_next) S.a_ready(nxt);
            if constexpr (SP2) {
#if defined(PG8_BAL_DMA)
            PG8_LDB(B0, 0, 0); PG8_LDB(B1, 0, 1); PG8_SCHED; PG8_LDA(At, 0, 0); PG8_STAGE(PG8_SB(1, 1), b1 + hstep, voffB); PG8_STAGE(PG8_SA(1, 1), a1 + hstep, voffA);
            PG8_WAIT_V(8); PG8_WAIT_L(0); PG8_BAR; PG8_MMA(0, 0, At, B0); PG8_MMA(0, 1, At, B1); PG8_BAR; PG8_SCHED;
            PG8_LDA(At, 0, 1); PG8_STAGE(PG8_SB(0, 0), b2, voffB); PG8_STAGE(PG8_SA(0, 0), a2, voffA);
            PG8_WAIT_V(6); PG8_WAIT_L(0); PG8_BAR; PG8_MMA(1, 0, At, B0); PG8_MMA(1, 1, At, B1); PG8_BAR; PG8_SCHED;
            PG8_LDB(B0, 1, 0); PG8_LDB(B1, 1, 1); PG8_SCHED; PG8_LDA(At, 1, 0); PG8_STAGE(PG8_SB(0, 1), b2 + hstep, voffB); PG8_STAGE(PG8_SA(0, 1), a2 + hstep, voffA);
            PG8_WAIT_V(8); PG8_WAIT_L(0); PG8_BAR; PG8_MMA(0, 0, At, B0); PG8_MMA(0, 1, At, B1); PG8_BAR; PG8_SCHED;
            PG8_LDA(At, 1, 1); PG8_STAGE(PG8_SB(1, 0), b3, voffB); PG8_STAGE(PG8_SA(1, 0), a3, voffA);
            PG8_WAIT_V(6); PG8_WAIT_L(0); PG8_BAR; PG8_MMA(1, 0, At, B0); PG8_MMA(1, 1, At, B1); PG8_BAR; PG8_SCHED;
#elif defined(PG8_STAGE_IN_MMA)
            PG8_LDB(B0, 0, 0); PG8_LDB(B1, 0, 1); PG8_SCHED; PG8_LDA(At, 0, 0);
            PG8_WAIT_V(6); PG8_WAIT_L(0); PG8_BAR; PG8_MMA_H(0, 0, At, B0, 0, 2); PG8_SCHED; PG8_STAGE(PG8_SA(1, 1), a1 + hstep, voffA); PG8_SCHED; PG8_MMA_H(0, 0, At, B0, 2, 4); PG8_MMA(0, 1, At, B1); PG8_BAR; PG8_SCHED;
            PG8_LDA(At, 0, 1);
            PG8_WAIT_V(2); PG8_WAIT_L(0); PG8_BAR; PG8_MMA_H(1, 0, At, B0, 0, 2); PG8_SCHED; PG8_STAGE(PG8_SB(0, 0), b2, voffB); PG8_SCHED; PG8_MMA_H(1, 0, At, B0, 2, 4); PG8_SCHED; PG8_STAGE(PG8_SB(0, 1), b2 + hstep, voffB); PG8_SCHED;
            PG8_MMA_H(1, 1, At, B1, 0, 2); PG8_SCHED; PG8_STAGE(PG8_SA(0, 0), a2, voffA); PG8_SCHED; PG8_MMA_H(1, 1, At, B1, 2, 4); PG8_BAR; PG8_SCHED;
            PG8_LDB(B0, 1, 0); PG8_LDB(B1, 1, 1); PG8_SCHED; PG8_LDA(At, 1, 0);
            PG8_WAIT_V(6); PG8_WAIT_L(0); PG8_BAR; PG8_MMA_H(0, 0, At, B0, 0, 2); PG8_SCHED; PG8_STAGE(PG8_SA(0, 1), a2 + hstep, voffA); PG8_SCHED; PG8_MMA_H(0, 0, At, B0, 2, 4); PG8_MMA(0, 1, At, B1); PG8_BAR; PG8_SCHED;
            PG8_LDA(At, 1, 1);
            PG8_WAIT_V(2); PG8_WAIT_L(0); PG8_BAR; PG8_MMA_H(1, 0, At, B0, 0, 2); PG8_SCHED; PG8_STAGE(PG8_SB(1, 0), b3, voffB); PG8_SCHED; PG8_MMA_H(1, 0, At, B0, 2, 4); PG8_SCHED; PG8_STAGE(PG8_SB(1, 1), b3 + hstep, voffB); PG8_SCHED;
            PG8_MMA_H(1, 1, At, B1, 0, 2); PG8_SCHED; PG8_STAGE(PG8_SA(1, 0), a3, voffA); PG8_SCHED; PG8_MMA_H(1, 1, At, B1, 2, 4); PG8_BAR; PG8_SCHED;
#else
            PG8_LDB(B0, 0, 0); PG8_LDB(B1, 0, 1); PG8_SCHED; PG8_LDA(At, 0, 0); PG8_STAGE(PG8_SA(1, 1), a1 + hstep, voffA);
            PG8_WAIT_V(8); PG8_WAIT_L(0); PG8_BAR; PG8_MMA(0, 0, At, B0); PG8_MMA(0, 1, At, B1); PG8_BAR; PG8_SCHED;
            PG8_LDA(At, 0, 1); PG8_STAGE(PG8_SB(0, 0), b2, voffB); PG8_STAGE(PG8_SB(0, 1), b2 + hstep, voffB); PG8_STAGE(PG8_SA(0, 0), a2, voffA);
            PG8_WAIT_V(8); PG8_WAIT_L(0); PG8_BAR; PG8_MMA(1, 0, At, B0); PG8_MMA(1, 1, At, B1); PG8_BAR; PG8_SCHED;
            PG8_LDB(B0, 1, 0); PG8_LDB(B1, 1, 1); PG8_SCHED; PG8_LDA(At, 1, 0); PG8_STAGE(PG8_SA(0, 1), a2 + hstep, voffA);
            PG8_WAIT_V(8); PG8_WAIT_L(0); PG8_BAR; PG8_MMA(0, 0, At, B0); PG8_MMA(0, 1, At, B1); PG8_BAR; PG8_SCHED;
            PG8_LDA(At, 1, 1); PG8_STAGE(PG8_SB(1, 0), b3, voffB); PG8_STAGE(PG8_SB(1, 1), b3 + hstep, voffB); PG8_STAGE(PG8_SA(1, 0), a3, voffA);
            PG8_WAIT_V(8); PG8_WAIT_L(0); PG8_BAR; PG8_MMA(1, 0, At, B0); PG8_MMA(1, 1, At, B1); PG8_BAR; PG8_SCHED;
#endif
            } else {
            PG8_LDB(B0, 0, 0); PG8_SCHED; PG8_LDA(At, 0, 0); PG8_STAGE(PG8_SA(1, 1), a1 + hstep, voffA);
            PG8_WAIT_L(8); PG8_BAR; PG8_WAIT_L(0); PG8_MMA(0, 0, At, B0); PG8_BAR; PG8_SCHED;
            PG8_LDB(B1, 0, 1); PG8_STAGE(PG8_SB(0, 0), b2, voffB);
            PG8_BAR; PG8_WAIT_L(0); PG8_MMA(0, 1, At, B1); PG8_BAR;
            PG8_LDA(At, 0, 1); PG8_STAGE(PG8_SA(0, 0), a2, voffA);
            PG8_BAR; PG8_WAIT_L(0); PG8_MMA(1, 0, At, B0); PG8_BAR; PG8_SCHED;
            PG8_STAGE(PG8_SB(0, 1), b2 + hstep, voffB);
            PG8_WAIT_V(6); PG8_BAR; PG8_MMA(1, 1, At, B1); PG8_BAR;
            PG8_LDB(B0, 1, 0); PG8_SCHED; PG8_LDA(At, 1, 0); PG8_STAGE(PG8_SA(0, 1), a2 + hstep, voffA);
            PG8_WAIT_L(8); PG8_BAR; PG8_WAIT_L(0); PG8_MMA(0, 0, At, B0); PG8_BAR; PG8_SCHED;
            PG8_LDB(B1, 1, 1); PG8_STAGE(PG8_SB(1, 0), b3, voffB);
            PG8_BAR; PG8_WAIT_L(0); PG8_MMA(0, 1, At, B1); PG8_BAR;
            PG8_LDA(At, 1, 1); PG8_STAGE(PG8_SA(1, 0), a3, voffA);
            PG8_BAR; PG8_WAIT_L(0); PG8_MMA(1, 0, At, B0); PG8_BAR; PG8_SCHED;
            PG8_STAGE(PG8_SB(1, 1), b3 + hstep, voffB);
            PG8_WAIT_V(6); PG8_BAR; PG8_MMA(1, 1, At, B1); PG8_BAR;
            }
        }
        if constexpr (ALIGN_EPI) { if (wr == 0) PG8_BAR; }
        if constexpr (!Epi::AFTER_DRAIN) { E(acc, cur, wr, wc, fr, fq); S.done(cur); }
        if (!has_next) break;
#pragma unroll
        for (int a = 0; a < 2; ++a)
#pragma unroll
            for (int b = 0; b < 2; ++b)
#pragma unroll
                for (int m = 0; m < 4; ++m)
#pragma unroll
                    for (int n = 0; n < 2; ++n) acc[a][b][m][n] = (f32x4){0.f, 0.f, 0.f, 0.f};
        cur = nxt; cA = nA; cB = nB; ++ui;
        if constexpr (ALIGN_EPI) { if (wr == 1) PG8_BAR; }
    }
    PG8_WAIT_V(0);
    if constexpr (!ALIGN_EPI) { if (wr == 0) PG8_BAR; }
    PG8_BAR;
    if constexpr (Epi::AFTER_DRAIN) { E.fused(acc, cur, wr, wc, fr, fq, lds, wid, lane); S.done(cur); }
#undef PG8_SA
#undef PG8_SB
#undef PG8_STAGE
#undef PG8_LDA
#undef PG8_LDB
#undef PG8_MMA
#undef PG8_WAIT_V
#undef PG8_WAIT_L
#undef PG8_BAR
#undef PG8_SCHED
}
}

constexpr int NWAVES = 8;
constexpr int N_PHASES = 11;
constexpr int N_LAUNCHES = MK_N_LAUNCHES;
constexpr int LDS_BYTES = 155648;
constexpr int RING_BYTES = 131072, LDSCTL_OFF = LDS_BYTES - 512, MISC_OFF = LDSCTL_OFF + 320;
constexpr int CW_BAR = 4096;
#define GAS __attribute__((address_space(1)))
#define LAS __attribute__((address_space(3)))
typedef unsigned short bf16;
typedef unsigned v4u __attribute__((ext_vector_type(4)));
typedef unsigned v2u __attribute__((ext_vector_type(2)));
typedef float f32x4 __attribute__((ext_vector_type(4)));
typedef float f32x16 __attribute__((ext_vector_type(16)));
typedef short bf16x8 __attribute__((ext_vector_type(8)));
typedef short s16x4 __attribute__((ext_vector_type(4)));
typedef short v4i16_t __attribute__((ext_vector_type(4)));
typedef GAS unsigned gu32;
#define LDS_WAIT() asm volatile("s_waitcnt lgkmcnt(0)" ::: "memory")
#define VM_WAIT() asm volatile("s_waitcnt vmcnt(0)" ::: "memory")
__device__ __forceinline__ unsigned pk2(float lo, float hi) { return pg8::cvt_pk_bf16(lo, hi); }
__device__ __forceinline__ float bflo(unsigned w) { return __uint_as_float(w << 16); }
__device__ __forceinline__ float bfhi(unsigned w) { return __uint_as_float(w & 0xffff0000u); }
__device__ __forceinline__ float bf1(bf16 h) { return __uint_as_float((unsigned)h << 16); }
__device__ __forceinline__ float ex2(float x) { return __builtin_amdgcn_exp2f(x); }
__device__ __forceinline__ float sigm(float x) { return __builtin_amdgcn_rcpf(1.f + __builtin_amdgcn_exp2f(-x * LOG2E)); }
__device__ __forceinline__ float wave_sum(float v) {
#pragma unroll
    for (int o = 1; o < 64; o <<= 1) v += __shfl_xor(v, o);
    return v;
}
__device__ __forceinline__ float swap32f(float v) {
    auto rr = __builtin_amdgcn_permlane32_swap(__float_as_uint(v), __float_as_uint(v), false, false);
    return (threadIdx.x & 32) ? __uint_as_float(rr[0]) : __uint_as_float(rr[1]);
}
__device__ __forceinline__ s16x4 trrd(const LAS char* p) { return __builtin_bit_cast(s16x4, __builtin_amdgcn_ds_read_tr16_b64_v4i16((LAS v4i16_t*)p)); }
#define MK8(lo, hi) (bf16x8){lo[0], lo[1], lo[2], lo[3], hi[0], hi[1], hi[2], hi[3]}

#define XB_TMO      128
#define XB_XCNT(j)  (256  + 64 * (j))
#define XB_XSUB(j)  (1280 + 64 * (j))
#define XB_XGEN(j)  (2304 + 64 * (j))
#define XB_TOP      3328
#define XB_TOPGEN   3392
#define XCD_BAR_WORDS 3456
#define XB_SPIN_CAP (1u << 18)

__device__ __forceinline__ unsigned xb_ld(unsigned* p)              { return __hip_atomic_load(p, __ATOMIC_RELAXED, __HIP_MEMORY_SCOPE_AGENT); }
__device__ __forceinline__ unsigned xb_add(unsigned* p, unsigned v) { return __hip_atomic_fetch_add(p, v, __ATOMIC_RELAXED, __HIP_MEMORY_SCOPE_AGENT); }
__device__ __forceinline__ unsigned xb_xcc_id() { return (unsigned)__builtin_amdgcn_s_getreg((3 << 11) | 20) & 0xFu; }
#define XB_SPIN(cond, bar) do { unsigned _sp = 0; while (cond) { __builtin_amdgcn_s_sleep(1); \
    if ((++_sp & 255u) == 0u) { if (xb_ld(&(bar)[XB_TMO])) break; if (_sp > XB_SPIN_CAP) { atomicAdd(&(bar)[XB_TMO], 1u); break; } } } } while (0)

struct XcdBarrier {
    unsigned* bar; unsigned x;
    volatile LAS unsigned* st;
};

__device__ __forceinline__ XcdBarrier xcd_barrier_post(unsigned* bar, volatile LAS unsigned* st) {
    XcdBarrier b; b.bar = bar; b.x = xb_xcc_id(); b.st = st;
    if (threadIdx.x == 0) (void)xb_add(&bar[XB_XCNT(b.x)], 1u);
    return b;
}
__device__ __forceinline__ void xcd_barrier_complete(unsigned* bar, unsigned x, unsigned& nloc, unsigned& nx) {
    const unsigned G = gridDim.x * gridDim.y * gridDim.z;
    unsigned sum, cnt, mine, sp = 0u;
    for (;;) {
        sum = 0u; cnt = 0u; mine = 0u;
#pragma unroll
        for (unsigned j = 0; j < 16; ++j) { const unsigned c = xb_ld(&bar[XB_XCNT(j)]); sum += c; cnt += (c > 0u) ? 1u : 0u; mine = (j == x) ? c : mine; }
        if (sum == G) break;
        __builtin_amdgcn_s_sleep(1);
        if ((++sp & 255u) == 0u) { if (xb_ld(&bar[XB_TMO])) break; if (sp > XB_SPIN_CAP) { atomicAdd(&bar[XB_TMO], 1u); break; } }
    }
    nloc = mine > 0u ? mine : 1u; nx = cnt > 0u ? cnt : 1u;
}

__device__ __forceinline__ void xcd_barrier(const XcdBarrier& b) {
    asm volatile("s_waitcnt vmcnt(0)" ::: "memory");
    __syncthreads();
    if (threadIdx.x == 0) {
        unsigned* bar = b.bar;
        __builtin_amdgcn_s_waitcnt(0);
        unsigned nloc = b.st[0], nx = b.st[1];
        if (nloc == 0u) { xcd_barrier_complete(bar, b.x, nloc, nx); b.st[0] = nloc; b.st[1] = nx; }
        const unsigned old = xb_add(&bar[XB_XSUB(b.x)], 1u);
        const unsigned gen = old / nloc;
        if (old + 1u == (gen + 1u) * nloc) {
            __builtin_amdgcn_fence(__ATOMIC_RELEASE, "agent");
            asm volatile("s_waitcnt vmcnt(0)" ::: "memory");
            const unsigned og = xb_add(&bar[XB_TOP], 1u);
            const unsigned tg = og / nx;
            if (og + 1u == (tg + 1u) * nx) xb_add(&bar[XB_TOPGEN], 1u);
            else XB_SPIN(xb_ld(&bar[XB_TOPGEN]) == tg, bar);
            __builtin_amdgcn_fence(__ATOMIC_ACQUIRE, "agent");
            xb_add(&bar[XB_XGEN(b.x)], 1u);
            asm volatile("s_waitcnt vmcnt(0)" ::: "memory");
        } else {
            XB_SPIN(xb_ld(&bar[XB_XGEN(b.x)]) == gen, bar);
            __builtin_amdgcn_fence(__ATOMIC_ACQUIRE, "agent");
            asm volatile("s_waitcnt vmcnt(0)" ::: "memory");
        }
    }
    __syncthreads();
}

struct Args { const float* in[19]; float* out; unsigned char* ws; int ph_lo, ph_hi, li, pad; };
enum { I_X = 0, I_P, I_NMPRE, I_NMPOST, I_NFPRE, I_NFPOST, I_WIN, I_GNG, I_PEK, I_W1K, I_W2K, I_PEV, I_W1V, I_W2V, I_WOUT, I_WFI, I_WFO, I_WPLE, I_WGATE };
struct Ctx { LAS unsigned char* lds; int tid, lane, wave, vcu, G; };

struct MapId { __device__ __forceinline__ int operator()(int v) const { return v; } };
struct MapWin { __device__ __forceinline__ int operator()(int v) const { return v < 4608 ? v : (v < 6656 ? v - 4608 + 5616 : (v < 7664 ? v - 6656 + 4608 : -1)); } };
struct MapFfn { __device__ __forceinline__ int operator()(int v) const { const int pn = v >> 8, r = v & 255, ch = pn * 128 + 32 * (r >> 6) + (r & 31); return ((r >> 5) & 1) ? DFF + ch : ch; } };
__device__ __forceinline__ int tile_logical(int v) { return (v & ~255) | (64 * ((v >> 5) & 3) + 32 * ((v >> 7) & 1) + (v & 31)); }
template <class MAP>
__device__ __forceinline__ void p0_transpose_item(const float* W, int K, int N, int Nv, bf16* WT, LAS float* scr, int item, int lane, const MAP& map, bool tperm, const float* kscale = nullptr) {
    const int nblk = Nv / 32, kb = item / nblk, nb = item % nblk, k0 = 64 * kb, n0 = 32 * nb;
    const int ac = map(tperm ? tile_logical(n0 + (lane & 31)) : n0 + (lane & 31));
#pragma unroll 16
    for (int i = 0; i < 32; ++i) { const int kk = 2 * i + (lane >> 5); const float ks = kscale ? kscale[k0 + kk] : 1.f; scr[kk * 33 + (lane & 31)] = ac >= 0 ? W[(size_t)(k0 + kk) * N + ac] * ks : 0.f; }
    LDS_WAIT(); asm volatile("" ::: "memory");
    const int c = lane & 7;
#pragma unroll
    for (int j = 0; j < 4; ++j) { const int n = (lane >> 3) + 8 * j; const LAS float* s = scr + (8 * c) * 33 + n;
        v4u o; o.x = pk2(s[0 * 33], s[1 * 33]); o.y = pk2(s[2 * 33], s[3 * 33]); o.z = pk2(s[4 * 33], s[5 * 33]); o.w = pk2(s[6 * 33], s[7 * 33]);
        *(GAS v4u*)(WT + (size_t)(n0 + n) * K + k0 + 8 * c) = o; }
    LDS_WAIT(); asm volatile("" ::: "memory");
}
template <int NR>
__device__ __forceinline__ void rms_rows_to_bf16(const float* x, const float* p, const f32x4 (&gg)[4], bf16* H, bf16* PB, int m0, int stride, int lane) {
    f32x4 v[NR][4], pv[NR];
#pragma unroll
    for (int r = 0; r < NR; ++r) { const GAS f32x4* xr = (const GAS f32x4*)(x + (size_t)(m0 + r * stride) * DM) + lane;
#pragma unroll
        for (int j = 0; j < 4; ++j) v[r][j] = __builtin_nontemporal_load(xr + 64 * j);
        pv[r] = __builtin_nontemporal_load((const GAS f32x4*)(p + (size_t)(m0 + r * stride) * PLE_D) + lane); }
#pragma unroll
    for (int r = 0; r < NR; ++r) { float s = 0.f;
#pragma unroll
        for (int j = 0; j < 4; ++j) s += (v[r][j].x * v[r][j].x + v[r][j].y * v[r][j].y) + (v[r][j].z * v[r][j].z + v[r][j].w * v[r][j].w);
        const float rstd = __builtin_amdgcn_rsqf(wave_sum(s) * (1.f / DM) + RMS_EPS);
        GAS v2u* o8 = (GAS v2u*)(H + (size_t)(m0 + r * stride) * DM) + lane;
#pragma unroll
        for (int j = 0; j < 4; ++j) { v2u w; w.x = pk2(v[r][j].x * rstd * gg[j].x, v[r][j].y * rstd * gg[j].y); w.y = pk2(v[r][j].z * rstd * gg[j].z, v[r][j].w * rstd * gg[j].w); o8[64 * j] = w; }
        v2u w; w.x = pk2(pv[r].x, pv[r].y); w.y = pk2(pv[r].z, pv[r].w); *((GAS v2u*)(PB + (size_t)(m0 + r * stride) * PLE_D) + lane) = w; }
}
__device__ __forceinline__ void p0_prologue(const Ctx& C, const Args& A) {
    LAS float* scr = (LAS float*)(C.lds + C.wave * 16384);
    const int gw = C.vcu * NWAVES + C.wave, NGW = C.G * NWAVES, lane = C.lane;
    unsigned char* ws = A.ws;
    constexpr int I_IN = 16 * (IN_VIRT / 32), I_OUT = 16 * 32, I_FI = 16 * (2 * DFF / 32), I_FO = (DFF / 64) * 32, I_PL = 4 * 32, I_GT = 16 * 32, I_1K = 48 * 3, I_1V = 32 * 2;
    constexpr int NITEMS = I_IN + I_OUT + I_FI + I_FO + I_PL + I_GT + I_1K + I_1V;
#if defined(P0_PROBE)
    for (int it2 = gw; it2 < 2 * NITEMS; it2 += NGW) {
        const int it = it2 >= NITEMS ? it2 - NITEMS : it2;
        int r = it;
#else
    for (int it = gw; it < NITEMS; it += NGW) {
        int r = it;
#endif
        if (r < I_IN) { p0_transpose_item(A.in[I_WIN], DM, IN_TOTAL, IN_VIRT, (bf16*)(ws + WS_WIN), scr, r, lane, MapWin(), true); continue; } r -= I_IN;
        if (r < I_OUT) { p0_transpose_item(A.in[I_WOUT], DM, DM, DM, (bf16*)(ws + WS_WOUT), scr, r, lane, MapId(), true); continue; } r -= I_OUT;
        if (r < I_FI) { p0_transpose_item(A.in[I_WFI], DM, 2 * DFF, 2 * DFF, (bf16*)(ws + WS_WFI), scr, r, lane, MapFfn(), true, A.in[I_NFPRE]); continue; } r -= I_FI;
        if (r < I_FO) { p0_transpose_item(A.in[I_WFO], DFF, DM, DM, (bf16*)(ws + WS_WFO), scr, r, lane, MapId(), true); continue; } r -= I_FO;
        if (r < I_PL) { p0_transpose_item(A.in[I_WPLE], PLE_D, DM, DM, (bf16*)(ws + WS_WPLE), scr, r, lane, MapId(), true); continue; } r -= I_PL;
        if (r < I_GT) { p0_transpose_item(A.in[I_WGATE], DM, DM, DM, (bf16*)(ws + WS_WG), scr, r, lane, MapId(), true); continue; } r -= I_GT;
        if (r < I_1K) { p0_transpose_item(A.in[I_W1K], 3072, 96, 96, (bf16*)(ws + WS_W1K), scr, r, lane, MapId(), false); continue; } r -= I_1K;
        p0_transpose_item(A.in[I_W1V], 2048, 64, 64, (bf16*)(ws + WS_W1V), scr, r, lane, MapId(), false);
    }
    { const int gt = (C.vcu * NWAVES + C.wave) * 64 + lane, NGT = NGW * 64;
      for (int i = gt; i < 96 * 96; i += NGT) { const int n = i / 96, k = i % 96; ((bf16*)(ws + WS_W2K))[i] = (bf16)(pk2(A.in[I_W2K][k * 96 + n], 0.f) & 0xffffu); }
      for (int i = gt; i < 64 * 64; i += NGT) { const int n = i / 64, k = i % 64; ((bf16*)(ws + WS_W2V))[i] = (bf16)(pk2(A.in[I_W2V][k * 64 + n], 0.f) & 0xffffu); } }
    { constexpr int W0 = (NITEMS % (256 * NWAVES)) + 640 <= 256 * NWAVES ? NITEMS % (256 * NWAVES) : 0;
      const int o4 = gw - W0;
      if (o4 >= 0 && o4 < 640) {
        const int o = o4 >> 2, sl = o4 & 3; const bool isk = o < 96; const int j = isk ? o : o - 96, J = isk ? 96 : 64, KQ = isk ? 768 : 512;
        const GAS float* pe = (const GAS float*)A.in[isk ? I_PEK : I_PEV] + sl * KQ; const GAS float* w1 = (const GAS float*)A.in[isk ? I_W1K : I_W1V] + (size_t)sl * KQ * J;
        float s = 0.f;
#pragma unroll 4
        for (int k = lane; k < KQ; k += 64) s += pe[k] * w1[(size_t)k * J + j];
        s = wave_sum(s);
        if (lane == 0) ((GAS float*)(ws + (isk ? WS_C1K : WS_C1V)))[4 * j + sl] = s;
      } }
    bf16* H = (bf16*)((unsigned char*)A.out + OUT_H); bf16* PB = (bf16*)((unsigned char*)A.out + OUT_PBF);
    { f32x4 gg[4];
#pragma unroll
      for (int j = 0; j < 4; ++j) gg[j] = *((const GAS f32x4*)A.in[I_NMPRE] + lane + 64 * j);
      static_assert(M_TOK % (4 * 256 * NWAVES) == 0, "four rows per wave per step");
      for (int m = gw; m < M_TOK; m += 4 * NGW) rms_rows_to_bf16<4>(A.in[I_X], A.in[I_P], gg, H, PB, m, NGW, lane); }
}


__device__ __forceinline__ int crow(int r, int hi) { return (r & 3) + 8 * (r >> 2) + 4 * hi; }
template <int DD, int NJT>
__device__ __forceinline__ void cmp_unit(const Ctx& C, const bf16* src, const bf16* w1t, const bf16* w2t, const float* c1, bf16* dst, int bg, int nt) {
    constexpr int J = DD, KK = 32 * DD, HS = J + 8;
    const int lane = C.lane, w = C.wave, r32 = lane & 31, hi = lane >> 5;
    const int b = bg >> 1, g = bg & 1, n0 = 32 * nt;
    LAS float* red = (LAS float*)C.lds;
    LAS bf16* hidg = (LAS bf16*)(C.lds + 8 * 32 * J * 4);
    f32x16 acc[NJT];
#pragma unroll
    for (int jt = 0; jt < NJT; ++jt) acc[jt] = f32x16{};
    const int n = n0 + r32;
#pragma unroll 1
    for (int li = 0; li < 4; ++li) {
        const int l = 4 * w + li;
        int tok = 16 * n + l; tok = tok < SEQ ? tok : SEQ - 1;
        const bf16* ap = src + ((size_t)(b * SEQ + tok)) * (2 * DD) + g * DD + hi * 8;
        const bf16* bp = w1t + (size_t)r32 * KK + l * DD + hi * 8;
#pragma unroll
        for (int s = 0; s < DD / 16; ++s) {
            const bf16x8 af = *(const bf16x8*)(ap + 16 * s);
#pragma unroll
            for (int jt = 0; jt < NJT; ++jt) { const bf16x8 bfr = *(const bf16x8*)(bp + (size_t)(32 * jt) * KK + 16 * s);
                acc[jt] = __builtin_amdgcn_mfma_f32_32x32x16_bf16(af, bfr, acc[jt], 0, 0, 0); }
        }
    }
#pragma unroll
    for (int jt = 0; jt < NJT; ++jt)
#pragma unroll
        for (int r = 0; r < 16; ++r) red[(w * 32 + crow(r, hi)) * J + 32 * jt + r32] = acc[jt][r];
    __syncthreads();
    for (int e = C.tid; e < 32 * J; e += NWAVES * 64) { const int nn = e / J, j = e % J; const f32x4 c4 = *(const GAS f32x4*)(c1 + 4 * j); float s = (c4.x + c4.y) + (c4.z + c4.w);
#pragma unroll
        for (int ww = 0; ww < 8; ++ww) s += red[(ww * 32 + nn) * J + j];
        const float u = 0.7978845608028654f * (s + 0.044715f * s * s * s);
        const float th = 1.f - 2.f * __builtin_amdgcn_rcpf(1.f + ex2(2.f * LOG2E * u));
        hidg[nn * HS + j] = (bf16)(pk2(0.5f * s * (1.f + th), 0.f) & 0xffffu); }
    __syncthreads();
    if (w < NJT) {
        f32x16 a2 = f32x16{};
#pragma unroll
        for (int s = 0; s < J / 16; ++s) { const bf16x8 af = *(const LAS bf16x8*)(hidg + r32 * HS + 16 * s + 8 * hi); const bf16x8 bfr = *(const bf16x8*)(w2t + (size_t)(32 * w + r32) * J + 16 * s + 8 * hi);
            a2 = __builtin_amdgcn_mfma_f32_32x32x16_bf16(af, bfr, a2, 0, 0, 0); }
#pragma unroll
        for (int r = 0; r < 16; ++r) { const int nn = n0 + crow(r, hi); dst[((size_t)bg * 256 + nn) * J + 32 * w + r32] = (bf16)(pk2(nn < 255 ? a2[r] : 0.f, 0.f) & 0xffffu); }
    }
    __syncthreads();
}
__device__ __forceinline__ void p2_compress(const Ctx& C, const Args& A) {
    unsigned char* ws = A.ws;
#if defined(DBG_CMP_ZERO)
    { v4u z = v4u{0u, 0u, 0u, 0u}; v4u* o = (v4u*)(ws + WS_KCMP);
      for (size_t i = (size_t)C.vcu * 512 + C.tid; i < (size_t)(WS_SSP - WS_KCMP) / 16; i += (size_t)C.G * 512) o[i] = z; }
    return;
#endif
    for (int u = C.vcu; u < 512; u += C.G) {
        const int idx = u & 255, bg = idx >> 3, nt = idx & 7;
        if (u < 256) cmp_unit<96, 3>(C, (const bf16*)(ws + WS_KC), (const bf16*)(ws + WS_W1K), (const bf16*)(ws + WS_W2K), (const float*)(ws + WS_C1K), (bf16*)(ws + WS_KCMP), bg, nt);
        else         cmp_unit<64, 2>(C, (const bf16*)(ws + WS_VC), (const bf16*)(ws + WS_W1V), (const bf16*)(ws + WS_W2V), (const float*)(ws + WS_C1V), (bf16*)(ws + WS_VCMP), bg, nt);
    }
}


constexpr int NSA_KSTR = 208;
constexpr int NSA_KB = 64 * NSA_KSTR;
constexpr int NSA_K0 = 0, NSA_K1 = NSA_KB, NSA_V0 = 2 * NSA_KB, NSA_V1 = NSA_V0 + 8192, NSA_IMPG = NSA_V1 + 8192, NSA_IMPL = NSA_IMPG + 64 * 32 * 4, NSA_WM = NSA_IMPL + 65 * 32 * 4, NSA_END = NSA_WM + 64, NSA_OUT = 61440, NSA_OUT_END = NSA_OUT + 8 * 10240, NSA_IMPS_END = NSA_OUT_END;
static_assert(NSA_END <= NSA_OUT && NSA_IMPS_END <= LDSCTL_OFF && NSA_OUT_END <= LDSCTL_OFF && (NSA_WM % 16) == 0, "NSA LDS map");
constexpr float NEGBIG = -1e30f, M_INIT = -5e29f;

constexpr float NSA_THR = 8.f;
template <int MODE, bool SEL, bool IMPS = false>
__device__ __forceinline__ void nsa_branch(const Ctx& C, const GAS bf16* Kg, int kp, const GAS bf16* Vg, int vp, unsigned long long tilemask,
                                           const bf16x8 (&qf)[6], float& mref, bool& has, float& l, f32x16& o0, f32x16& o1,
                                           int t, int lo, int hq, bool lane_en, unsigned long long selmask, unsigned long long wavemask,
                                           int wlo, int whi, int wlo_in, int whi_in, float slope2, int ka, int kb, float invl, int qi) {
    constexpr bool LOADV = (MODE == 0);
    const int tid = C.tid, lane = C.lane, r32 = lane & 31, hi = lane >> 5;
    LAS char* lds = (LAS char*)C.lds;
    const int wv_ = C.wave;
    const int kc_a = wv_ * 64 + lane, kc_b = kc_a + 512;
    const bool kv_a = (kc_a % 13) < 12, kv_b = (wv_ + 8 < 13) && (kc_b % 13) < 12;
    const int ko_a = (kc_a / 13) * kp * 2 + (kc_a % 13) * 16, ko_b = (kc_b / 13) * kp * 2 + (kc_b % 13) * 16;
    const int vo_ = wv_ * 1024 + lane * 16;
    const int vo_g = ((vo_ & 4095) >> 6) * vp * 2 + ((vo_ >> 12) * 4 + ((vo_ & 63) >> 4)) * 16;
    const __amdgpu_buffer_rsrc_t rsK = __builtin_amdgcn_make_buffer_rsrc((void*)Kg, 0, 0x7fffffff, 0x00020000), rsV = __builtin_amdgcn_make_buffer_rsrc((void*)Vg, 0, 0x7fffffff, 0x00020000);
#define NSA_DMA(bb, jj) do { const int ks_ = 64 * (jj) * kp * 2, vs_ = 64 * (jj) * vp * 2; \
        if (kv_a) __builtin_amdgcn_raw_ptr_buffer_load_lds(rsK, (LAS unsigned*)(lds + ((bb) ? NSA_K1 : NSA_K0) + wv_ * 1024), 16, ko_a, ks_, 0, 0); \
        if (kv_b) __builtin_amdgcn_raw_ptr_buffer_load_lds(rsK, (LAS unsigned*)(lds + ((bb) ? NSA_K1 : NSA_K0) + (wv_ + 8) * 1024), 16, ko_b, ks_, 0, 0); \
        if (LOADV) __builtin_amdgcn_raw_ptr_buffer_load_lds(rsV, (LAS unsigned*)(lds + ((bb) ? NSA_V1 : NSA_V0) + wv_ * 1024), 16, vo_g, vs_, 0, 0); } while (0)
#define NSA_DMA_WAIT() asm volatile("s_waitcnt vmcnt(0)" ::: "memory")
#define NSA_TOPBIT(x) (63 - __builtin_clzll(x))
    unsigned long long rem = tilemask;
    if (rem == 0ull) return;
    int j = NSA_TOPBIT(rem); rem &= ~(1ull << j);
    NSA_DMA(0, j); NSA_DMA_WAIT(); __syncthreads();
    int buf = 0;
    const float sa = slope2 * (float)ka;
    const unsigned span = (unsigned)(hq - lo);
    for (;;) {
        const bool more = rem != 0ull; int jn = 0;
        if (more) { jn = NSA_TOPBIT(rem); rem &= ~(1ull << jn); NSA_DMA(buf ^ 1, jn); }
        const bool wneed = SEL ? (((wavemask >> j) & 1ull) != 0ull) : true;
        if (wneed) {
            const bool en = lane_en && (SEL ? (((selmask >> j) & 1ull) != 0ull) : true);
            const bool do1 = (64 * j + 32 <= whi) && (64 * j + 63 >= wlo), do0 = (64 * j <= whi) && (64 * j + 31 >= wlo);
            const LAS char* kt_ = lds + (buf ? NSA_K1 : NSA_K0) + r32 * NSA_KSTR + hi * 16;
            const LAS char* vt_ = lds + (buf ? NSA_V1 : NSA_V0) + ((lane >> 4) & 1) * 32 + (lane & 3) * 8 + (4 * hi + ((lane & 15) >> 2)) * 64;
            bf16x8 kfA[6], kfB[6]; s16x4 vA[8], vB[8];
            if (do1) {
#pragma unroll
                for (int s = 0; s < 6; ++s) kfA[s] = *(const LAS bf16x8*)(kt_ + 32 * NSA_KSTR + 32 * s);
                if (MODE == 0) {
#pragma unroll
                    for (int q = 0; q < 4; ++q) { vA[2 * q] = trrd(vt_ + 2048 + (q >> 1) * 4096 + (q & 1) * 1024); vA[2 * q + 1] = trrd(vt_ + 2048 + (q >> 1) * 4096 + (q & 1) * 1024 + 512); }
                }
            }
            if (do0) {
#pragma unroll
                for (int s = 0; s < 6; ++s) kfB[s] = *(const LAS bf16x8*)(kt_ + 32 * s);
                if (MODE == 0) {
#pragma unroll
                    for (int q = 0; q < 4; ++q) { vB[2 * q] = trrd(vt_ + (q >> 1) * 4096 + (q & 1) * 1024); vB[2 * q + 1] = trrd(vt_ + (q >> 1) * 4096 + (q & 1) * 1024 + 512); }
                }
            }
#pragma unroll
            for (int sb = 0; sb < 2; ++sb) {
                const int sub = 1 - sb;
                const int i0 = 64 * j + 32 * sub;
                if (sub ? do1 : do0) {
                    const int ib = i0 + 4 * hi;
                    const float bias0 = en ? (-slope2 * (float)(t - (ka * ib + kb)) - mref) : NEGBIG;
                    f32x16 p;
                    if (i0 >= wlo_in && i0 + 31 <= whi_in) {
#pragma unroll
                        for (int r = 0; r < 16; ++r) { const int ci = (r & 3) + 8 * (r >> 2); p[r] = bias0 + sa * (float)ci; }
                    } else {
#pragma unroll
                        for (int r = 0; r < 16; ++r) { const int ci = (r & 3) + 8 * (r >> 2); const bool v = ((unsigned)(ib + ci - lo) <= span); p[r] = v ? (bias0 + sa * (float)ci) : NEGBIG; }
                    }
#pragma unroll
                    for (int s = 0; s < 6; ++s) p = __builtin_amdgcn_mfma_f32_32x32x16_bf16(sub ? kfA[s] : kfB[s], qf[s], p, 0, 0, 0);
                    if (MODE == 0) {
                        float mx = __builtin_fmaxf(__builtin_fmaxf(p[0], p[1]), p[2]);
#pragma unroll
                        for (int r = 3; r < 15; r += 2) mx = __builtin_fmaxf(__builtin_fmaxf(mx, p[r]), p[r + 1]);
                        mx = __builtin_fmaxf(mx, p[15]);
                        { auto rr = __builtin_amdgcn_permlane32_swap(__float_as_uint(mx), __float_as_uint(mx), false, false); mx = __builtin_fmaxf(__uint_as_float(rr[0]), __uint_as_float(rr[1])); }
                        const bool valid = mx > -1e29f;
                        const bool mv = valid && (!has || mx > NSA_THR);
                        if (__any(mv)) {
                            const float delta = mv ? mx : 0.f, f = (mv && has) ? ex2(-delta) : 1.f;
                            mref += delta; has = has || valid;
#pragma unroll
                            for (int r = 0; r < 16; ++r) p[r] -= delta;
                            l *= f; o0 = o0 * f; o1 = o1 * f;
                        }
#pragma unroll
                        for (int r = 0; r < 16; ++r) p[r] = ex2(p[r]);
                        const float g0_ = (p[0] + p[1]) + (p[2] + p[3]), g1_ = (p[4] + p[5]) + (p[6] + p[7]), g2_ = (p[8] + p[9]) + (p[10] + p[11]), g3_ = (p[12] + p[13]) + (p[14] + p[15]);
                        l += (g0_ + g1_) + (g2_ + g3_);
                        v4u w0, w1; w0.x = pk2(p[0], p[1]); w0.y = pk2(p[2], p[3]); w0.z = pk2(p[4], p[5]); w0.w = pk2(p[6], p[7]);
                        w1.x = pk2(p[8], p[9]); w1.y = pk2(p[10], p[11]); w1.z = pk2(p[12], p[13]); w1.w = pk2(p[14], p[15]);
                        const bf16x8 pa0 = __builtin_bit_cast(bf16x8, w0), pa1 = __builtin_bit_cast(bf16x8, w1);
                        if (IMPS) {
                            LAS unsigned* ip = (LAS unsigned*)(lds + NSA_OUT + ((C.wave * 8 + (i0 >> 5)) * 320 + lane) * 4);
                            ip[0] = pk2(g0_, g1_); ip[64] = pk2(g2_, g3_); ip[128] = __builtin_amdgcn_perm(w0.w, w0.y, 0x07060302u); ip[192] = __builtin_amdgcn_perm(w1.w, w1.y, 0x07060302u); ip[256] = __float_as_uint(mref); }
                        if (sub) {
                            o0 = __builtin_amdgcn_mfma_f32_32x32x16_bf16(MK8(vA[0], vA[1]), pa0, o0, 0, 0, 0); o1 = __builtin_amdgcn_mfma_f32_32x32x16_bf16(MK8(vA[4], vA[5]), pa0, o1, 0, 0, 0);
                            o0 = __builtin_amdgcn_mfma_f32_32x32x16_bf16(MK8(vA[2], vA[3]), pa1, o0, 0, 0, 0); o1 = __builtin_amdgcn_mfma_f32_32x32x16_bf16(MK8(vA[6], vA[7]), pa1, o1, 0, 0, 0);
                        } else {
                            o0 = __builtin_amdgcn_mfma_f32_32x32x16_bf16(MK8(vB[0], vB[1]), pa0, o0, 0, 0, 0); o1 = __builtin_amdgcn_mfma_f32_32x32x16_bf16(MK8(vB[4], vB[5]), pa0, o1, 0, 0, 0);
                            o0 = __builtin_amdgcn_mfma_f32_32x32x16_bf16(MK8(vB[2], vB[3]), pa1, o0, 0, 0, 0); o1 = __builtin_amdgcn_mfma_f32_32x32x16_bf16(MK8(vB[6], vB[7]), pa1, o1, 0, 0, 0);
                        }
                    } else {
                        LAS float* impG = (LAS float*)(lds + NSA_IMPG); LAS float* impL = (LAS float*)(lds + NSA_IMPL);
#pragma unroll
                        for (int r = 0; r < 16; ++r) p[r] = ex2(p[r]);
#pragma unroll
                        for (int k = 0; k < 4; ++k) { float G = ((p[4 * k] + p[4 * k + 1]) + (p[4 * k + 2] + p[4 * k + 3])) * invl, L = p[4 * k + 3] * invl;
                            G += __shfl_xor(G, 1); L += __shfl_xor(L, 1); G += __shfl_xor(G, 2); L += __shfl_xor(L, 2); G += __shfl_xor(G, 4); L += __shfl_xor(L, 4);
                            if ((r32 & 7) == 0) { const int jb = (i0 >> 2) + 2 * k + hi; impG[jb * 32 + qi] = G; impL[(jb + 1) * 32 + qi] = L; } }
                    }
                }
            }
        }
        NSA_DMA_WAIT();
        __syncthreads();
        if (!more) break;
        j = jn; buf ^= 1;
    }
#undef NSA_DMA
#undef NSA_DMA_WAIT
#undef NSA_TOPBIT
}

__device__ __forceinline__ void nsa_unit(const Ctx& C, const Args& A, int b, int g, int c) {
    unsigned long long wsu = (unsigned long long)A.ws, outu = (unsigned long long)A.out;
    asm volatile("" : "+s"(wsu), "+s"(outu));
    const GAS unsigned char* ws = (const GAS unsigned char*)wsu; GAS unsigned char* outb = (GAS unsigned char*)outu;
    const int tid = C.tid, lane = C.lane, w = C.wave, r32 = lane & 31, hi = lane >> 5, q4 = r32 >> 3, hh = r32 & 7;
    LAS char* lds = (LAS char*)C.lds;
    const int qi = 4 * w + q4, t = 32 * c + qi, head = g * 8 + hh;
    const size_t row = (size_t)b * SEQ + t;
    const float slope2 = ex2(-0.5f * (float)(head + 1)) * LOG2E;
    const int tmin = 32 * c + 4 * w, tmax = tmin + 3;
    for (int i = tid; i < (64 + 65) * 32; i += NWAVES * 64) ((LAS float*)(lds + NSA_IMPG))[i] = 0.f;
    bf16x8 qf[6];
    { const GAS bf16* qp = (const GAS bf16*)(ws + WS_NQ) + row * 1536 + head * 96 + hi * 8;
#pragma unroll
      for (int s = 0; s < 6; ++s) qf[s] = *(const GAS bf16x8*)(qp + 16 * s); }
    const GAS bf16* ng = (const GAS bf16*)(ws + WS_NG) + row * 48;
    const float g_c = sigm(bf1(ng[head])), g_s = sigm(bf1(ng[16 + head])), g_w = sigm(bf1(ng[32 + head]));
    LAS float* ost = (LAS float*)(lds + NSA_OUT) + w * 2560 + lane;
    const size_t bg = (size_t)(b * 2 + g);
    __syncthreads();
    const int nmax = (t - 31) >> 4;
    const int wnmax = (tmax - 31) >> 4;
    const unsigned long long cmask = (2ull << ((2 * c) >> 6)) - 1ull;
    float m_c = 0.f, l_c = 0.f, invl_c; bool has_c = false;
    const int wnmin = (tmin - 31) >> 4;
    {
        f32x16 o0 = f32x16{}, o1 = f32x16{};
        nsa_branch<0, false, true>(C, (const GAS bf16*)(ws + WS_KCMP) + bg * 256 * 96, 96, (const GAS bf16*)(ws + WS_VCMP) + bg * 256 * 64, 64, cmask, qf, m_c, has_c, l_c, o0, o1,
                             t, 0, nmax, nmax >= 0, 0ull, 0ull, 0, wnmax, 0, wnmin, slope2, 16, 31, 0.f, qi);
        { auto rr = __builtin_amdgcn_permlane32_swap(__float_as_uint(l_c), __float_as_uint(l_c), false, false); l_c = __uint_as_float(rr[0]) + __uint_as_float(rr[1]); }
        invl_c = l_c > 0.f ? __builtin_amdgcn_rcpf(l_c) : 0.f;
        { LAS float* impG = (LAS float*)(lds + NSA_IMPG); LAS float* impL = (LAS float*)(lds + NSA_IMPL);
          const int nslot = wnmax >= 0 ? (wnmax >> 5) + 1 : 0;
          for (int slot = 0; slot < nslot; ++slot) {
              const LAS unsigned* ip = (const LAS unsigned*)(lds + NSA_OUT + ((w * 8 + slot) * 320 + lane) * 4);
              const unsigned g01 = ip[0], g23 = ip[64], l01 = ip[128], l23 = ip[192];
              const float scl = ex2(__builtin_fminf(__uint_as_float(ip[256]) - m_c, 0.f)) * invl_c;
              const float Gv[4] = {bflo(g01), bfhi(g01), bflo(g23), bfhi(g23)}, Lv[4] = {bflo(l01), bfhi(l01), bflo(l23), bfhi(l23)};
#pragma unroll
              for (int k = 0; k < 4; ++k) { float G = Gv[k] * scl, L = Lv[k] * scl;
                  G += __shfl_xor(G, 1); L += __shfl_xor(L, 1); G += __shfl_xor(G, 2); L += __shfl_xor(L, 2); G += __shfl_xor(G, 4); L += __shfl_xor(L, 4);
                  if ((r32 & 7) == 0) { const int jb = 8 * slot + 2 * k + hi; impG[jb * 32 + qi] = G; impL[(jb + 1) * 32 + qi] = L; } } } }
        const float sc = g_c * invl_c;
#pragma unroll
        for (int r = 0; r < 16; ++r) { ost[64 * r] = o0[r] * sc; ost[64 * (16 + r)] = o1[r] * sc; }
    }
    unsigned long long mymask = 0ull, wmask = 0ull;
    {
        const LAS float* impG = (const LAS float*)(lds + NSA_IMPG); const LAS float* impL = (const LAS float*)(lds + NSA_IMPL);
#pragma unroll
        for (int qq = 0; qq < 4; ++qq) {
            const int qx = 4 * w + qq, tq = 32 * c + qx, cur = tq >> 6, jj = lane;
            const float imp = impG[jj * 32 + qx] + impL[jj * 32 + qx];
            const bool forced = (jj == 0) | (jj == cur) | (jj == cur - 1);
            const int key = forced ? (0x7f000000 | (63 - jj)) : (jj <= cur ? ((__float_as_int(imp) & ~63) | (63 - jj)) : (-1 - jj));
            int rank = 0;
#pragma unroll
            for (int i = 0; i < 64; ++i) { const int ki = __builtin_amdgcn_readlane(key, i); rank += (ki > key) ? 1 : 0; }
            const unsigned long long sm = __ballot(rank < 16);
            wmask |= sm; if (q4 == qq) mymask = sm;
        }
        if (lane == 0) *(LAS unsigned long long*)(lds + NSA_WM + 8 * w) = wmask;
    }
    __syncthreads();
    unsigned long long umask = 0ull;
#pragma unroll
    for (int i = 0; i < 8; ++i) umask |= *(const LAS unsigned long long*)(lds + NSA_WM + 8 * i);
    const int curmax = (32 * c + 31) >> 6;
    umask &= (2ull << curmax) - 1ull;
    { const unsigned ulo = __builtin_amdgcn_readfirstlane((unsigned)umask), uhi = __builtin_amdgcn_readfirstlane((unsigned)(umask >> 32)); umask = ((unsigned long long)uhi << 32) | ulo; }
    { const unsigned wlo_ = __builtin_amdgcn_readfirstlane((unsigned)wmask), whi_ = __builtin_amdgcn_readfirstlane((unsigned)(wmask >> 32)); wmask = ((unsigned long long)whi_ << 32) | wlo_; }
    {
        float m_s = 0.f, l_s = 0.f; bool has_s = false; f32x16 o0 = f32x16{}, o1 = f32x16{};
        nsa_branch<0, true>(C, (const GAS bf16*)(ws + WS_KS) + ((size_t)b * SEQ) * 192 + g * 96, 192, (const GAS bf16*)(ws + WS_VS) + ((size_t)b * SEQ) * 128 + g * 64, 128, umask, qf, m_s, has_s, l_s, o0, o1,
                            t, 0, t, true, mymask, wmask, 0, tmax, 0, tmin, slope2, 1, 0, 0.f, qi);
        { auto rr = __builtin_amdgcn_permlane32_swap(__float_as_uint(l_s), __float_as_uint(l_s), false, false); l_s = __uint_as_float(rr[0]) + __uint_as_float(rr[1]); }
        const float sc = g_s * (l_s > 0.f ? __builtin_amdgcn_rcpf(l_s) : 0.f);
#pragma unroll
        for (int r = 0; r < 16; ++r) { ost[64 * r] += o0[r] * sc; ost[64 * (16 + r)] += o1[r] * sc; }
    }
    {
        const int plo = 32 * c - 511 > 0 ? 32 * c - 511 : 0;
        const int jlo = plo >> 6, jhi = (32 * c + 31) >> 6;
        const unsigned long long wm_ = ((2ull << jhi) - 1ull) & ~((1ull << jlo) - 1ull);
        float m_w = 0.f, l_w = 0.f; bool has_w = false; f32x16 o0 = f32x16{}, o1 = f32x16{};
        nsa_branch<0, false>(C, (const GAS bf16*)(ws + WS_KW) + ((size_t)b * SEQ) * 192 + g * 96, 192, (const GAS bf16*)(ws + WS_VW) + ((size_t)b * SEQ) * 128 + g * 64, 128, wm_, qf, m_w, has_w, l_w, o0, o1,
                             t, t - 511, t, true, 0ull, 0ull, tmin - 511, tmax, tmax - 511, tmin, slope2, 1, 0, 0.f, qi);
        { auto rr = __builtin_amdgcn_permlane32_swap(__float_as_uint(l_w), __float_as_uint(l_w), false, false); l_w = __uint_as_float(rr[0]) + __uint_as_float(rr[1]); }
        const float sc = g_w * (l_w > 0.f ? __builtin_amdgcn_rcpf(l_w) : 0.f);
        f32x16 out0, out1;
#pragma unroll
        for (int r = 0; r < 16; ++r) { out0[r] = ost[64 * r] + o0[r] * sc; out1[r] = ost[64 * (16 + r)] + o1[r] * sc; }
        LAS char* ot = lds + NSA_K0 + w * 4096;
#pragma unroll
        for (int k = 0; k < 4; ++k) { v2u w0; w0.x = pk2(out0[4 * k], out0[4 * k + 1]); w0.y = pk2(out0[4 * k + 2], out0[4 * k + 3]); *(LAS v2u*)(ot + q4 * 1024 + hh * 128 + (8 * k + 4 * hi) * 2) = w0;
            v2u w1; w1.x = pk2(out1[4 * k], out1[4 * k + 1]); w1.y = pk2(out1[4 * k + 2], out1[4 * k + 3]); *(LAS v2u*)(ot + q4 * 1024 + hh * 128 + (32 + 8 * k + 4 * hi) * 2) = w1; }
        GAS unsigned char* ob = outb + OUT_NSA + ((size_t)b * SEQ + 32 * c + 4 * w) * 2048 + g * 1024;
#pragma unroll
        for (int i = 0; i < 4; ++i) { const v4u v = *(const LAS v4u*)(ot + i * 1024 + lane * 16); *(GAS v4u*)(ob + (size_t)i * 2048 + lane * 16) = v; }
    }
}
__device__ __forceinline__ void p3_nsa(const Ctx& C, const Args& A) {
#if defined(DBG_COPY_OFF)
    { const bf16* src = (const bf16*)(A.ws + (size_t)DBG_COPY_OFF * MiB); bf16* o = (bf16*)((unsigned char*)A.out + OUT_NSA);
      for (size_t i = (size_t)C.vcu * 512 + C.tid; i < (size_t)M_TOK * 1024; i += (size_t)C.G * 512) { const size_t r = (i >> 10) & DBG_COPY_RMASK, c = i & 1023; o[i] = src[r * DBG_COPY_LD + (c % DBG_COPY_LD)]; } }
    return;
#endif
#if defined(DBG_NSA_ZERO)
    { v4u z = v4u{0u, 0u, 0u, 0u}; v4u* o = (v4u*)((unsigned char*)A.out + OUT_NSA);
      for (size_t i = (size_t)C.vcu * 512 + C.tid; i < (size_t)M_TOK * 1024 * 2 / 16; i += (size_t)C.G * 512) o[i] = z; }
    return;
#endif
    for (int u = C.vcu; u < 4096; u += C.G) {
        const int bg = (u & 255) >> 3, c = (u & 7) + 8 * (u >> 8);
        nsa_unit(C, A, bg >> 1, bg & 1, c);
    }
}


constexpr int RT_KZ = 0, RT_KZS = 144, RT_V = 128 * RT_KZS, RT_R = RT_V + 32768, RT_Y = RT_R + 128 * RT_KZS, RT_YS = 528, RT_END = RT_Y + 8 * 16 * RT_YS;
static_assert(RT_END <= LDSCTL_OFF, "retention LDS map");
typedef float f32x4v __attribute__((ext_vector_type(4)));
#ifndef RT_SPLIT
#define RT_SPLIT 18
#endif
#define RT_BAR() asm volatile("s_waitcnt lgkmcnt(0)\n\ts_barrier" ::: "memory")

__device__ __forceinline__ void ret_unit(const Ctx& C, const Args& A, int b, int h, int seg) {
    unsigned char* ws = A.ws;
    const int tid = C.tid, lane = C.lane, w = C.wave, i_in = lane & 15, fq = lane >> 4;
    LAS char* lds = (LAS char*)C.lds;
    const float eps_g = ex2(-5.f - (float)h);
    const float lg = -eps_g * (1.f + eps_g * (0.5f + eps_g * (0.33333334f + eps_g * (0.25f + eps_g * (0.2f + eps_g * 0.16666667f))))) * LOG2E;
    const float dec128 = ex2(128.f * lg);
    const int ic = 16 * w + i_in;
    const float gi = ex2((float)(ic - 127) * lg), xi = ex2((float)(ic + 1) * lg);
    unsigned long long wsu = (unsigned long long)ws, nsu = (unsigned long long)((const unsigned char*)A.out + OUT_NSA);
    const GAS bf16* wsb = (const GAS bf16*)wsu; const GAS bf16* nsb = (const GAS bf16*)nsu;
#define RT_OPAQUE() do { asm volatile("" : "+s"(wsu), "+s"(nsu)); wsb = (const GAS bf16*)wsu; nsb = (const GAS bf16*)nsu; } while (0)
    constexpr unsigned O_RQ = (unsigned)(WS_RQ / 2), O_RK = (unsigned)(WS_RK / 2), O_RV = (unsigned)(WS_RV / 2), O_RG = (unsigned)(WS_RG / 2), O_MG = (unsigned)(WS_MG / 2), O_MX = (unsigned)(WS_MIXIN / 2);
    const int ec = 8 * (lane & 15), er = lane >> 4;
    const f32x4 gnA = *(const f32x4*)(A.in[I_GNG] + h * 128 + ec), gnB = *(const f32x4*)(A.in[I_GNG] + h * 128 + ec + 4);
    f32x4v R[4];
#pragma unroll
    for (int dt = 0; dt < 4; ++dt) R[dt] = f32x4v{0.f, 0.f, 0.f, 0.f};
    const int tq = i_in >> 2, tp = i_in & 3;
    const int c_first = seg ? RT_SPLIT : 0, n_total = seg ? 32 : RT_SPLIT;
    if (c_first == 0) {
#pragma unroll
        for (int dt = 0; dt < 4; ++dt)
#pragma unroll
            for (int r = 0; r < 4; ++r) *(LAS bf16*)(lds + RT_R + (16 * w + 4 * fq + r) * RT_KZS + (16 * dt + i_in) * 2) = (bf16)0;
    }
    v4u sK[2], sV[4]; bf16x8 qn[2] = {bf16x8{}, bf16x8{}};
#define RT_LOADKV(chn) do { const unsigned T_ = (unsigned)(b * SEQ + (chn) * 128); \
        _Pragma("unroll") for (int i_ = 0; i_ < 2; ++i_) { const unsigned x_ = tid + 512 * i_; sK[i_] = *(const GAS v4u*)(wsb + (O_RK + (T_ + (x_ >> 3)) * 512u + h * 64 + (x_ & 7) * 8)); } \
        _Pragma("unroll") for (int i_ = 0; i_ < 4; ++i_) { const unsigned x_ = tid + 512 * i_; sV[i_] = *(const GAS v4u*)(wsb + (O_RV + (T_ + (x_ >> 4)) * 1024u + h * 128 + (x_ & 15) * 8)); } } while (0)
#define RT_LOADQ(chn) do { const unsigned qo_ = O_RQ + (unsigned)(b * SEQ + (chn) * 128 + ic) * 512u + h * 64 + 8 * fq; qn[0] = *(const GAS bf16x8*)(wsb + qo_); qn[1] = *(const GAS bf16x8*)(wsb + qo_ + 32); } while (0)
    RT_LOADKV(0); if (c_first == 0) RT_LOADQ(0);
#pragma unroll 1
    for (int ch = 0; ch < n_total; ++ch) {
        RT_OPAQUE();
        const bool full = ch >= c_first;
        const unsigned T0 = (unsigned)(b * SEQ + ch * 128);
#pragma unroll
        for (int i = 0; i < 2; ++i) { const int x = tid + 512 * i, rr = x >> 3, cc = x & 7; const v4u kv = sK[i];
            const float z = ex2((float)(127 - rr) * lg) * 0.125f;
            v4u o; o.x = pk2(bflo(kv.x) * z, bfhi(kv.x) * z); o.y = pk2(bflo(kv.y) * z, bfhi(kv.y) * z); o.z = pk2(bflo(kv.z) * z, bfhi(kv.z) * z); o.w = pk2(bflo(kv.w) * z, bfhi(kv.w) * z);
            *(LAS v4u*)(lds + RT_KZ + rr * RT_KZS + cc * 16) = o; }
#pragma unroll
        for (int i = 0; i < 4; ++i) { const int x = tid + 512 * i, rr = x >> 4, cc = x & 15;
            *(LAS v4u*)(lds + RT_V + (cc >> 1) * 4096 + rr * 32 + (cc & 1) * 16) = sV[i]; }
        const bf16x8 qf0 = qn[0], qf1 = qn[1];
        RT_BAR();
        if (ch + 1 < n_total) { RT_LOADKV(ch + 1); if (ch + 1 >= c_first) RT_LOADQ(ch + 1); }
        v4u eRG[4], eGA[4], eGB[4], eNS[4];
        if (full) {
#pragma unroll
            for (int k = 0; k < 4; ++k) { const unsigned rw = T0 + 16 * w + 4 * k + er; const unsigned e0 = h * 128 + ec;
                eRG[k] = *(const GAS v4u*)(wsb + (O_RG + rw * 1024u + e0)); eGA[k] = *(const GAS v4u*)(wsb + (O_MG + rw * 2048u + e0));
#if defined(RT_PROBE) && RT_PROBE == 2
                eGB[k] = *(const GAS v4u*)(wsb + (O_MG + rw * 2048u + 1024u + e0)); eNS[k] = *(const GAS v4u*)(nsb + (rw * 1024u + e0));
#endif
                }
        }
        if (full) {
            f32x4v acc[8];
#pragma unroll
            for (int et = 0; et < 8; ++et) { const LAS char* rp = lds + RT_R + (16 * et + i_in) * RT_KZS + fq * 16;
                f32x4v a = f32x4v{0.f, 0.f, 0.f, 0.f};
                a = __builtin_amdgcn_mfma_f32_16x16x32_bf16(*(const LAS bf16x8*)rp, qf0, a, 0, 0, 0);
                a = __builtin_amdgcn_mfma_f32_16x16x32_bf16(*(const LAS bf16x8*)(rp + 64), qf1, a, 0, 0, 0);
                acc[et] = a * xi; }
            bf16x8 pf[4];
#pragma unroll
            for (int a = 0; a < 4; ++a) {
                v4u pw = v4u{0u, 0u, 0u, 0u};
                if (2 * a <= w) {
#pragma unroll
                    for (int hf = 0; hf < 2; ++hf) { const int jt = 2 * a + hf;
                        if (jt <= w) { const LAS char* kp = lds + RT_KZ + (16 * jt + i_in) * RT_KZS + fq * 16;
                            f32x4v s = f32x4v{0.f, 0.f, 0.f, 0.f};
                            s = __builtin_amdgcn_mfma_f32_16x16x32_bf16(*(const LAS bf16x8*)kp, qf0, s, 0, 0, 0);
                            s = __builtin_amdgcn_mfma_f32_16x16x32_bf16(*(const LAS bf16x8*)(kp + 64), qf1, s, 0, 0, 0);
                            float pv[4];
#pragma unroll
                            for (int r = 0; r < 4; ++r) pv[r] = (jt < w || (4 * fq + r) <= i_in) ? s[r] * gi : 0.f;
                            if (hf == 0) { pw.x = pk2(pv[0], pv[1]); pw.y = pk2(pv[2], pv[3]); } else { pw.z = pk2(pv[0], pv[1]); pw.w = pk2(pv[2], pv[3]); } } }
                }
                pf[a] = __builtin_bit_cast(bf16x8, pw);
            }
#if !defined(RT_PROBE) || RT_PROBE != 2
#pragma unroll
            for (int k = 0; k < 4; ++k) { const unsigned rw = T0 + 16 * w + 4 * k + er; const unsigned e0 = h * 128 + ec;
                eGB[k] = *(const GAS v4u*)(wsb + (O_MG + rw * 2048u + 1024u + e0)); eNS[k] = *(const GAS v4u*)(nsb + (rw * 1024u + e0)); }
#endif
#pragma unroll
            for (int a = 0; a < 4; ++a) {
                if (2 * a <= w) {
#pragma unroll
                    for (int et = 0; et < 8; ++et) { const LAS char* vp = lds + RT_V + et * 4096 + (32 * a + 4 * fq + tq) * 32 + tp * 8;
                        const s16x4 lo_ = trrd(vp), hi_ = trrd(vp + 16 * 32);
                        acc[et] = __builtin_amdgcn_mfma_f32_16x16x32_bf16(MK8(lo_, hi_), pf[a], acc[et], 0, 0, 0); }
                }
            }
            float s1 = 0.f;
#pragma unroll
            for (int et = 0; et < 8; ++et) s1 += (acc[et][0] + acc[et][1]) + (acc[et][2] + acc[et][3]);
            s1 += __shfl_xor(s1, 16); s1 += __shfl_xor(s1, 32);
            const float mu = s1 * (1.f / 128.f);
            float s2 = 0.f;
#pragma unroll
            for (int et = 0; et < 8; ++et) { const f32x4v dlt = acc[et] - mu; s2 += (dlt[0] * dlt[0] + dlt[1] * dlt[1]) + (dlt[2] * dlt[2] + dlt[3] * dlt[3]); }
            s2 += __shfl_xor(s2, 16); s2 += __shfl_xor(s2, 32);
            const float rstd = __builtin_amdgcn_rsqf(s2 * (1.f / 128.f) + GN_EPS);
            LAS char* yw = lds + RT_Y + w * (16 * RT_YS);
#pragma unroll
            for (int et = 0; et < 8; ++et) *(LAS f32x4v*)(yw + i_in * RT_YS + (16 * et + 4 * fq) * 4) = (acc[et] - mu) * rstd;
            LDS_WAIT();
#pragma unroll
            for (int k = 0; k < 4; ++k) { const f32x4v ya = *(const LAS f32x4v*)(yw + (4 * k + er) * RT_YS + ec * 4), yb = *(const LAS f32x4v*)(yw + (4 * k + er) * RT_YS + ec * 4 + 16);
                const float yf_[8] = {ya[0], ya[1], ya[2], ya[3], yb[0], yb[1], yb[2], yb[3]};
                const unsigned rg_[4] = {eRG[k].x, eRG[k].y, eRG[k].z, eRG[k].w}, ga_[4] = {eGA[k].x, eGA[k].y, eGA[k].z, eGA[k].w};
                const unsigned gb_[4] = {eGB[k].x, eGB[k].y, eGB[k].z, eGB[k].w}, ns_[4] = {eNS[k].x, eNS[k].y, eNS[k].z, eNS[k].w};
                const float gn_[8] = {gnA.x, gnA.y, gnA.z, gnA.w, gnB.x, gnB.y, gnB.z, gnB.w};
                unsigned ow[4];
#pragma unroll
                for (int q = 0; q < 4; ++q) { float o2[2];
#pragma unroll
                    for (int hh = 0; hh < 2; ++hh) { const float y = yf_[2 * q + hh] * gn_[2 * q + hh], rg = hh ? bfhi(rg_[q]) : bflo(rg_[q]), ga = hh ? bfhi(ga_[q]) : bflo(ga_[q]);
                        const float gb = hh ? bfhi(gb_[q]) : bflo(gb_[q]), nsv = hh ? bfhi(ns_[q]) : bflo(ns_[q]);
                        const float den = (1.f + ex2(-rg * LOG2E)) * (1.f + ex2(-ga));
                        o2[hh] = rg * __builtin_amdgcn_rcpf(den) * y + __builtin_amdgcn_rcpf(1.f + ex2(-gb)) * nsv; }
                    ow[q] = pk2(o2[0], o2[1]); }
                v4u ov; ov.x = ow[0]; ov.y = ow[1]; ov.z = ow[2]; ov.w = ow[3];
                *(GAS v4u*)((GAS bf16*)wsb + (O_MX + (T0 + 16 * w + 4 * k + er) * 1024u + h * 128 + ec)) = ov; }
        }
#pragma unroll
        for (int dt = 0; dt < 4; ++dt) R[dt] = R[dt] * dec128;
#pragma unroll
        for (int a = 0; a < 4; ++a) { const LAS char* vp = lds + RT_V + w * 4096 + (32 * a + 4 * fq + tq) * 32 + tp * 8;
            const s16x4 vlo = trrd(vp), vhi = trrd(vp + 16 * 32); const bf16x8 vf = MK8(vlo, vhi);
#pragma unroll
            for (int dt = 0; dt < 4; ++dt) { const LAS char* kp = lds + RT_KZ + (32 * a + 4 * fq + tq) * RT_KZS + (16 * dt + 4 * tp) * 2;
                const s16x4 klo = trrd(kp), khi = trrd(kp + 16 * RT_KZS);
                R[dt] = __builtin_amdgcn_mfma_f32_16x16x32_bf16(vf, MK8(klo, khi), R[dt], 0, 0, 0); } }
        RT_BAR();
        if (ch + 1 >= c_first && ch + 1 < n_total) {
#pragma unroll
            for (int dt = 0; dt < 4; ++dt)
#pragma unroll
                for (int r = 0; r < 4; ++r) *(LAS bf16*)(lds + RT_R + (16 * w + 4 * fq + r) * RT_KZS + (16 * dt + i_in) * 2) = (bf16)(pk2(R[dt][r], 0.f) & 0xffffu);
        }
    }
    __syncthreads();
#undef RT_LOADKV
#undef RT_OPAQUE
#undef RT_LOADQ
}
__device__ __forceinline__ void p4_retention(const Ctx& C, const Args& A) {
    for (int u = C.vcu; u < 256; u += C.G) ret_unit(C, A, u >> 4, (u >> 1) & 7, u & 1);
}


template <bool XF32>
__device__ __forceinline__ void thin_phase(const Ctx& C, const void* xi, const bf16* add, const float* ssp, const float* g_post, bf16* xo, float* rso) {
    const int gw = C.vcu * NWAVES + C.wave, NGW = C.G * NWAVES, lane = C.lane;
    for (int m = gw; m < M_TOK; m += NGW) {
        const float sp = lane < 16 ? ssp[(size_t)m * 16 + lane] : 0.f;
        const float rs = __builtin_amdgcn_rsqf(wave_sum(sp) * (1.f / DM) + RMS_EPS);
        const GAS v2u* ar = (const GAS v2u*)(add + (size_t)m * DM) + lane; const GAS f32x4* gp = (const GAS f32x4*)g_post + lane;
        f32x4 v[4]; float s = 0.f;
#pragma unroll
        for (int j = 0; j < 4; ++j) { f32x4 x;
            if (XF32) x = ((const GAS f32x4*)((const float*)xi + (size_t)m * DM) + lane)[64 * j];
            else { const v2u xb = ((const GAS v2u*)((const bf16*)xi + (size_t)m * DM) + lane)[64 * j]; x = f32x4{bflo(xb.x), bfhi(xb.x), bflo(xb.y), bfhi(xb.y)}; }
            const f32x4 g = gp[64 * j]; const v2u a = ar[64 * j];
            v[j].x = x.x + bflo(a.x) * rs * g.x; v[j].y = x.y + bfhi(a.x) * rs * g.y; v[j].z = x.z + bflo(a.y) * rs * g.z; v[j].w = x.w + bfhi(a.y) * rs * g.w;
            s += (v[j].x * v[j].x + v[j].y * v[j].y) + (v[j].z * v[j].z + v[j].w * v[j].w); }
        GAS v2u* hw = (GAS v2u*)(xo + (size_t)m * DM) + lane;
#pragma unroll
        for (int j = 0; j < 4; ++j) { v2u w; w.x = pk2(v[j].x, v[j].y); w.y = pk2(v[j].z, v[j].w); hw[64 * j] = w; }
        const float r2 = __builtin_amdgcn_rsqf(wave_sum(s) * (1.f / DM) + RMS_EPS);
        if (lane == 0) rso[m] = r2;
    }
}

#define CAS __attribute__((address_space(4)))
__device__ __forceinline__ Args load_args() {
    Args a{};
#if defined(__HIP_DEVICE_COMPILE__)
    const CAS Args* p_ = (const CAS Args*)__builtin_amdgcn_kernarg_segment_ptr(); asm volatile("" : "+s"(p_));
#pragma unroll
    for (int i = 0; i < 19; ++i) a.in[i] = p_->in[i];
    a.out = p_->out; a.ws = p_->ws; a.ph_lo = p_->ph_lo; a.ph_hi = p_->ph_hi; a.li = p_->li; a.pad = 0;
#endif
    return a;
}
__global__ void __launch_bounds__(NWAVES * 64, 2) hyb_fwd(Args args) {
    extern __shared__ __attribute__((aligned(16))) unsigned char lds[];
#define MKCTX() Ctx C; C.lds = (LAS unsigned char*)lds; C.tid = threadIdx.x; C.lane = C.tid & 63; C.wave = __builtin_amdgcn_readfirstlane(C.tid >> 6); \
    C.G = gridDim.x; { const int bx_ = blockIdx.x; C.vcu = (C.G % 8 == 0) ? (bx_ % 8) * (C.G / 8) + bx_ / 8 : bx_; }
    volatile LAS unsigned* MISC = (volatile LAS unsigned*)((LAS unsigned char*)lds + MISC_OFF);
    gu32* ctl = (gu32*)(args.ws + WS_CTL);
    for (int u = threadIdx.x; u < (LDS_BYTES - LDSCTL_OFF) / 4; u += NWAVES * 64) ((LAS unsigned*)((LAS unsigned char*)lds + LDSCTL_OFF))[u] = 0u;
    __syncthreads();
    XcdBarrier bar; bar.bar = (unsigned*)(ctl + CW_BAR); bar.x = 0; bar.st = nullptr;
    if (N_LAUNCHES == 1) bar = xcd_barrier_post((unsigned*)(ctl + CW_BAR), MISC + 8);
    const int lo = args.ph_lo, hi = args.ph_hi;
#ifndef PH_REP
#define PH_REP 0
#endif
#ifndef PH_MASK
#define PH_MASK 0x7ff
#endif
#define IN(k) (((PH_MASK >> (k)) & 1) && lo <= (k) && (k) < hi)
#define SEAM(k) do { if (IN(k) && IN((k) + 1)) xcd_barrier(bar); } while (0)
#define LOAD_ARGS(Av) const Args Av = load_args(); unsigned char* ws = Av.ws; (void)ws

    if (IN(0)) { LOAD_ARGS(a); MKCTX(); LAS unsigned char* ring = C.lds; const int bx = (int)blockIdx.x; (void)ring; (void)bx; p0_prologue(C, a); if ((PH_REP >> 0) & 1) { __syncthreads(); p0_prologue(C, a); } }
    SEAM(0);
    if (IN(1)) { LOAD_ARGS(a); MKCTX(); LAS unsigned char* ring = C.lds; const int bx = (int)blockIdx.x; (void)ring; (void)bx;
        pg8::Gemm g{(const bf16*)((const unsigned char*)a.out + OUT_H), (const bf16*)(ws + WS_WIN), M_TOK, IN_VIRT, DM}; pg8::StaticOrder S; S.init(M_TOK, IN_VIRT, C.G, bx);
        pg8::EpiProj E{(bf16*)ws, ring, (unsigned char*)a.out + 160 * MiB};
#if defined(P1_STAGGER)
        for (int i = 0; i < ((bx >> 3) & 3) * P1_STAGGER; ++i) __builtin_amdgcn_s_sleep(127);
#endif
        pg8::gemm_phase<pg8::EpiProj, pg8::StaticOrder, true, true>(ring, g, S, E);
#if defined(GEMM_PROBE)
        { __syncthreads(); asm volatile("" ::: "memory"); __builtin_amdgcn_sched_barrier(0); pg8::EpiNone EN{ring}; pg8::gemm_phase<pg8::EpiNone, pg8::StaticOrder, true, true>(ring, g, S, EN); }
#else
        if ((PH_REP >> 1) & 1) { __syncthreads(); asm volatile("" ::: "memory"); __builtin_amdgcn_sched_barrier(0); pg8::gemm_phase<pg8::EpiProj, pg8::StaticOrder, true, true>(ring, g, S, E); }
#endif
    }
    SEAM(1);
    if (IN(2)) { LOAD_ARGS(a); MKCTX(); LAS unsigned char* ring = C.lds; const int bx = (int)blockIdx.x; (void)ring; (void)bx; p2_compress(C, a); if ((PH_REP >> 2) & 1) { __syncthreads(); p2_compress(C, a); } }
    SEAM(2);
    if (IN(3)) { LOAD_ARGS(a); MKCTX(); LAS unsigned char* ring = C.lds; const int bx = (int)blockIdx.x; (void)ring; (void)bx; p3_nsa(C, a); if ((PH_REP >> 3) & 1) { __syncthreads(); p3_nsa(C, a); } }
    SEAM(3);
    if (IN(4)) { LOAD_ARGS(a); MKCTX(); LAS unsigned char* ring = C.lds; const int bx = (int)blockIdx.x; (void)ring; (void)bx; p4_retention(C, a); if ((PH_REP >> 4) & 1) { __syncthreads(); p4_retention(C, a); } }
    SEAM(4);
    if (IN(5)) { LOAD_ARGS(a); MKCTX(); LAS unsigned char* ring = C.lds; const int bx = (int)blockIdx.x; (void)ring; (void)bx;
        { pg8::Gemm g{(const bf16*)(ws + WS_MIXIN), (const bf16*)(ws + WS_WOUT), M_TOK, DM, DM}; pg8::StaticOrder S; S.init(M_TOK, DM, C.G, bx);
          pg8::EpiNormRes<true> E{(const void*)a.in[I_X], (bf16*)(ws + WS_H2), a.in[I_NMPOST], (float*)(ws + WS_SSP), (unsigned*)(ws + WS_XBUF), (unsigned*)(ws + WS_CTL + CW_XCNT2), ring};
          pg8::gemm_phase<pg8::EpiNormRes<true>, pg8::StaticOrder, true, true>(ring, g, S, E); }
        __syncthreads(); asm volatile("" ::: "memory"); __builtin_amdgcn_sched_barrier(0);
        { pg8::Gemm g{(const bf16*)((const unsigned char*)a.out + OUT_PBF), (const bf16*)(ws + WS_WPLE), M_TOK, DM, PLE_D}; pg8::StaticOrder S; S.init(M_TOK, DM, C.G, bx);
          pg8::EpiPlain E{(bf16*)(ws + WS_PLEO), DM, ring};
          pg8::gemm_phase<pg8::EpiPlain, pg8::StaticOrder, true, true>(ring, g, S, E); }
    }
    SEAM(5);
    if (IN(7)) { LOAD_ARGS(a); MKCTX(); LAS unsigned char* ring = C.lds; const int bx = (int)blockIdx.x; (void)ring; (void)bx;
        pg8::Gemm g{(const bf16*)(ws + WS_H2), (const bf16*)(ws + WS_WFI), M_TOK, 2 * DFF, DM}; pg8::StaticOrder S; S.init(M_TOK, 2 * DFF, C.G, bx);
        pg8::EpiSwiglu E{(bf16*)(ws + WS_ACT), (const float*)(ws + WS_SSP)};
        pg8::gemm_phase<pg8::EpiSwiglu, pg8::StaticOrder, true, true>(ring, g, S, E);
        if ((PH_REP >> 7) & 1) { __syncthreads(); asm volatile("" ::: "memory"); __builtin_amdgcn_sched_barrier(0); pg8::gemm_phase<pg8::EpiSwiglu, pg8::StaticOrder, true, true>(ring, g, S, E); }
    }
    SEAM(7);
    if (IN(8)) { LOAD_ARGS(a); MKCTX(); LAS unsigned char* ring = C.lds; const int bx = (int)blockIdx.x; (void)ring; (void)bx;
        pg8::Gemm g{(const bf16*)(ws + WS_ACT), (const bf16*)(ws + WS_WFO), M_TOK, DM, DFF}; pg8::StaticOrder S; S.init(M_TOK, DM, C.G, bx);
        pg8::EpiNormRes<false> E{(const void*)(ws + WS_H2), (bf16*)(ws + WS_H2), a.in[I_NFPOST], (float*)(ws + WS_SSP2), (unsigned*)(ws + WS_XBUF), (unsigned*)(ws + WS_CTL + CW_XCNT), ring};
        pg8::gemm_phase<pg8::EpiNormRes<false>, pg8::StaticOrder, true, true>(ring, g, S, E);
    }
    SEAM(8);
    if (IN(10)) { LOAD_ARGS(a); MKCTX(); LAS unsigned char* ring = C.lds; const int bx = (int)blockIdx.x; (void)ring; (void)bx;
        pg8::Gemm g{(const bf16*)(ws + WS_H2), (const bf16*)(ws + WS_WG), M_TOK, DM, DM}; pg8::StaticOrder S; S.init(M_TOK, DM, C.G, bx);
        pg8::EpiFinal E{(const bf16*)(ws + WS_H2), (const bf16*)(ws + WS_PLEO), (const float*)(ws + WS_SSP2), a.out, ring};
#if defined(P10_STAGGER)
        for (int i = 0; i < (bx & (P10_GROUPS - 1)) * P10_STAGGER; ++i) __builtin_amdgcn_s_sleep(127);
#endif
        pg8::gemm_phase<pg8::EpiFinal, pg8::StaticOrder, true, true>(ring, g, S, E);
        if ((PH_REP >> 10) & 1) { __syncthreads(); asm volatile("" ::: "memory"); __builtin_amdgcn_sched_barrier(0); pg8::gemm_phase<pg8::EpiFinal, pg8::StaticOrder, true, true>(ring, g, S, E); }
    }
#undef IN
#undef SEAM
}

static_assert(pg8::EPI_X_END <= LDSCTL_OFF, "fused-epilogue LDS tables fit below the control words");
extern "C" void kernel_launch(void* const* d_in, const int* in_sizes, int n_in, void* d_out, int out_size, void* d_ws, size_t ws_size, hipStream_t stream) {
    static int grid = 0;
    if (grid == 0) {
        if (n_in != 19 || in_sizes[0] != M_TOK * DM || out_size != M_TOK * DM || ws_size < WS_END) {
            fprintf(stderr, "kernel_launch: built for 19 inputs, x/out of %d floats, >= %zu bytes of workspace; got n_in %d, in0 %d, out %d, ws %zu; nothing launched\n", M_TOK * DM, (size_t)WS_END, n_in, n_in > 0 ? in_sizes[0] : -1, out_size, ws_size);
            grid = -1; return; }
        int dev = 0, cus = 0, per_cu = 0;
        if (hipGetDevice(&dev) != hipSuccess || hipDeviceGetAttribute(&cus, hipDeviceAttributeMultiprocessorCount, dev) != hipSuccess) { fprintf(stderr, "kernel_launch: device query failed\n"); grid = -1; return; }
        if (hipFuncSetAttribute((const void*)hyb_fwd, hipFuncAttributeMaxDynamicSharedMemorySize, LDS_BYTES) != hipSuccess) { fprintf(stderr, "kernel_launch: hipFuncSetAttribute failed\n"); grid = -1; return; }
        if (hipOccupancyMaxActiveBlocksPerMultiprocessor(&per_cu, (const void*)hyb_fwd, NWAVES * 64, LDS_BYTES) != hipSuccess || per_cu < 1)
            fprintf(stderr, "kernel_launch: note: occupancy query reports %d workgroups per CU\n", per_cu);
        (void)hipGetLastError();
        grid = cus;
    }
    if (grid < 0) return;
    if (N_LAUNCHES == 1) { if (hipMemsetAsync((char*)d_ws + WS_CTL, 0, CTL_ZERO_BYTES, stream) != hipSuccess) { fprintf(stderr, "kernel_launch: hipMemsetAsync failed\n"); return; } }
    Args a{};
    for (int i = 0; i < 19; ++i) a.in[i] = (const float*)d_in[i];
    a.out = (float*)d_out; a.ws = (unsigned char*)d_ws;
    for (int li = 0; li < N_LAUNCHES; ++li) {
        a.ph_lo = (N_LAUNCHES == 1) ? 0 : li; a.ph_hi = (N_LAUNCHES == 1) ? N_PHASES : li + 1; a.li = li; a.pad = 0;
        hipLaunchKernelGGL(hyb_fwd, dim3(grid), dim3(NWAVES * 64), LDS_BYTES, stream, a);
        const hipError_t le = hipPeekAtLastError();
        if (le != hipSuccess) { fprintf(stderr, "kernel_launch: launch %d failed: %s\n", li, hipGetErrorName(le)); break; }
    }
}
```

```cpp
#include <hip/hip_runtime.h>
#include <cstdio>
#include <cstdint>

#ifndef MK_N_LAUNCHES
#define MK_N_LAUNCHES 1
#endif

constexpr int NB = 16, SEQ = 4096, DM = 1024, M_TOK = NB * SEQ, DFF = 2816, PLE_D = 256;
constexpr int IN_TOTAL = 7664, IN_VIRT = 7680;
constexpr float RMS_EPS = 1e-6f, GN_EPS = 1e-5f, LOG2E = 1.4426950408889634f;
constexpr float QSCALE = 0.10206207261596575f * 1.4426950408889634f;
constexpr size_t MiB = 1u << 20;
constexpr size_t WS_CTL = 0, CTL_ZERO_BYTES = 1 * MiB;
constexpr size_t WS_WIN = 1 * MiB;
constexpr size_t WS_WOUT = 16 * MiB;
constexpr size_t WS_WFI = 18 * MiB;
constexpr size_t WS_WFO = 29 * MiB;
constexpr size_t WS_WPLE = 34 * MiB + 512 * 1024;
constexpr size_t WS_WG = 35 * MiB;
constexpr size_t WS_W1K = 37 * MiB;
constexpr size_t WS_W1V = 37 * MiB + 589824;
constexpr size_t WS_W2K = 38 * MiB, WS_W2V = 38 * MiB + 32768;
constexpr size_t WS_C1K = 38 * MiB + 65536, WS_C1V = 38 * MiB + 65536 + 2048;
constexpr size_t WS_KCMP = 39 * MiB;
constexpr size_t WS_VCMP = 40 * MiB + 512 * 1024;
constexpr size_t WS_SSP = 42 * MiB;
constexpr size_t WS_RS2 = 46 * MiB, WS_RS3 = 46 * MiB + 512 * 1024;
constexpr size_t WS_XBUF = 47 * MiB;
constexpr size_t WS_SSP2 = 420 * MiB;
constexpr size_t CW_XCNT2 = 131072;
constexpr size_t CW_XCNT = 65536;
constexpr size_t WS_NQ = 48 * MiB, WS_KC = 240 * MiB, WS_VC = 264 * MiB, WS_KS = 280 * MiB, WS_VS = 304 * MiB, WS_KW = 320 * MiB, WS_VW = 344 * MiB, WS_NG = 360 * MiB;
constexpr size_t WS_RQ = 366 * MiB, WS_RK = 430 * MiB, WS_RV = 494 * MiB, WS_RG = 622 * MiB, WS_MG = 750 * MiB, WS_END = 1006 * MiB;
constexpr size_t WS_MIXIN = WS_NQ;
constexpr size_t WS_MIX = WS_RQ;
constexpr size_t WS_PLEO = WS_RV;
constexpr size_t WS_H2 = WS_RG;
constexpr size_t WS_ACT = WS_NQ;
constexpr size_t OUT_H = 0;
constexpr size_t OUT_PBF = 128 * MiB;
constexpr size_t OUT_NSA = 0;
constexpr size_t OUT_F = 0;

namespace pg8 {
#define PG8_LAS __attribute__((address_space(3)))
typedef unsigned short bf16_t;
typedef short bf16x8 __attribute__((ext_vector_type(8)));
typedef float f32x4 __attribute__((ext_vector_type(4)));
typedef unsigned u32x4 __attribute__((ext_vector_type(4)));
constexpr int BM = 256, BK = 64, HALF = 128, HTB = HALF * BK * 2  , STAGE_BYTES = 8 * HTB, NXCD = 8, WGM = 4;

__host__ __device__ __forceinline__ int lds_byte(int r, int c) { const int st = (r >> 4) * 2 + (c >> 5), rr = r & 15, cc = c & 31, ob = rr * 64 + cc * 2; return st * 1024 + (ob ^ (((ob >> 9) & 1) << 5)); }
__host__ __device__ __forceinline__ void stage_rc(int b, int& R, int& C) { const int st = b / 1024, sb = b % 1024, swz = sb ^ (((sb >> 9) & 1) << 5); R = (st >> 1) * 16 + swz / 64; C = (st & 1) * 32 + (swz % 64) / 2; }
__host__ __device__ __forceinline__ int perm32(int rho) { const int n = rho >> 4, i = rho & 15; return 8 * (i >> 2) + 4 * n + (i & 3); }

struct Unit { int pm, pn; };
struct Gemm { const bf16_t* A; const bf16_t* Bt; int M, N, K; };

struct StaticOrder {
    int nM, nN, nwg, G, c;
    __host__ __device__ void init(int M, int N, int G_, int c_) { nM = M / BM; nN = N / BM; nwg = nM * nN; G = G_; c = c_; }
    __host__ __device__ bool next(int i, Unit& u) const {
        const long L = (long)i * G + c; if (L >= nwg) return false;
        int wgid = (int)L; { const int q = nwg / NXCD, r = nwg % NXCD, xcd = wgid % NXCD, off = wgid / NXCD; wgid = (xcd < r ? xcd * (q + 1) : r * (q + 1) + (xcd - r) * q) + off; }
        const int nig = WGM * nN, gid = wgid / nig, fm = gid * WGM, gsz = (nM - fm) < WGM ? (nM - fm) : WGM;
        u.pm = fm + ((wgid % nig) % gsz); u.pn = (wgid % nig) / gsz; return true;
    }
    __device__ __forceinline__ void a_ready(const Unit&) const {}
    __device__ __forceinline__ void done(const Unit&) const {}
};

struct PanelOrder {
    int nN, pm;
    __device__ __forceinline__ void init(int N, int pm_) { int n_ = N / BM; asm volatile("" : "+s"(n_)); nN = n_; pm = pm_; }
    __device__ __forceinline__ bool next(int i, Unit& u) const { if (i >= nN) return false; u.pm = pm; u.pn = i; return true; }
    __device__ __forceinline__ void a_ready(const Unit&) const {}
    __device__ __forceinline__ void done(const Unit&) const {}
};

typedef float f32x2_t __attribute__((ext_vector_type(2))); typedef __bf16 bf16x2_t __attribute__((ext_vector_type(2)));
__device__ __forceinline__ unsigned cvt_pk_bf16(float lo, float hi) { f32x2_t v = {lo, hi}; bf16x2_t b = __builtin_convertvector(v, bf16x2_t); return __builtin_bit_cast(unsigned, b); }
__device__ __forceinline__ float bf_lo(unsigned w) { return __uint_as_float(w << 16); }
__device__ __forceinline__ float bf_hi(unsigned w) { return __uint_as_float(w & 0xffff0000u); }
__device__ __forceinline__ float fast_sigmoid(float x) { return __builtin_amdgcn_rcpf(1.f + __builtin_amdgcn_exp2f(-x * ::LOG2E)); }

constexpr int EPI_STG_OFF = 131072, EPI_STG_ROW = 144, EPI_STG_WAVE = 16 * EPI_STG_ROW;
__device__ __forceinline__ void stage_store_rows(PG8_LAS unsigned char* stg, int fr, int fq, const u32x4& w0, const u32x4& w1, unsigned char* gblock, size_t pitch, int nchunk) {
    *(PG8_LAS u32x4*)(stg + fr * EPI_STG_ROW + fq * 16) = w0; *(PG8_LAS u32x4*)(stg + fr * EPI_STG_ROW + 64 + fq * 16) = w1;
    const int ln = fq * 16 + fr, r = ln >> 3, c = ln & 7;
#pragma unroll
    for (int h = 0; h < 2; ++h) { const u32x4 v = *(const PG8_LAS u32x4*)(stg + (8 * h + r) * EPI_STG_ROW + c * 16);
        if (c < nchunk) *(u32x4*)(gblock + (size_t)(8 * h + r) * pitch + c * 16) = v; }
}
__device__ __forceinline__ u32x4 pack8(const f32x4& v0, const f32x4& v1) { u32x4 w; w.x = cvt_pk_bf16(v0[0], v0[1]); w.y = cvt_pk_bf16(v0[2], v0[3]); w.z = cvt_pk_bf16(v1[0], v1[1]); w.w = cvt_pk_bf16(v1[2], v1[3]); return w; }

struct EpiProj {
    static constexpr bool PERM = true, AFTER_DRAIN = false;
    bf16_t* ws; PG8_LAS unsigned char* lds; unsigned char* scr;
    __device__ __forceinline__ static void route(int v, size_t& off, int& ld, float& sc, int& nch) {
        sc = 1.f; nch = 8;
        if (v < 512)       { off = ::WS_RQ / 2 + v;            ld = 512; }
        else if (v < 1024) { off = ::WS_RK / 2 + (v - 512);    ld = 512; }
        else if (v < 2048) { off = ::WS_RV / 2 + (v - 1024);   ld = 1024; }
        else if (v < 3072) { off = ::WS_RG / 2 + (v - 2048);   ld = 1024; }
        else if (v < 4608) { off = ::WS_NQ / 2 + (v - 3072);   ld = 1536; sc = ::QSCALE; }
        else if (v < 6656) { off = ::WS_MG / 2 + (v - 4608);   ld = 2048; sc = ::LOG2E; }
        else { const int w = v - 6656;
            if (w < 192)       { off = ::WS_KC / 2 + w;          ld = 192; }
            else if (w < 320)  { off = ::WS_VC / 2 + (w - 192);  ld = 128; }
            else if (w < 512)  { off = ::WS_KS / 2 + (w - 320);  ld = 192; }
            else if (w < 640)  { off = ::WS_VS / 2 + (w - 512);  ld = 128; }
            else if (w < 832)  { off = ::WS_KW / 2 + (w - 640);  ld = 192; }
            else if (w < 960)  { off = ::WS_VW / 2 + (w - 832);  ld = 128; }
            else               { off = ::WS_NG / 2 + (w - 960);  ld = 48; nch = 6; } }
    }
    __device__ __forceinline__ void operator()(const f32x4 (&acc)[2][2][4][2], const Unit& u, int wr, int wc, int fr_in, int fq_in) const {
        int fr = fr_in, fq = fq_in; asm volatile("" : "+v"(fr), "+v"(fq));
        size_t off; int ld, nch; float sc;
        route(u.pn * BM + wc * 64, off, ld, sc, nch);
        PG8_LAS unsigned char* stg = lds + EPI_STG_OFF + (wr * 4 + wc) * EPI_STG_WAVE;
        const int rowb = u.pm * BM + wr * 64;
#pragma unroll
        for (int ai = 0; ai < 2; ++ai)
#pragma unroll
            for (int m = 0; m < 4; ++m) { const size_t row = (size_t)(rowb + ai * HALF + m * 16);
                stage_store_rows(stg, fr, fq, pack8(acc[ai][0][m][0] * sc, acc[ai][0][m][1] * sc), pack8(acc[ai][1][m][0] * sc, acc[ai][1][m][1] * sc), (unsigned char*)(ws + off + row * ld), (size_t)ld * 2, nch);
#if defined(EPI_PROBE) && (EPI_PROBE == 4 || EPI_PROBE == 5)
                { const u32x4 wz = pack8(acc[ai][0][m][0], acc[ai][0][m][1]); const int ln = fq * 16 + fr, k2_ = (ai * 4 + m) * 2;
                  unsigned char* sb = scr + (size_t)blockIdx.x * 131072 + (size_t)(wr * 4 + wc) * 16384;
                  if (EPI_PROBE == 4) { *(volatile __attribute__((address_space(1))) u32x4*)(sb + (size_t)k2_ * 1024 + ln * 16) = wz; *(volatile __attribute__((address_space(1))) u32x4*)(sb + (size_t)(k2_ + 1) * 1024 + ln * 16) = wz; }
                  else { *(volatile __attribute__((address_space(1))) u32x4*)(scr + (size_t)blockIdx.x * 131072 + (size_t)(k2_ * 8 + (ln >> 3)) * 1024 + (wr * 4 + wc) * 128 + (ln & 7) * 16) = wz;
                         *(volatile __attribute__((address_space(1))) u32x4*)(scr + (size_t)blockIdx.x * 131072 + (size_t)((k2_ + 1) * 8 + (ln >> 3)) * 1024 + (wr * 4 + wc) * 128 + (ln & 7) * 16) = wz; } }
#endif
                }
    }
};

#if defined(GEMM_PROBE)
struct EpiNone {
    static constexpr bool PERM = true, AFTER_DRAIN = false;
    PG8_LAS unsigned char* lds;
    __device__ __forceinline__ void operator()(const f32x4 (&acc)[2][2][4][2], const Unit& u, int wr, int wc, int fr_in, int fq_in) const {
#pragma unroll
        for (int ai = 0; ai < 2; ++ai)
#pragma unroll
            for (int bj = 0; bj < 2; ++bj)
#pragma unroll
                for (int m = 0; m < 4; ++m)
#pragma unroll
                    for (int n = 0; n < 2; ++n) asm volatile("" :: "v"(acc[ai][bj][m][n]));
    }
};
#endif

struct EpiPlain {
    static constexpr bool PERM = true, AFTER_DRAIN = false;
    bf16_t* O; int ldc; PG8_LAS unsigned char* lds;
    __device__ __forceinline__ void operator()(const f32x4 (&acc)[2][2][4][2], const Unit& u, int wr, int wc, int fr_in, int fq_in) const {
        int fr = fr_in, fq = fq_in; asm volatile("" : "+v"(fr), "+v"(fq));
        PG8_LAS unsigned char* stg = lds + EPI_STG_OFF + (wr * 4 + wc) * EPI_STG_WAVE;
        const int rowb = u.pm * BM + wr * 64, colb = u.pn * BM + wc * 64;
#pragma unroll
        for (int ai = 0; ai < 2; ++ai)
#pragma unroll
            for (int m = 0; m < 4; ++m) { const size_t row = (size_t)(rowb + ai * HALF + m * 16);
                stage_store_rows(stg, fr, fq, pack8(acc[ai][0][m][0], acc[ai][0][m][1]), pack8(acc[ai][1][m][0], acc[ai][1][m][1]), (unsigned char*)(O + row * ldc + colb), (size_t)ldc * 2, 8); }
    }
};

struct EpiSumsq {
    static constexpr bool PERM = true, AFTER_DRAIN = false;
    bf16_t* O; float* ssp; PG8_LAS unsigned char* lds;
    __device__ __forceinline__ void operator()(const f32x4 (&acc)[2][2][4][2], const Unit& u, int wr, int wc, int fr_in, int fq_in) const {
        int fr = fr_in, fq = fq_in; asm volatile("" : "+v"(fr), "+v"(fq));
        PG8_LAS unsigned char* stg = lds + EPI_STG_OFF + (wr * 4 + wc) * EPI_STG_WAVE;
        const int rowb = u.pm * BM + wr * 64, colb = u.pn * BM + wc * 64;
#pragma unroll
        for (int ai = 0; ai < 2; ++ai)
#pragma unroll
            for (int m = 0; m < 4; ++m) { const int row = rowb + ai * HALF + m * 16; float s = 0.f;
#pragma unroll
                for (int bj = 0; bj < 2; ++bj) { const f32x4 v0 = acc[ai][bj][m][0], v1 = acc[ai][bj][m][1];
                    s += (v0[0] * v0[0] + v0[1] * v0[1]) + (v0[2] * v0[2] + v0[3] * v0[3]); s += (v1[0] * v1[0] + v1[1] * v1[1]) + (v1[2] * v1[2] + v1[3] * v1[3]); }
                stage_store_rows(stg, fr, fq, pack8(acc[ai][0][m][0], acc[ai][0][m][1]), pack8(acc[ai][1][m][0], acc[ai][1][m][1]), (unsigned char*)(O + (size_t)row * 1024 + colb), 2048, 8);
                s += __shfl_xor(s, 16); s += __shfl_xor(s, 32);
                if (fq == 0) ssp[(size_t)(row + fr) * 16 + u.pn * 4 + wc] = s; }
    }
};

constexpr int EPI_P_OFF = EPI_STG_OFF + 8 * EPI_STG_WAVE, EPI_S_OFF = EPI_P_OFF + 4096, EPI_X_END = EPI_S_OFF + 1024;
template <bool XF32>
struct EpiNormRes {
    static constexpr bool PERM = true, AFTER_DRAIN = false;
    const void* Xin; bf16_t* X; const float* gpost; float* ssp2; unsigned* xbuf; unsigned* cnt; PG8_LAS unsigned char* lds;
    static constexpr int NPRE = XF32 ? 3 : 6;
    struct Res { f32x4 v[2][2]; };
    __device__ __forceinline__ static void ld(const void* Xin, size_t idx, u32x4 (&raw)[XF32 ? 4 : 2]) {
        if constexpr (XF32) { const float* p = (const float*)Xin + idx;
            raw[0] = *(const u32x4*)(p); raw[1] = *(const u32x4*)(p + 4); raw[2] = *(const u32x4*)(p + 32); raw[3] = *(const u32x4*)(p + 36); }
        else { const bf16_t* p = (const bf16_t*)Xin + idx; raw[0] = *(const u32x4*)(p); raw[1] = *(const u32x4*)(p + 32); }
    }
    __device__ __forceinline__ static Res cvt(const u32x4 (&raw)[XF32 ? 4 : 2]) { Res r;
        if constexpr (XF32) {
#pragma unroll
            for (int q = 0; q < 4; ++q) r.v[q >> 1][q & 1] = (f32x4){__uint_as_float(raw[q].x), __uint_as_float(raw[q].y), __uint_as_float(raw[q].z), __uint_as_float(raw[q].w)}; }
        else {
#pragma unroll
            for (int bj = 0; bj < 2; ++bj) { const u32x4 xw = raw[bj]; r.v[bj][0] = (f32x4){bf_lo(xw.x), bf_hi(xw.x), bf_lo(xw.y), bf_hi(xw.y)}; r.v[bj][1] = (f32x4){bf_lo(xw.z), bf_hi(xw.z), bf_lo(xw.w), bf_hi(xw.w)}; } }
        return r; }
    __device__ __forceinline__ void operator()(const f32x4 (&acc)[2][2][4][2], const Unit& u, int wr, int wc, int fr_in, int fq_in) const {
        int fr = fr_in, fq = fq_in; asm volatile("" : "+v"(fr), "+v"(fq));
        const int tid = threadIdx.x, wid = __builtin_amdgcn_readfirstlane(tid >> 6), lane = tid & 63;
        PG8_LAS float* P = (PG8_LAS float*)(lds + EPI_P_OFF); PG8_LAS float* S = (PG8_LAS float*)(lds + EPI_S_OFF);
        PG8_LAS unsigned char* stg = lds + EPI_STG_OFF + (wr * 4 + wc) * EPI_STG_WAVE;
        const int rowb = u.pm * BM + wr * 64, colb = u.pn * BM + wc * 64;
        u32x4 pre[NPRE][XF32 ? 4 : 2];
#pragma unroll
        for (int q = 0; q < NPRE; ++q) ld(Xin, (size_t)(rowb + (q >> 2) * HALF + (q & 3) * 16 + fr) * 1024 + colb + 8 * fq, pre[q]);
#pragma unroll
        for (int ai = 0; ai < 2; ++ai)
#pragma unroll
            for (int m = 0; m < 4; ++m) { float s = 0.f;
#pragma unroll
                for (int bj = 0; bj < 2; ++bj) { const f32x4 v0 = acc[ai][bj][m][0], v1 = acc[ai][bj][m][1];
                    s += (v0[0] * v0[0] + v0[1] * v0[1]) + (v0[2] * v0[2] + v0[3] * v0[3]); s += (v1[0] * v1[0] + v1[1] * v1[1]) + (v1[2] * v1[2] + v1[3] * v1[3]); }
                s += __shfl_xor(s, 16); s += __shfl_xor(s, 32);
                if (fq == 0) P[(ai * HALF + wr * 64 + m * 16 + fr) * 4 + wc] = s; }
        asm volatile("s_waitcnt lgkmcnt(0)" ::: "memory"); __builtin_amdgcn_s_barrier(); asm volatile("" ::: "memory");
        if (tid < 256) { const f32x4 p4 = *(const PG8_LAS f32x4*)(P + tid * 4);
            __hip_atomic_store(xbuf + (size_t)(u.pm * BM + tid) * 4 + u.pn, __float_as_uint((p4[0] + p4[1]) + (p4[2] + p4[3])), __ATOMIC_RELAXED, __HIP_MEMORY_SCOPE_AGENT); }
        asm volatile("s_waitcnt vmcnt(0)" ::: "memory");
        if (tid < 256 && lane == 0) __hip_atomic_fetch_add(cnt + 64 * u.pm, 1u, __ATOMIC_RELAXED, __HIP_MEMORY_SCOPE_AGENT);
        if (wid == 0) { unsigned sp = 0u;
            while ((unsigned)__builtin_amdgcn_readfirstlane(__hip_atomic_load(cnt + 64 * u.pm, __ATOMIC_RELAXED, __HIP_MEMORY_SCOPE_AGENT)) < 16u) { __builtin_amdgcn_s_sleep(2); if (++sp > (1u << 21)) break; } }
        asm volatile("s_waitcnt vmcnt(0) lgkmcnt(0)" ::: "memory"); __builtin_amdgcn_s_barrier(); asm volatile("" ::: "memory");
        if (tid < 256) { const unsigned long long* sl = (const unsigned long long*)(xbuf + (size_t)(u.pm * BM + tid) * 4);
            const unsigned long long a = __hip_atomic_load(sl, __ATOMIC_RELAXED, __HIP_MEMORY_SCOPE_AGENT), b = __hip_atomic_load(sl + 1, __ATOMIC_RELAXED, __HIP_MEMORY_SCOPE_AGENT);
            const float t = (__uint_as_float((unsigned)a) + __uint_as_float((unsigned)(a >> 32))) + (__uint_as_float((unsigned)b) + __uint_as_float((unsigned)(b >> 32)));
            S[tid] = __builtin_amdgcn_rsqf(t * (1.f / 1024.f) + ::RMS_EPS); }
        asm volatile("s_waitcnt lgkmcnt(0)" ::: "memory"); __builtin_amdgcn_s_barrier(); asm volatile("" ::: "memory");
        f32x4 gp[2][2];
#pragma unroll
        for (int bj = 0; bj < 2; ++bj)
#pragma unroll
            for (int n = 0; n < 2; ++n) gp[bj][n] = *(const f32x4*)(gpost + colb + 32 * bj + 8 * fq + 4 * n);
#pragma unroll
        for (int ai = 0; ai < 2; ++ai)
#pragma unroll
            for (int m = 0; m < 4; ++m) { const int rl = ai * HALF + wr * 64 + m * 16 + fr, row = u.pm * BM + rl; const float rs = S[rl];
                Res x;
                if (ai * 4 + m < NPRE) x = cvt(pre[ai * 4 + m < NPRE ? ai * 4 + m : 0]);
                else { u32x4 raw[XF32 ? 4 : 2]; ld(Xin, (size_t)row * 1024 + colb + 8 * fq, raw); x = cvt(raw); }
                f32x4 o[2][2]; float s2 = 0.f;
#pragma unroll
                for (int bj = 0; bj < 2; ++bj) {
                    o[bj][0] = x.v[bj][0] + acc[ai][bj][m][0] * rs * gp[bj][0]; o[bj][1] = x.v[bj][1] + acc[ai][bj][m][1] * rs * gp[bj][1];
                    s2 += (o[bj][0][0] * o[bj][0][0] + o[bj][0][1] * o[bj][0][1]) + (o[bj][0][2] * o[bj][0][2] + o[bj][0][3] * o[bj][0][3]);
                    s2 += (o[bj][1][0] * o[bj][1][0] + o[bj][1][1] * o[bj][1][1]) + (o[bj][1][2] * o[bj][1][2] + o[bj][1][3] * o[bj][1][3]); }
                stage_store_rows(stg, fr, fq, pack8(o[0][0], o[0][1]), pack8(o[1][0], o[1][1]), (unsigned char*)(X + (size_t)(row - fr) * 1024 + colb), 2048, 8);
                s2 += __shfl_xor(s2, 16); s2 += __shfl_xor(s2, 32);
                if (fq == 0) ssp2[(size_t)row * 16 + u.pn * 4 + wc] = s2; }
    }
};

struct EpiSwiglu {
    static constexpr bool PERM = true, AFTER_DRAIN = false;
    bf16_t* O; const float* ssp;
    __device__ __forceinline__ void operator()(const f32x4 (&acc)[2][2][4][2], const Unit& u, int wr, int wc, int fr_in, int fq_in) const {
        int fr = fr_in, fq = fq_in; asm volatile("" : "+v"(fr), "+v"(fq));
        const int row0 = u.pm * BM + wr * 64 + fr, col0 = u.pn * HALF + wc * 32 + 8 * fq;
#pragma unroll
        for (int ai = 0; ai < 2; ++ai)
#pragma unroll
            for (int m = 0; m < 4; ++m) { const int row = row0 + ai * HALF + m * 16; bf16_t* rowp = O + (size_t)row * ::DFF + col0; float r[8];
                float rsv; { const f32x4* pp = (const f32x4*)(ssp + (size_t)row * 16); const f32x4 p0 = pp[0], p1 = pp[1], p2 = pp[2], p3 = pp[3];
                  const float t = (((p0[0] + p0[1]) + (p0[2] + p0[3])) + ((p1[0] + p1[1]) + (p1[2] + p1[3]))) + (((p2[0] + p2[1]) + (p2[2] + p2[3])) + ((p3[0] + p3[1]) + (p3[2] + p3[3])));
                  rsv = __builtin_amdgcn_rsqf(t * (1.f / 1024.f) + ::RMS_EPS); }
#pragma unroll
                for (int n = 0; n < 2; ++n)
#pragma unroll
                    for (int k = 0; k < 4; ++k) { const float a = acc[ai][0][m][n][k] * rsv, b = acc[ai][1][m][n][k] * rsv; r[4 * n + k] = a * fast_sigmoid(a) * b; }
                u32x4 w; w.x = cvt_pk_bf16(r[0], r[1]); w.y = cvt_pk_bf16(r[2], r[3]); w.z = cvt_pk_bf16(r[4], r[5]); w.w = cvt_pk_bf16(r[6], r[7]);
                *(u32x4*)rowp = w; }
    }
};

struct EpiFinal {
    static constexpr bool PERM = true, AFTER_DRAIN = false;
    const bf16_t* x2; const bf16_t* ple; const float* ssp2; float* out; PG8_LAS unsigned char* lds;
    struct In { f32x4 pp[4]; u32x4 xw[2], pw[2]; };
    __device__ __forceinline__ In load(int row, int colb, int fq) const { In r; const f32x4* p = (const f32x4*)(ssp2 + (size_t)row * 16);
#pragma unroll
        for (int q = 0; q < 4; ++q) r.pp[q] = p[q];
#pragma unroll
        for (int bj = 0; bj < 2; ++bj) { const size_t idx = (size_t)row * 1024 + colb + 32 * bj + 8 * fq; r.xw[bj] = *(const u32x4*)(x2 + idx); r.pw[bj] = *(const u32x4*)(ple + idx); }
        return r; }
    __device__ __forceinline__ void operator()(const f32x4 (&acc)[2][2][4][2], const Unit& u, int wr, int wc, int fr_in, int fq_in) const {
        int fr = fr_in, fq = fq_in; asm volatile("" : "+v"(fr), "+v"(fq));
        PG8_LAS unsigned char* stg = lds + EPI_STG_OFF + (wr * 4 + wc) * EPI_STG_WAVE;
        const int rowb = u.pm * BM + wr * 64, colb = u.pn * BM + wc * 64;
        const int ln = fq * 16 + fr, r8 = ln >> 3, c8 = ln & 7;
        In cur = load(rowb + fr, colb, fq);
#pragma unroll
        for (int g = 0; g < 8; ++g) { const int ai = g >> 2, m = g & 3; const int rowblk = rowb + ai * HALF + m * 16;
            In nxt = cur; if (g < 7) nxt = load(rowb + ((g + 1) >> 2) * HALF + ((g + 1) & 3) * 16 + fr, colb, fq);
            const f32x4 p0 = cur.pp[0], p1 = cur.pp[1], p2 = cur.pp[2], p3 = cur.pp[3];
            const float t = (((p0[0] + p0[1]) + (p0[2] + p0[3])) + ((p1[0] + p1[1]) + (p1[2] + p1[3]))) + (((p2[0] + p2[1]) + (p2[2] + p2[3])) + ((p3[0] + p3[1]) + (p3[2] + p3[3])));
            const float rsv = __builtin_amdgcn_rsqf(t * (1.f / 1024.f) + ::RMS_EPS);
#pragma unroll
            for (int bj = 0; bj < 2; ++bj) { const u32x4 xw = cur.xw[bj], pw = cur.pw[bj];
                const f32x4 a0 = acc[ai][bj][m][0] * rsv, a1 = acc[ai][bj][m][1] * rsv; u32x4 o0, o1;
                o0.x = __float_as_uint(bf_lo(xw.x) + fast_sigmoid(a0[0]) * bf_lo(pw.x)); o0.y = __float_as_uint(bf_hi(xw.x) + fast_sigmoid(a0[1]) * bf_hi(pw.x));
                o0.z = __float_as_uint(bf_lo(xw.y) + fast_sigmoid(a0[2]) * bf_lo(pw.y)); o0.w = __float_as_uint(bf_hi(xw.y) + fast_sigmoid(a0[3]) * bf_hi(pw.y));
                o1.x = __float_as_uint(bf_lo(xw.z) + fast_sigmoid(a1[0]) * bf_lo(pw.z)); o1.y = __float_as_uint(bf_hi(xw.z) + fast_sigmoid(a1[1]) * bf_hi(pw.z));
                o1.z = __float_as_uint(bf_lo(xw.w) + fast_sigmoid(a1[2]) * bf_lo(pw.w)); o1.w = __float_as_uint(bf_hi(xw.w) + fast_sigmoid(a1[3]) * bf_hi(pw.w));
                *(PG8_LAS u32x4*)(stg + fr * EPI_STG_ROW + fq * 32) = o0; *(PG8_LAS u32x4*)(stg + fr * EPI_STG_ROW + fq * 32 + 16) = o1;
#pragma unroll
                for (int h = 0; h < 2; ++h) { const u32x4 v = *(const PG8_LAS u32x4*)(stg + (8 * h + r8) * EPI_STG_ROW + c8 * 16);
                    *(u32x4*)((unsigned char*)out + ((size_t)(rowblk + 8 * h + r8) * 1024 + colb + 32 * bj) * 4 + c8 * 16) = v; } }
            cur = nxt; }
    }
};

template <class E> struct ProbeTraits { static constexpr bool no_stage = false, no_lds = false; };
#if defined(GEMM_PROBE)
template <> struct ProbeTraits<EpiNone> { static constexpr bool no_stage = (GEMM_PROBE == 2 || GEMM_PROBE == 4), no_lds = (GEMM_PROBE == 3 || GEMM_PROBE == 4); };
#endif
template <class Epi, class Sched, bool ALIGN_EPI = false, bool SP2 = false>
__device__ __forceinline__ void gemm_phase(PG8_LAS unsigned char* lds, const Gemm g, const Sched& S, const Epi& E) {
    const int tid = threadIdx.x, wid = __builtin_amdgcn_readfirstlane(tid >> 6), lane = tid & 63, wr = wid >> 2, wc = wid & 3, fr = lane & 15, fq = lane >> 4;
    const int K = g.K, nt = K / BK;
    unsigned voffA[2], voffB[2];
#pragma unroll
    for (int i = 0; i < 2; ++i) { int R, C; stage_rc(tid * 16 + i * 8192, R, C); const int Rb = Epi::PERM ? ((R & ~31) + perm32(R & 31)) : R;
        voffA[i] = (unsigned)(R * K + C) * 2u; voffB[i] = (unsigned)(Rb * K + C) * 2u; }
    const size_t kstep = (size_t)(BK * 2);
    const size_t hstep = (size_t)HALF * K * 2;
    const size_t tstep = 2 * hstep;
    const unsigned ldsw = (unsigned)wid * 1024u;
    const int aoff = lds_byte(wr * 64 + fr, fq * 8), boff = lds_byte(wc * 32 + fr, fq * 8);
#define PG8_SA(b, h) (((b) * 2 + (h)) * HTB)
#define PG8_SB(b, h) ((4 + (b) * 2 + (h)) * HTB)
#if !defined(PG8_GLOBAL_DMA)
    const __amdgpu_buffer_rsrc_t rsrcA = __builtin_amdgcn_make_buffer_rsrc((void*)g.A, 0, 0x7fffffff, 0x00020000), rsrcB = __builtin_amdgcn_make_buffer_rsrc((void*)g.Bt, 0, 0x7fffffff, 0x00020000);
#define PG8_STAGE(bufoff, gbase, voff) do { if constexpr (!ProbeTraits<Epi>::no_stage) { const bool isA_ = ((const void*)(voff) == (const void*)voffA); \
        const int so_ = (int)((const char*)(gbase) - (isA_ ? (const char*)g.A : (const char*)g.Bt)); _Pragma("unroll") for (int _i = 0; _i < 2; ++_i) { \
        if (isA_) __builtin_amdgcn_raw_ptr_buffer_load_lds(rsrcA, (PG8_LAS unsigned*)(lds + (bufoff) + ldsw + _i * 8192), 16, (int)(voff)[_i], so_, 0, 0); \
        else      __builtin_amdgcn_raw_ptr_buffer_load_lds(rsrcB, (PG8_LAS unsigned*)(lds + (bufoff) + ldsw + _i * 8192), 16, (int)(voff)[_i], so_, 0, 0); } } } while (0)
#else
#define PG8_STAGE(bufoff, gbase, voff) do { if constexpr (!ProbeTraits<Epi>::no_stage) _Pragma("unroll") for (int _i = 0; _i < 2; ++_i) \
        __builtin_amdgcn_global_load_lds((const unsigned*)((const char*)(gbase) + (voff)[_i]), (PG8_LAS unsigned*)(lds + (bufoff) + ldsw + _i * 8192), 16, 0, 0); } while (0)
#endif
#define PG8_LDA(dst, b, h) do { if constexpr (!ProbeTraits<Epi>::no_lds) _Pragma("unroll") for (int m = 0; m < 4; ++m) _Pragma("unroll") for (int k = 0; k < 2; ++k) dst[m][k] = *(const PG8_LAS bf16x8*)(lds + PG8_SA(b, h) + aoff + m * 2048 + k * 1024); } while (0)
#define PG8_LDB(dst, b, h) do { if constexpr (!ProbeTraits<Epi>::no_lds) _Pragma("unroll") for (int n = 0; n < 2; ++n) _Pragma("unroll") for (int k = 0; k < 2; ++k) dst[n][k] = *(const PG8_LAS bf16x8*)(lds + PG8_SB(b, h) + boff + n * 2048 + k * 1024); } while (0)
#if defined(PG8_NO_PRIO)
#define PG8_PRIO(x) do { } while (0)
#else
#if defined(PG8_PRIO_HI)
#define PG8_PRIO(x) __builtin_amdgcn_s_setprio((x) ? PG8_PRIO_HI : 0)
#else
#define PG8_PRIO(x) __builtin_amdgcn_s_setprio(x)
#endif
#endif
#define PG8_MMA(ai, bj, At, Bt) do { PG8_PRIO(1); _Pragma("unroll") for (int m = 0; m < 4; ++m) _Pragma("unroll") for (int n = 0; n < 2; ++n) _Pragma("unroll") for (int k = 0; k < 2; ++k) \
        acc[ai][bj][m][n] = __builtin_amdgcn_mfma_f32_16x16x32_bf16(Bt[n][k], At[m][k], acc[ai][bj][m][n], 0, 0, 0); PG8_PRIO(0); } while (0)
#define PG8_MMA_H(ai, bj, At, Bt, mlo, mhi) do { __builtin_amdgcn_s_setprio(1); _Pragma("unroll") for (int m = mlo; m < mhi; ++m) _Pragma("unroll") for (int n = 0; n < 2; ++n) _Pragma("unroll") for (int k = 0; k < 2; ++k) \
        acc[ai][bj][m][n] = __builtin_amdgcn_mfma_f32_16x16x32_bf16(Bt[n][k], At[m][k], acc[ai][bj][m][n], 0, 0, 0); __builtin_amdgcn_s_setprio(0); } while (0)
#define PG8_WAIT_V(n) asm volatile("s_waitcnt vmcnt(" #n ")" ::: "memory")
#define PG8_WAIT_L(n) asm volatile("s_waitcnt lgkmcnt(" #n ")" ::: "memory")
#define PG8_BAR __builtin_amdgcn_s_barrier()
#define PG8_SCHED __builtin_amdgcn_sched_barrier(0)
    Unit cur, nxt; int ui = 0;
    if (!S.next(0, cur)) return;
    f32x4 acc[2][2][4][2];
#pragma unroll
    for (int a = 0; a < 2; ++a)
#pragma unroll
        for (int b = 0; b < 2; ++b)
#pragma unroll
            for (int m = 0; m < 4; ++m)
#pragma unroll
                for (int n = 0; n < 2; ++n) acc[a][b][m][n] = (f32x4){0.f, 0.f, 0.f, 0.f};
    bf16x8 At[4][2], B0[2][2], B1[2][2];
    if constexpr (ProbeTraits<Epi>::no_lds) { _Pragma("unroll") for (int m = 0; m < 4; ++m) _Pragma("unroll") for (int k = 0; k < 2; ++k) { _Pragma("unroll") for (int e = 0; e < 8; ++e) At[m][k][e] = (short)(0x3e00 | ((tid * 2654435761u + (m * 2 + k) * 40503u + e * 9176u) >> 16 & 0x81ff)); } _Pragma("unroll") for (int n = 0; n < 2; ++n) _Pragma("unroll") for (int k = 0; k < 2; ++k) { _Pragma("unroll") for (int e = 0; e < 8; ++e) { B0[n][k][e] = (short)(0x3e00 | ((tid * 40503u + (n * 2 + k) * 2654435761u + e * 7919u) >> 13 & 0x81ff)); B1[n][k][e] = (short)(0x3e00 | ((tid * 9973u + (n * 2 + k) * 1234577u + e * 7919u) >> 11 & 0x81ff)); } } }
    const char* cA = (const char*)g.A + (size_t)cur.pm * tstep; const char* cB = (const char*)g.Bt + (size_t)cur.pn * tstep;
    S.a_ready(cur);
    if constexpr (SP2) {
        PG8_STAGE(PG8_SB(0, 0), cB, voffB); PG8_STAGE(PG8_SB(0, 1), cB + hstep, voffB); PG8_STAGE(PG8_SA(0, 0), cA, voffA); PG8_STAGE(PG8_SA(0, 1), cA + hstep, voffA);
        if (wr == 1) PG8_BAR;
        PG8_WAIT_V(2); PG8_BAR;
#if defined(PG8_BAL_DMA)
        PG8_STAGE(PG8_SB(1, 0), cB + kstep, voffB); PG8_STAGE(PG8_SA(1, 0), cA + kstep, voffA);
        PG8_WAIT_V(4); PG8_BAR;
#else
        PG8_STAGE(PG8_SB(1, 0), cB + kstep, voffB); PG8_STAGE(PG8_SA(1, 0), cA + kstep, voffA); PG8_STAGE(PG8_SB(1, 1), cB + hstep + kstep, voffB);
        PG8_WAIT_V(6); PG8_BAR;
#endif
    } else {
        PG8_STAGE(PG8_SB(0, 0), cB, voffB); PG8_STAGE(PG8_SA(0, 0), cA, voffA); PG8_STAGE(PG8_SB(0, 1), cB + hstep, voffB); PG8_STAGE(PG8_SA(0, 1), cA + hstep, voffA);
        if (wr == 1) PG8_BAR;
        PG8_WAIT_V(4); PG8_BAR;
        PG8_STAGE(PG8_SB(1, 0), cB + kstep, voffB); PG8_STAGE(PG8_SA(1, 0), cA + kstep, voffA); PG8_STAGE(PG8_SB(1, 1), cB + hstep + kstep, voffB);
        PG8_WAIT_V(6); PG8_BAR;
    }
    for (;;) {
        const bool has_next = S.next(ui + 1, nxt);
        const char* nA = has_next ? (const char*)g.A + (size_t)nxt.pm * tstep : cA; const char* nB = has_next ? (const char*)g.Bt + (size_t)nxt.pn * tstep : cB;
#pragma unroll 1
        for (int t = 0; t < nt; t += 2) {
            const bool last = (t == nt - 2);
            const char* a1 = cA + (size_t)(t + 1) * kstep;
            const char* b1 = cB + (size_t)(t + 1) * kstep; (void)b1;
            const char* a2 = last ? nA : cA + (size_t)(t + 2) * kstep; const char* b2 = last ? nB : cB + (size_t)(t + 2) * kstep;
            const char* a3 = a2 + kstep; const char* b3 = b2 + kstep;
            if (last && has_next) S.a_ready(nxt);
            if constexpr (SP2) {
#if defined(PG8_BAL_DMA)
            PG8_LDB(B0, 0, 0); PG8_LDB(B1, 0, 1); PG8_SCHED; PG8_LDA(At, 0, 0); PG8_STAGE(PG8_SB(1, 1), b1 + hstep, voffB); PG8_STAGE(PG8_SA(1, 1), a1 + hstep, voffA);
            PG8_WAIT_V(8); PG8_WAIT_L(0); PG8_BAR; PG8_MMA(0, 0, At, B0); PG8_MMA(0, 1, At, B1); PG8_BAR; PG8_SCHED;
            PG8_LDA(At, 0, 1); PG8_STAGE(PG8_SB(0, 0), b2, voffB); PG8_STAGE(PG8_SA(0, 0), a2, voffA);
            PG8_WAIT_V(6); PG8_WAIT_L(0); PG8_BAR; PG8_MMA(1, 0, At, B0); PG8_MMA(1, 1, At, B1); PG8_BAR; PG8_SCHED;
            PG8_LDB(B0, 1, 0); PG8_LDB(B1, 1, 1); PG8_SCHED; PG8_LDA(At, 1, 0); PG8_STAGE(PG8_SB(0, 1), b2 + hstep, voffB); PG8_STAGE(PG8_SA(0, 1), a2 + hstep, voffA);
            PG8_WAIT_V(8); PG8_WAIT_L(0); PG8_BAR; PG8_MMA(0, 0, At, B0); PG8_MMA(0, 1, At, B1); PG8_BAR; PG8_SCHED;
            PG8_LDA(At, 1, 1); PG8_STAGE(PG8_SB(1, 0), b3, voffB); PG8_STAGE(PG8_SA(1, 0), a3, voffA);
            PG8_WAIT_V(6); PG8_WAIT_L(0); PG8_BAR; PG8_MMA(1, 0, At, B0); PG8_MMA(1, 1, At, B1); PG8_BAR; PG8_SCHED;
#elif defined(PG8_STAGE_IN_MMA)
            PG8_LDB(B0, 0, 0); PG8_LDB(B1, 0, 1); PG8_SCHED; PG8_LDA(At, 0, 0);
            PG8_WAIT_V(6); PG8_WAIT_L(0); PG8_BAR; PG8_MMA_H(0, 0, At, B0, 0, 2); PG8_SCHED; PG8_STAGE(PG8_SA(1, 1), a1 + hstep, voffA); PG8_SCHED; PG8_MMA_H(0, 0, At, B0, 2, 4); PG8_MMA(0, 1, At, B1); PG8_BAR; PG8_SCHED;
            PG8_LDA(At, 0, 1);
            PG8_WAIT_V(2); PG8_WAIT_L(0); PG8_BAR; PG8_MMA_H(1, 0, At, B0, 0, 2); PG8_SCHED; PG8_STAGE(PG8_SB(0, 0), b2, voffB); PG8_SCHED; PG8_MMA_H(1, 0, At, B0, 2, 4); PG8_SCHED; PG8_STAGE(PG8_SB(0, 1), b2 + hstep, voffB); PG8_SCHED;
            PG8_MMA_H(1, 1, At, B1, 0, 2); PG8_SCHED; PG8_STAGE(PG8_SA(0, 0), a2, voffA); PG8_SCHED; PG8_MMA_H(1, 1, At, B1, 2, 4); PG8_BAR; PG8_SCHED;
            PG8_LDB(B0, 1, 0); PG8_LDB(B1, 1, 1); PG8_SCHED; PG8_LDA(At, 1, 0);
            PG8_WAIT_V(6); PG8_WAIT_L(0); PG8_BAR; PG8_MMA_H(0, 0, At, B0, 0, 2); PG8_SCHED; PG8_STAGE(PG8_SA(0, 1), a2 + hstep, voffA); PG8_SCHED; PG8_MMA_H(0, 0, At, B0, 2, 4); PG8_MMA(0, 1, At, B1); PG8_BAR; PG8_SCHED;
            PG8_LDA(At, 1, 1);
            PG8_WAIT_V(2); PG8_WAIT_L(0); PG8_BAR; PG8_MMA_H(1, 0, At, B0, 0, 2); PG8_SCHED; PG8_STAGE(PG8_SB(1, 0), b3, voffB); PG8_SCHED; PG8_MMA_H(1, 0, At, B0, 2, 4); PG8_SCHED; PG8_STAGE(PG8_SB(1, 1), b3 + hstep, voffB); PG8_SCHED;
            PG8_MMA_H(1, 1, At, B1, 0, 2); PG8_SCHED; PG8_STAGE(PG8_SA(1, 0), a3, voffA); PG8_SCHED; PG8_MMA_H(1, 1, At, B1, 2, 4); PG8_BAR; PG8_SCHED;
#else
            PG8_LDB(B0, 0, 0); PG8_LDB(B1, 0, 1); PG8_SCHED; PG8_LDA(At, 0, 0); PG8_STAGE(PG8_SA(1, 1), a1 + hstep, voffA);
            PG8_WAIT_V(8); PG8_WAIT_L(0); PG8_BAR; PG8_MMA(0, 0, At, B0); PG8_MMA(0, 1, At, B1); PG8_BAR; PG8_SCHED;
            PG8_LDA(At, 0, 1); PG8_STAGE(PG8_SB(0, 0), b2, voffB); PG8_STAGE(PG8_SB(0, 1), b2 + hstep, voffB); PG8_STAGE(PG8_SA(0, 0), a2, voffA);
            PG8_WAIT_V(8); PG8_WAIT_L(0); PG8_BAR; PG8_MMA(1, 0, At, B0); PG8_MMA(1, 1, At, B1); PG8_BAR; PG8_SCHED;
            PG8_LDB(B0, 1, 0); PG8_LDB(B1, 1, 1); PG8_SCHED; PG8_LDA(At, 1, 0); PG8_STAGE(PG8_SA(0, 1), a2 + hstep, voffA);
            PG8_WAIT_V(8); PG8_WAIT_L(0); PG8_BAR; PG8_MMA(0, 0, At, B0); PG8_MMA(0, 1, At, B1); PG8_BAR; PG8_SCHED;
            PG8_LDA(At, 1, 1); PG8_STAGE(PG8_SB(1, 0), b3, voffB); PG8_STAGE(PG8_SB(1, 1), b3 + hstep, voffB); PG8_STAGE(PG8_SA(1, 0), a3, voffA);
            PG8_WAIT_V(8); PG8_WAIT_L(0); PG8_BAR; PG8_MMA(1, 0, At, B0); PG8_MMA(1, 1, At, B1); PG8_BAR; PG8_SCHED;
#endif
            } else {
            PG8_LDB(B0, 0, 0); PG8_SCHED; PG8_LDA(At, 0, 0); PG8_STAGE(PG8_SA(1, 1), a1 + hstep, voffA);
            PG8_WAIT_L(8); PG8_BAR; PG8_WAIT_L(0); PG8_MMA(0, 0, At, B0); PG8_BAR; PG8_SCHED;
            PG8_LDB(B1, 0, 1); PG8_STAGE(PG8_SB(0, 0), b2, voffB);
            PG8_BAR; PG8_WAIT_L(0); PG8_MMA(0, 1, At, B1); PG8_BAR;
            PG8_LDA(At, 0, 1); PG8_STAGE(PG8_SA(0, 0), a2, voffA);
            PG8_BAR; PG8_WAIT_L(0); PG8_MMA(1, 0, At, B0); PG8_BAR; PG8_SCHED;
            PG8_STAGE(PG8_SB(0, 1), b2 + hstep, voffB);
            PG8_WAIT_V(6); PG8_BAR; PG8_MMA(1, 1, At, B1); PG8_BAR;
            PG8_LDB(B0, 1, 0); PG8_SCHED; PG8_LDA(At, 1, 0); PG8_STAGE(PG8_SA(0, 1), a2 + hstep, voffA);
            PG8_WAIT_L(8); PG8_BAR; PG8_WAIT_L(0); PG8_MMA(0, 0, At, B0); PG8_BAR; PG8_SCHED;
            PG8_LDB(B1, 1, 1); PG8_STAGE(PG8_SB(1, 0), b3, voffB);
            PG8_BAR; PG8_WAIT_L(0); PG8_MMA(0, 1, At, B1); PG8_BAR;
            PG8_LDA(At, 1, 1); PG8_STAGE(PG8_SA(1, 0), a3, voffA);
            PG8_BAR; PG8_WAIT_L(0); PG8_MMA(1, 0, At, B0); PG8_BAR; PG8_SCHED;
            PG8_STAGE(PG8_SB(1, 1), b3 + hstep, voffB);
            PG8_WAIT_V(6); PG8_BAR; PG8_MMA(1, 1, At, B1); PG8_BAR;
            }
        }
        if constexpr (ALIGN_EPI) { if (wr == 0) PG8_BAR; }
        if constexpr (!Epi::AFTER_DRAIN) { E(acc, cur, wr, wc, fr, fq); S.done(cur); }
        if (!has_next) break;
#pragma unroll
        for (int a = 0; a < 2; ++a)
#pragma unroll
            for (int b = 0; b < 2; ++b)
#pragma unroll
                for (int m = 0; m < 4; ++m)
#pragma unroll
                    for (int n = 0; n < 2; ++n) acc[a][b][m][n] = (f32x4){0.f, 0.f, 0.f, 0.f};
        cur = nxt; cA = nA; cB = nB; ++ui;
        if constexpr (ALIGN_EPI) { if (wr == 1) PG8_BAR; }
    }
    PG8_WAIT_V(0);
    if constexpr (!ALIGN_EPI) { if (wr == 0) PG8_BAR; }
    PG8_BAR;
    if constexpr (Epi::AFTER_DRAIN) { E.fused(acc, cur, wr, wc, fr, fq, lds, wid, lane); S.done(cur); }
#undef PG8_SA
#undef PG8_SB
#undef PG8_STAGE
#undef PG8_LDA
#undef PG8_LDB
#undef PG8_MMA
#undef PG8_WAIT_V
#undef PG8_WAIT_L
#undef PG8_BAR
#undef PG8_SCHED
}
}

constexpr int NWAVES = 8;
constexpr int N_PHASES = 11;
constexpr int N_LAUNCHES = MK_N_LAUNCHES;
constexpr int LDS_BYTES = 155648;
constexpr int RING_BYTES = 131072, LDSCTL_OFF = LDS_BYTES - 512, MISC_OFF = LDSCTL_OFF + 320;
constexpr int CW_BAR = 4096;
#define GAS __attribute__((address_space(1)))
#define LAS __attribute__((address_space(3)))
typedef unsigned short bf16;
typedef unsigned v4u __attribute__((ext_vector_type(4)));
typedef unsigned v2u __attribute__((ext_vector_type(2)));
typedef float f32x4 __attribute__((ext_vector_type(4)));
typedef float f32x16 __attribute__((ext_vector_type(16)));
typedef short bf16x8 __attribute__((ext_vector_type(8)));
typedef short s16x4 __attribute__((ext_vector_type(4)));
typedef short v4i16_t __attribute__((ext_vector_type(4)));
typedef GAS unsigned gu32;
#define LDS_WAIT() asm volatile("s_waitcnt lgkmcnt(0)" ::: "memory")
#define VM_WAIT() asm volatile("s_waitcnt vmcnt(0)" ::: "memory")
__device__ __forceinline__ unsigned pk2(float lo, float hi) { return pg8::cvt_pk_bf16(lo, hi); }
__device__ __forceinline__ float bflo(unsigned w) { return __uint_as_float(w << 16); }
__device__ __forceinline__ float bfhi(unsigned w) { return __uint_as_float(w & 0xffff0000u); }
__device__ __forceinline__ float bf1(bf16 h) { return __uint_as_float((unsigned)h << 16); }
__device__ __forceinline__ float ex2(float x) { return __builtin_amdgcn_exp2f(x); }
__device__ __forceinline__ float sigm(float x) { return __builtin_amdgcn_rcpf(1.f + __builtin_amdgcn_exp2f(-x * LOG2E)); }
__device__ __forceinline__ float wave_sum(float v) {
#pragma unroll
    for (int o = 1; o < 64; o <<= 1) v += __shfl_xor(v, o);
    return v;
}
__device__ __forceinline__ float swap32f(float v) {
    auto rr = __builtin_amdgcn_permlane32_swap(__float_as_uint(v), __float_as_uint(v), false, false);
    return (threadIdx.x & 32) ? __uint_as_float(rr[0]) : __uint_as_float(rr[1]);
}
__device__ __forceinline__ s16x4 trrd(const LAS char* p) { return __builtin_bit_cast(s16x4, __builtin_amdgcn_ds_read_tr16_b64_v4i16((LAS v4i16_t*)p)); }
#define MK8(lo, hi) (bf16x8){lo[0], lo[1], lo[2], lo[3], hi[0], hi[1], hi[2], hi[3]}

#define XB_TMO      128
#define XB_XCNT(j)  (256  + 64 * (j))
#define XB_XSUB(j)  (1280 + 64 * (j))
#define XB_XGEN(j)  (2304 + 64 * (j))
#define XB_TOP      3328
#define XB_TOPGEN   3392
#define XCD_BAR_WORDS 3456
#define XB_SPIN_CAP (1u << 18)

__device__ __forceinline__ unsigned xb_ld(unsigned* p)              { return __hip_atomic_load(p, __ATOMIC_RELAXED, __HIP_MEMORY_SCOPE_AGENT); }
__device__ __forceinline__ unsigned xb_add(unsigned* p, unsigned v) { return __hip_atomic_fetch_add(p, v, __ATOMIC_RELAXED, __HIP_MEMORY_SCOPE_AGENT); }
__device__ __forceinline__ unsigned xb_xcc_id() { return (unsigned)__builtin_amdgcn_s_getreg((3 << 11) | 20) & 0xFu; }
#define XB_SPIN(cond, bar) do { unsigned _sp = 0; while (cond) { __builtin_amdgcn_s_sleep(1); \
    if ((++_sp & 255u) == 0u) { if (xb_ld(&(bar)[XB_TMO])) break; if (_sp > XB_SPIN_CAP) { atomicAdd(&(bar)[XB_TMO], 1u); break; } } } } while (0)

struct XcdBarrier {
    unsigned* bar; unsigned x;
    volatile LAS unsigned* st;
};

__device__ __forceinline__ XcdBarrier xcd_barrier_post(unsigned* bar, volatile LAS unsigned* st) {
    XcdBarrier b; b.bar = bar; b.x = xb_xcc_id(); b.st = st;
    if (threadIdx.x == 0) (void)xb_add(&bar[XB_XCNT(b.x)], 1u);
    return b;
}
__device__ __forceinline__ void xcd_barrier_complete(unsigned* bar, unsigned x, unsigned& nloc, unsigned& nx) {
    const unsigned G = gridDim.x * gridDim.y * gridDim.z;
    unsigned sum, cnt, mine, sp = 0u;
    for (;;) {
        sum = 0u; cnt = 0u; mine = 0u;
#pragma unroll
        for (unsigned j = 0; j < 16; ++j) { const unsigned c = xb_ld(&bar[XB_XCNT(j)]); sum += c; cnt += (c > 0u) ? 1u : 0u; mine = (j == x) ? c : mine; }
        if (sum == G) break;
        __builtin_amdgcn_s_sleep(1);
        if ((++sp & 255u) == 0u) { if (xb_ld(&bar[XB_TMO])) break; if (sp > XB_SPIN_CAP) { atomicAdd(&bar[XB_TMO], 1u); break; } }
    }
    nloc = mine > 0u ? mine : 1u; nx = cnt > 0u ? cnt : 1u;
}

__device__ __forceinline__ void xcd_barrier(const XcdBarrier& b) {
    asm volatile("s_waitcnt vmcnt(0)" ::: "memory");
    __syncthreads();
    if (threadIdx.x == 0) {
        unsigned* bar = b.bar;
        __builtin_amdgcn_s_waitcnt(0);
        unsigned nloc = b.st[0], nx = b.st[1];
        if (nloc == 0u) { xcd_barrier_complete(bar, b.x, nloc, nx); b.st[0] = nloc; b.st[1] = nx; }
        const unsigned old = xb_add(&bar[XB_XSUB(b.x)], 1u);
        const unsigned gen = old / nloc;
        if (old + 1u == (gen + 1u) * nloc) {
            __builtin_amdgcn_fence(__ATOMIC_RELEASE, "agent");
            asm volatile("s_waitcnt vmcnt(0)" ::: "memory");
            const unsigned og = xb_add(&bar[XB_TOP], 1u);
            const unsigned tg = og / nx;
            if (og + 1u == (tg + 1u) * nx) xb_add(&bar[XB_TOPGEN], 1u);
            else XB_SPIN(xb_ld(&bar[XB_TOPGEN]) == tg, bar);
            __builtin_amdgcn_fence(__ATOMIC_ACQUIRE, "agent");
            xb_add(&bar[XB_XGEN(b.x)], 1u);
            asm volatile("s_waitcnt vmcnt(0)" ::: "memory");
        } else {
            XB_SPIN(xb_ld(&bar[XB_XGEN(b.x)]) == gen, bar);
            __builtin_amdgcn_fence(__ATOMIC_ACQUIRE, "agent");
            asm volatile("s_waitcnt vmcnt(0)" ::: "memory");
        }
    }
    __syncthreads();
}

struct Args { const float* in[19]; float* out; unsigned char* ws; int ph_lo, ph_hi, li, pad; };
enum { I_X = 0, I_P, I_NMPRE, I_NMPOST, I_NFPRE, I_NFPOST, I_WIN, I_GNG, I_PEK, I_W1K, I_W2K, I_PEV, I_W1V, I_W2V, I_WOUT, I_WFI, I_WFO, I_WPLE, I_WGATE };
struct Ctx { LAS unsigned char* lds; int tid, lane, wave, vcu, G; };

struct MapId { __device__ __forceinline__ int operator()(int v) const { return v; } };
struct MapWin { __device__ __forceinline__ int operator()(int v) const { return v < 4608 ? v : (v < 6656 ? v - 4608 + 5616 : (v < 7664 ? v - 6656 + 4608 : -1)); } };
struct MapFfn { __device__ __forceinline__ int operator()(int v) const { const int pn = v >> 8, r = v & 255, ch = pn * 128 + 32 * (r >> 6) + (r & 31); return ((r >> 5) & 1) ? DFF + ch : ch; } };
__device__ __forceinline__ int tile_logical(int v) { return (v & ~255) | (64 * ((v >> 5) & 3) + 32 * ((v >> 7) & 1) + (v & 31)); }
template <class MAP>
__device__ __forceinline__ void p0_transpose_item(const float* W, int K, int N, int Nv, bf16* WT, LAS float* scr, int item, int lane, const MAP& map, bool tperm, const float* kscale = nullptr) {
    const int nblk = Nv / 32, kb = item / nblk, nb = item % nblk, k0 = 64 * kb, n0 = 32 * nb;
    const int ac = map(tperm ? tile_logical(n0 + (lane & 31)) : n0 + (lane & 31));
#pragma unroll 16
    for (int i = 0; i < 32; ++i) { const int kk = 2 * i + (lane >> 5); const float ks = kscale ? kscale[k0 + kk] : 1.f; scr[kk * 33 + (lane & 31)] = ac >= 0 ? W[(size_t)(k0 + kk) * N + ac] * ks : 0.f; }
    LDS_WAIT(); asm volatile("" ::: "memory");
    const int c = lane & 7;
#pragma unroll
    for (int j = 0; j < 4; ++j) { const int n = (lane >> 3) + 8 * j; const LAS float* s = scr + (8 * c) * 33 + n;
        v4u o; o.x = pk2(s[0 * 33], s[1 * 33]); o.y = pk2(s[2 * 33], s[3 * 33]); o.z = pk2(s[4 * 33], s[5 * 33]); o.w = pk2(s[6 * 33], s[7 * 33]);
        *(GAS v4u*)(WT + (size_t)(n0 + n) * K + k0 + 8 * c) = o; }
    LDS_WAIT(); asm volatile("" ::: "memory");
}
template <int NR>
__device__ __forceinline__ void rms_rows_to_bf16(const float* x, const float* p, const f32x4 (&gg)[4], bf16* H, bf16* PB, int m0, int stride, int lane) {
    f32x4 v[NR][4], pv[NR];
#pragma unroll
    for (int r = 0; r < NR; ++r) { const GAS f32x4* xr = (const GAS f32x4*)(x + (size_t)(m0 + r * stride) * DM) + lane;
#pragma unroll
        for (int j = 0; j < 4; ++j) v[r][j] = __builtin_nontemporal_load(xr + 64 * j);
        pv[r] = __builtin_nontemporal_load((const GAS f32x4*)(p + (size_t)(m0 + r * stride) * PLE_D) + lane); }
#pragma unroll
    for (int r = 0; r < NR; ++r) { float s = 0.f;
#pragma unroll
        for (int j = 0; j < 4; ++j) s += (v[r][j].x * v[r][j].x + v[r][j].y * v[r][j].y) + (v[r][j].z * v[r][j].z + v[r][j].w * v[r][j].w);
        const float rstd = __builtin_amdgcn_rsqf(wave_sum(s) * (1.f / DM) + RMS_EPS);
        GAS v2u* o8 = (GAS v2u*)(H + (size_t)(m0 + r * stride) * DM) + lane;
#pragma unroll
        for (int j = 0; j < 4; ++j) { v2u w; w.x = pk2(v[r][j].x * rstd * gg[j].x, v[r][j].y * rstd * gg[j].y); w.y = pk2(v[r][j].z * rstd * gg[j].z, v[r][j].w * rstd * gg[j].w); o8[64 * j] = w; }
        v2u w; w.x = pk2(pv[r].x, pv[r].y); w.y = pk2(pv[r].z, pv[r].w); *((GAS v2u*)(PB + (size_t)(m0 + r * stride) * PLE_D) + lane) = w; }
}
__device__ __forceinline__ void p0_prologue(const Ctx& C, const Args& A) {
    LAS float* scr = (LAS float*)(C.lds + C.wave * 16384);
    const int gw = C.vcu * NWAVES + C.wave, NGW = C.G * NWAVES, lane = C.lane;
    unsigned char* ws = A.ws;
    constexpr int I_IN = 16 * (IN_VIRT / 32), I_OUT = 16 * 32, I_FI = 16 * (2 * DFF / 32), I_FO = (DFF / 64) * 32, I_PL = 4 * 32, I_GT = 16 * 32, I_1K = 48 * 3, I_1V = 32 * 2;
    constexpr int NITEMS = I_IN + I_OUT + I_FI + I_FO + I_PL + I_GT + I_1K + I_1V;
#if defined(P0_PROBE)
    for (int it2 = gw; it2 < 2 * NITEMS; it2 += NGW) {
        const int it = it2 >= NITEMS ? it2 - NITEMS : it2;
        int r = it;
#else
    for (int it = gw; it < NITEMS; it += NGW) {
        int r = it;
#endif
        if (r < I_IN) { p0_transpose_item(A.in[I_WIN], DM, IN_TOTAL, IN_VIRT, (bf16*)(ws + WS_WIN), scr, r, lane, MapWin(), true); continue; } r -= I_IN;
        if (r < I_OUT) { p0_transpose_item(A.in[I_WOUT], DM, DM, DM, (bf16*)(ws + WS_WOUT), scr, r, lane, MapId(), true); continue; } r -= I_OUT;
        if (r < I_FI) { p0_transpose_item(A.in[I_WFI], DM, 2 * DFF, 2 * DFF, (bf16*)(ws + WS_WFI), scr, r, lane, MapFfn(), true, A.in[I_NFPRE]); continue; } r -= I_FI;
        if (r < I_FO) { p0_transpose_item(A.in[I_WFO], DFF, DM, DM, (bf16*)(ws + WS_WFO), scr, r, lane, MapId(), true); continue; } r -= I_FO;
        if (r < I_PL) { p0_transpose_item(A.in[I_WPLE], PLE_D, DM, DM, (bf16*)(ws + WS_WPLE), scr, r, lane, MapId(), true); continue; } r -= I_PL;
        if (r < I_GT) { p0_transpose_item(A.in[I_WGATE], DM, DM, DM, (bf16*)(ws + WS_WG), scr, r, lane, MapId(), true); continue; } r -= I_GT;
        if (r < I_1K) { p0_transpose_item(A.in[I_W1K], 3072, 96, 96, (bf16*)(ws + WS_W1K), scr, r, lane, MapId(), false); continue; } r -= I_1K;
        p0_transpose_item(A.in[I_W1V], 2048, 64, 64, (bf16*)(ws + WS_W1V), scr, r, lane, MapId(), false);
    }
    { const int gt = (C.vcu * NWAVES + C.wave) * 64 + lane, NGT = NGW * 64;
      for (int i = gt; i < 96 * 96; i += NGT) { const int n = i / 96, k = i % 96; ((bf16*)(ws + WS_W2K))[i] = (bf16)(pk2(A.in[I_W2K][k * 96 + n], 0.f) & 0xffffu); }
      for (int i = gt; i < 64 * 64; i += NGT) { const int n = i / 64, k = i % 64; ((bf16*)(ws + WS_W2V))[i] = (bf16)(pk2(A.in[I_W2V][k * 64 + n], 0.f) & 0xffffu); } }
    { constexpr int W0 = (NITEMS % (256 * NWAVES)) + 640 <= 256 * NWAVES ? NITEMS % (256 * NWAVES) : 0;
      const int o4 = gw - W0;
      if (o4 >= 0 && o4 < 640) {
        const int o = o4 >> 2, sl = o4 & 3; const bool isk = o < 96; const int j = isk ? o : o - 96, J = isk ? 96 : 64, KQ = isk ? 768 : 512;
        const GAS float* pe = (const GAS float*)A.in[isk ? I_PEK : I_PEV] + sl * KQ; const GAS float* w1 = (const GAS float*)A.in[isk ? I_W1K : I_W1V] + (size_t)sl * KQ * J;
        float s = 0.f;
#pragma unroll 4
        for (int k = lane; k < KQ; k += 64) s += pe[k] * w1[(size_t)k * J + j];
        s = wave_sum(s);
        if (lane == 0) ((GAS float*)(ws + (isk ? WS_C1K : WS_C1V)))[4 * j + sl] = s;
      } }
    bf16* H = (bf16*)((unsigned char*)A.out + OUT_H); bf16* PB = (bf16*)((unsigned char*)A.out + OUT_PBF);
    { f32x4 gg[4];
#pragma unroll
      for (int j = 0; j < 4; ++j) gg[j] = *((const GAS f32x4*)A.in[I_NMPRE] + lane + 64 * j);
      static_assert(M_TOK % (4 * 256 * NWAVES) == 0, "four rows per wave per step");
      for (int m = gw; m < M_TOK; m += 4 * NGW) rms_rows_to_bf16<4>(A.in[I_X], A.in[I_P], gg, H, PB, m, NGW, lane); }
}


__device__ __forceinline__ int crow(int r, int hi) { return (r & 3) + 8 * (r >> 2) + 4 * hi; }
template <int DD, int NJT>
__device__ __forceinline__ void cmp_unit(const Ctx& C, const bf16* src, const bf16* w1t, const bf16* w2t, const float* c1, bf16* dst, int bg, int nt) {
    constexpr int J = DD, KK = 32 * DD, HS = J + 8;
    const int lane = C.lane, w = C.wave, r32 = lane & 31, hi = lane >> 5;
    const int b = bg >> 1, g = bg & 1, n0 = 32 * nt;
    LAS float* red = (LAS float*)C.lds;
    LAS bf16* hidg = (LAS bf16*)(C.lds + 8 * 32 * J * 4);
    f32x16 acc[NJT];
#pragma unroll
    for (int jt = 0; jt < NJT; ++jt) acc[jt] = f32x16{};
    const int n = n0 + r32;
#pragma unroll 1
    for (int li = 0; li < 4; ++li) {
        const int l = 4 * w + li;
        int tok = 16 * n + l; tok = tok < SEQ ? tok : SEQ - 1;
        const bf16* ap = src + ((size_t)(b * SEQ + tok)) * (2 * DD) + g * DD + hi * 8;
        const bf16* bp = w1t + (size_t)r32 * KK + l * DD + hi * 8;
#pragma unroll
        for (int s = 0; s < DD / 16; ++s) {
            const bf16x8 af = *(const bf16x8*)(ap + 16 * s);
#pragma unroll
            for (int jt = 0; jt < NJT; ++jt) { const bf16x8 bfr = *(const bf16x8*)(bp + (size_t)(32 * jt) * KK + 16 * s);
                acc[jt] = __builtin_amdgcn_mfma_f32_32x32x16_bf16(af, bfr, acc[jt], 0, 0, 0); }
        }
    }
#pragma unroll
    for (int jt = 0; jt < NJT; ++jt)
#pragma unroll
        for (int r = 0; r < 16; ++r) red[(w * 32 + crow(r, hi)) * J + 32 * jt + r32] = acc[jt][r];
    __syncthreads();
    for (int e = C.tid; e < 32 * J; e += NWAVES * 64) { const int nn = e / J, j = e % J; const f32x4 c4 = *(const GAS f32x4*)(c1 + 4 * j); float s = (c4.x + c4.y) + (c4.z + c4.w);
#pragma unroll
        for (int ww = 0; ww < 8; ++ww) s += red[(ww * 32 + nn) * J + j];
        const float u = 0.7978845608028654f * (s + 0.044715f * s * s * s);
        const float th = 1.f - 2.f * __builtin_amdgcn_rcpf(1.f + ex2(2.f * LOG2E * u));
        hidg[nn * HS + j] = (bf16)(pk2(0.5f * s * (1.f + th), 0.f) & 0xffffu); }
    __syncthreads();
    if (w < NJT) {
        f32x16 a2 = f32x16{};
#pragma unroll
        for (int s = 0; s < J / 16; ++s) { const bf16x8 af = *(const LAS bf16x8*)(hidg + r32 * HS + 16 * s + 8 * hi); const bf16x8 bfr = *(const bf16x8*)(w2t + (size_t)(32 * w + r32) * J + 16 * s + 8 * hi);
            a2 = __builtin_amdgcn_mfma_f32_32x32x16_bf16(af, bfr, a2, 0, 0, 0); }
#pragma unroll
        for (int r = 0; r < 16; ++r) { const int nn = n0 + crow(r, hi); dst[((size_t)bg * 256 + nn) * J + 32 * w + r32] = (bf16)(pk2(nn < 255 ? a2[r] : 0.f, 0.f) & 0xffffu); }
    }
    __syncthreads();
}
__device__ __forceinline__ void p2_compress(const Ctx& C, const Args& A) {
    unsigned char* ws = A.ws;
#if defined(DBG_CMP_ZERO)
    { v4u z = v4u{0u, 0u, 0u, 0u}; v4u* o = (v4u*)(ws + WS_KCMP);
      for (size_t i = (size_t)C.vcu * 512 + C.tid; i < (size_t)(WS_SSP - WS_KCMP) / 16; i += (size_t)C.G * 512) o[i] = z; }
    return;
#endif
    for (int u = C.vcu; u < 512; u += C.G) {
        const int idx = u & 255, bg = idx >> 3, nt = idx & 7;
        if (u < 256) cmp_unit<96, 3>(C, (const bf16*)(ws + WS_KC), (const bf16*)(ws + WS_W1K), (const bf16*)(ws + WS_W2K), (const float*)(ws + WS_C1K), (bf16*)(ws + WS_KCMP), bg, nt);
        else         cmp_unit<64, 2>(C, (const bf16*)(ws + WS_VC), (const bf16*)(ws + WS_W1V), (const bf16*)(ws + WS_W2V), (const float*)(ws + WS_C1V), (bf16*)(ws + WS_VCMP), bg, nt);
    }
}


constexpr int NSA_KSTR = 208;
constexpr int NSA_KB = 64 * NSA_KSTR;
constexpr int NSA_K0 = 0, NSA_K1 = NSA_KB, NSA_V0 = 2 * NSA_KB, NSA_V1 = NSA_V0 + 8192, NSA_IMPG = NSA_V1 + 8192, NSA_IMPL = NSA_IMPG + 64 * 32 * 4, NSA_WM = NSA_IMPL + 65 * 32 * 4, NSA_END = NSA_WM + 64, NSA_OUT = 61440, NSA_OUT_END = NSA_OUT + 8 * 10240, NSA_IMPS_END = NSA_OUT_END;
static_assert(NSA_END <= NSA_OUT && NSA_IMPS_END <= LDSCTL_OFF && NSA_OUT_END <= LDSCTL_OFF && (NSA_WM % 16) == 0, "NSA LDS map");
constexpr float NEGBIG = -1e30f, M_INIT = -5e29f;

constexpr float NSA_THR = 8.f;
template <int MODE, bool SEL, bool IMPS = false>
__device__ __forceinline__ void nsa_branch(const Ctx& C, const GAS bf16* Kg, int kp, const GAS bf16* Vg, int vp, unsigned long long tilemask,
                                           const bf16x8 (&qf)[6], float& mref, bool& has, float& l, f32x16& o0, f32x16& o1,
                                           int t, int lo, int hq, bool lane_en, unsigned long long selmask, unsigned long long wavemask,
                                           int wlo, int whi, int wlo_in, int whi_in, float slope2, int ka, int kb, float invl, int qi) {
    constexpr bool LOADV = (MODE == 0);
    const int tid = C.tid, lane = C.lane, r32 = lane & 31, hi = lane >> 5;
    LAS char* lds = (LAS char*)C.lds;
    const int wv_ = C.wave;
    const int kc_a = wv_ * 64 + lane, kc_b = kc_a + 512;
    const bool kv_a = (kc_a % 13) < 12, kv_b = (wv_ + 8 < 13) && (kc_b % 13) < 12;
    const int ko_a = (kc_a / 13) * kp * 2 + (kc_a % 13) * 16, ko_b = (kc_b / 13) * kp * 2 + (kc_b % 13) * 16;
    const int vo_ = wv_ * 1024 + lane * 16;
    const int vo_g = ((vo_ & 4095) >> 6) * vp * 2 + ((vo_ >> 12) * 4 + ((vo_ & 63) >> 4)) * 16;
    const __amdgpu_buffer_rsrc_t rsK = __builtin_amdgcn_make_buffer_rsrc((void*)Kg, 0, 0x7fffffff, 0x00020000), rsV = __builtin_amdgcn_make_buffer_rsrc((void*)Vg, 0, 0x7fffffff, 0x00020000);
#define NSA_DMA(bb, jj) do { const int ks_ = 64 * (jj) * kp * 2, vs_ = 64 * (jj) * vp * 2; \
        if (kv_a) __builtin_amdgcn_raw_ptr_buffer_load_lds(rsK, (LAS unsigned*)(lds + ((bb) ? NSA_K1 : NSA_K0) + wv_ * 1024), 16, ko_a, ks_, 0, 0); \
        if (kv_b) __builtin_amdgcn_raw_ptr_buffer_load_lds(rsK, (LAS unsigned*)(lds + ((bb) ? NSA_K1 : NSA_K0) + (wv_ + 8) * 1024), 16, ko_b, ks_, 0, 0); \
        if (LOADV) __builtin_amdgcn_raw_ptr_buffer_load_lds(rsV, (LAS unsigned*)(lds + ((bb) ? NSA_V1 : NSA_V0) + wv_ * 1024), 16, vo_g, vs_, 0, 0); } while (0)
#define NSA_DMA_WAIT() asm volatile("s_waitcnt vmcnt(0)" ::: "memory")
#define NSA_TOPBIT(x) (63 - __builtin_clzll(x))
    unsigned long long rem = tilemask;
    if (rem == 0ull) return;
    int j = NSA_TOPBIT(rem); rem &= ~(1ull << j);
    NSA_DMA(0, j); NSA_DMA_WAIT(); __syncthreads();
    int buf = 0;
    const float sa = slope2 * (float)ka;
    const unsigned span = (unsigned)(hq - lo);
    for (;;) {
        const bool more = rem != 0ull; int jn = 0;
        if (more) { jn = NSA_TOPBIT(rem); rem &= ~(1ull << jn); NSA_DMA(buf ^ 1, jn); }
        const bool wneed = SEL ? (((wavemask >> j) & 1ull) != 0ull) : true;
        if (wneed) {
            const bool en = lane_en && (SEL ? (((selmask >> j) & 1ull) != 0ull) : true);
            const bool do1 = (64 * j + 32 <= whi) && (64 * j + 63 >= wlo), do0 = (64 * j <= whi) && (64 * j + 31 >= wlo);
            const LAS char* kt_ = lds + (buf ? NSA_K1 : NSA_K0) + r32 * NSA_KSTR + hi * 16;
            const LAS char* vt_ = lds + (buf ? NSA_V1 : NSA_V0) + ((lane >> 4) & 1) * 32 + (lane & 3) * 8 + (4 * hi + ((lane & 15) >> 2)) * 64;
            bf16x8 kfA[6], kfB[6]; s16x4 vA[8], vB[8];
            if (do1) {
#pragma unroll
                for (int s = 0; s < 6; ++s) kfA[s] = *(const LAS bf16x8*)(kt_ + 32 * NSA_KSTR + 32 * s);
                if (MODE == 0) {
#pragma unroll
                    for (int q = 0; q < 4; ++q) { vA[2 * q] = trrd(vt_ + 2048 + (q >> 1) * 4096 + (q & 1) * 1024); vA[2 * q + 1] = trrd(vt_ + 2048 + (q >> 1) * 4096 + (q & 1) * 1024 + 512); }
                }
            }
            if (do0) {
#pragma unroll
                for (int s = 0; s < 6; ++s) kfB[s] = *(const LAS bf16x8*)(kt_ + 32 * s);
                if (MODE == 0) {
#pragma unroll
                    for (int q = 0; q < 4; ++q) { vB[2 * q] = trrd(vt_ + (q >> 1) * 4096 + (q & 1) * 1024); vB[2 * q + 1] = trrd(vt_ + (q >> 1) * 4096 + (q & 1) * 1024 + 512); }
                }
            }
#pragma unroll
            for (int sb = 0; sb < 2; ++sb) {
                const int sub = 1 - sb;
                const int i0 = 64 * j + 32 * sub;
                if (sub ? do1 : do0) {
                    const int ib = i0 + 4 * hi;
                    const float bias0 = en ? (-slope2 * (float)(t - (ka * ib + kb)) - mref) : NEGBIG;
                    f32x16 p;
                    if (i0 >= wlo_in && i0 + 31 <= whi_in) {
#pragma unroll
                        for (int r = 0; r < 16; ++r) { const int ci = (r & 3) + 8 * (r >> 2); p[r] = bias0 + sa * (float)ci; }
                    } else {
#pragma unroll
                        for (int r = 0; r < 16; ++r) { const int ci = (r & 3) + 8 * (r >> 2); const bool v = ((unsigned)(ib + ci - lo) <= span); p[r] = v ? (bias0 + sa * (float)ci) : NEGBIG; }
                    }
#pragma unroll
                    for (int s = 0; s < 6; ++s) p = __builtin_amdgcn_mfma_f32_32x32x16_bf16(sub ? kfA[s] : kfB[s], qf[s], p, 0, 0, 0);
                    if (MODE == 0) {
                        float mx = __builtin_fmaxf(__builtin_fmaxf(p[0], p[1]), p[2]);
#pragma unroll
                        for (int r = 3; r < 15; r += 2) mx = __builtin_fmaxf(__builtin_fmaxf(mx, p[r]), p[r + 1]);
                        mx = __builtin_fmaxf(mx, p[15]);
                        { auto rr = __builtin_amdgcn_permlane32_swap(__float_as_uint(mx), __float_as_uint(mx), false, false); mx = __builtin_fmaxf(__uint_as_float(rr[0]), __uint_as_float(rr[1])); }
                        const bool valid = mx > -1e29f;
                        const bool mv = valid && (!has || mx > NSA_THR);
                        if (__any(mv)) {
                            const float delta = mv ? mx : 0.f, f = (mv && has) ? ex2(-delta) : 1.f;
                            mref += delta; has = has || valid;
#pragma unroll
                            for (int r = 0; r < 16; ++r) p[r] -= delta;
                            l *= f; o0 = o0 * f; o1 = o1 * f;
                        }
#pragma unroll
                        for (int r = 0; r < 16; ++r) p[r] = ex2(p[r]);
                        const float g0_ = (p[0] + p[1]) + (p[2] + p[3]), g1_ = (p[4] + p[5]) + (p[6] + p[7]), g2_ = (p[8] + p[9]) + (p[10] + p[11]), g3_ = (p[12] + p[13]) + (p[14] + p[15]);
                        l += (g0_ + g1_) + (g2_ + g3_);
                        v4u w0, w1; w0.x = pk2(p[0], p[1]); w0.y = pk2(p[2], p[3]); w0.z = pk2(p[4], p[5]); w0.w = pk2(p[6], p[7]);
                        w1.x = pk2(p[8], p[9]); w1.y = pk2(p[10], p[11]); w1.z = pk2(p[12], p[13]); w1.w = pk2(p[14], p[15]);
                        const bf16x8 pa0 = __builtin_bit_cast(bf16x8, w0), pa1 = __builtin_bit_cast(bf16x8, w1);
                        if (IMPS) {
                            LAS unsigned* ip = (LAS unsigned*)(lds + NSA_OUT + ((C.wave * 8 + (i0 >> 5)) * 320 + lane) * 4);
                            ip[0] = pk2(g0_, g1_); ip[64] = pk2(g2_, g3_); ip[128] = __builtin_amdgcn_perm(w0.w, w0.y, 0x07060302u); ip[192] = __builtin_amdgcn_perm(w1.w, w1.y, 0x07060302u); ip[256] = __float_as_uint(mref); }
                        if (sub) {
                            o0 = __builtin_amdgcn_mfma_f32_32x32x16_bf16(MK8(vA[0], vA[1]), pa0, o0, 0, 0, 0); o1 = __builtin_amdgcn_mfma_f32_32x32x16_bf16(MK8(vA[4], vA[5]), pa0, o1, 0, 0, 0);
                            o0 = __builtin_amdgcn_mfma_f32_32x32x16_bf16(MK8(vA[2], vA[3]), pa1, o0, 0, 0, 0); o1 = __builtin_amdgcn_mfma_f32_32x32x16_bf16(MK8(vA[6], vA[7]), pa1, o1, 0, 0, 0);
                        } else {
                            o0 = __builtin_amdgcn_mfma_f32_32x32x16_bf16(MK8(vB[0], vB[1]), pa0, o0, 0, 0, 0); o1 = __builtin_amdgcn_mfma_f32_32x32x16_bf16(MK8(vB[4], vB[5]), pa0, o1, 0, 0, 0);
                            o0 = __builtin_amdgcn_mfma_f32_32x32x16_bf16(MK8(vB[2], vB[3]), pa1, o0, 0, 0, 0); o1 = __builtin_amdgcn_mfma_f32_32x32x16_bf16(MK8(vB[6], vB[7]), pa1, o1, 0, 0, 0);
                        }
                    } else {
                        LAS float* impG = (LAS float*)(lds + NSA_IMPG); LAS float* impL = (LAS float*)(lds + NSA_IMPL);
#pragma unroll
                        for (int r = 0; r < 16; ++r) p[r] = ex2(p[r]);
#pragma unroll
                        for (int k = 0; k < 4; ++k) { float G = ((p[4 * k] + p[4 * k + 1]) + (p[4 * k + 2] + p[4 * k + 3])) * invl, L = p[4 * k + 3] * invl;
                            G += __shfl_xor(G, 1); L += __shfl_xor(L, 1); G += __shfl_xor(G, 2); L += __shfl_xor(L, 2); G += __shfl_xor(G, 4); L += __shfl_xor(L, 4);
                            if ((r32 & 7) == 0) { const int jb = (i0 >> 2) + 2 * k + hi; impG[jb * 32 + qi] = G; impL[(jb + 1) * 32 + qi] = L; } }
                    }
                }
            }
        }
        NSA_DMA_WAIT();
        __syncthreads();
        if (!more) break;
        j = jn; buf ^= 1;
    }
#undef NSA_DMA
#undef NSA_DMA_WAIT
#undef NSA_TOPBIT
}

__device__ __forceinline__ void nsa_unit(const Ctx& C, const Args& A, int b, int g, int c) {
    unsigned long long wsu = (unsigned long long)A.ws, outu = (unsigned long long)A.out;
    asm volatile("" : "+s"(wsu), "+s"(outu));
    const GAS unsigned char* ws = (const GAS unsigned char*)wsu; GAS unsigned char* outb = (GAS unsigned char*)outu;
    const int tid = C.tid, lane = C.lane, w = C.wave, r32 = lane & 31, hi = lane >> 5, q4 = r32 >> 3, hh = r32 & 7;
    LAS char* lds = (LAS char*)C.lds;
    const int qi = 4 * w + q4, t = 32 * c + qi, head = g * 8 + hh;
    const size_t row = (size_t)b * SEQ + t;
    const float slope2 = ex2(-0.5f * (float)(head + 1)) * LOG2E;
    const int tmin = 32 * c + 4 * w, tmax = tmin + 3;
    for (int i = tid; i < (64 + 65) * 32; i += NWAVES * 64) ((LAS float*)(lds + NSA_IMPG))[i] = 0.f;
    bf16x8 qf[6];
    { const GAS bf16* qp = (const GAS bf16*)(ws + WS_NQ) + row * 1536 + head * 96 + hi * 8;
#pragma unroll
      for (int s = 0; s < 6; ++s) qf[s] = *(const GAS bf16x8*)(qp + 16 * s); }
    const GAS bf16* ng = (const GAS bf16*)(ws + WS_NG) + row * 48;
    const float g_c = sigm(bf1(ng[head])), g_s = sigm(bf1(ng[16 + head])), g_w = sigm(bf1(ng[32 + head]));
    LAS float* ost = (LAS float*)(lds + NSA_OUT) + w * 2560 + lane;
    const size_t bg = (size_t)(b * 2 + g);
    __syncthreads();
    const int nmax = (t - 31) >> 4;
    const int wnmax = (tmax - 31) >> 4;
    const unsigned long long cmask = (2ull << ((2 * c) >> 6)) - 1ull;
    float m_c = 0.f, l_c = 0.f, invl_c; bool has_c = false;
    const int wnmin = (tmin - 31) >> 4;
    const int curmax = (32 * c + 31) >> 6;
    {
        f32x16 o0 = f32x16{}, o1 = f32x16{};
        nsa_branch<0, false, true>(C, (const GAS bf16*)(ws + WS_KCMP) + bg * 256 * 96, 96, (const GAS bf16*)(ws + WS_VCMP) + bg * 256 * 64, 64, cmask, qf, m_c, has_c, l_c, o0, o1,
                             t, 0, nmax, nmax >= 0, 0ull, 0ull, 0, wnmax, 0, wnmin, slope2, 16, 31, 0.f, qi);
        { auto rr = __builtin_amdgcn_permlane32_swap(__float_as_uint(l_c), __float_as_uint(l_c), false, false); l_c = __uint_as_float(rr[0]) + __uint_as_float(rr[1]); }
        invl_c = l_c > 0.f ? __builtin_amdgcn_rcpf(l_c) : 0.f;
        { LAS float* impG = (LAS float*)(lds + NSA_IMPG); LAS float* impL = (LAS float*)(lds + NSA_IMPL);
          const int nslot = wnmax >= 0 ? (wnmax >> 5) + 1 : 0;
          for (int slot = 0; slot < nslot; ++slot) {
              const LAS unsigned* ip = (const LAS unsigned*)(lds + NSA_OUT + ((w * 8 + slot) * 320 + lane) * 4);
              const unsigned g01 = ip[0], g23 = ip[64], l01 = ip[128], l23 = ip[192];
              const float scl = ex2(__builtin_fminf(__uint_as_float(ip[256]) - m_c, 0.f)) * invl_c;
              const float Gv[4] = {bflo(g01), bfhi(g01), bflo(g23), bfhi(g23)}, Lv[4] = {bflo(l01), bfhi(l01), bflo(l23), bfhi(l23)};
#pragma unroll
              for (int k = 0; k < 4; ++k) { float G = Gv[k] * scl, L = Lv[k] * scl;
                  G += __shfl_xor(G, 1); L += __shfl_xor(L, 1); G += __shfl_xor(G, 2); L += __shfl_xor(L, 2); G += __shfl_xor(G, 4); L += __shfl_xor(L, 4);
                  if ((r32 & 7) == 0) { const int jb = 8 * slot + 2 * k + hi; impG[jb * 32 + qi] = G; impL[(jb + 1) * 32 + qi] = L; } } } }
        const float sc = g_c * invl_c;
#pragma unroll
        for (int r = 0; r < 16; ++r) { ost[64 * r] = o0[r] * sc; ost[64 * (16 + r)] = o1[r] * sc; }
    }
    unsigned long long mymask = 0ull, wmask = 0ull;
    {
        const LAS float* impG = (const LAS float*)(lds + NSA_IMPG); const LAS float* impL = (const LAS float*)(lds + NSA_IMPL);
#pragma unroll
        for (int qq = 0; qq < 4; ++qq) {
            const int qx = 4 * w + qq, tq = 32 * c + qx, cur = tq >> 6, jj = lane;
            const float imp = impG[jj * 32 + qx] + impL[jj * 32 + qx];
            const bool forced = (jj == 0) | (jj == cur) | (jj == cur - 1);
            const int key = forced ? (0x7f000000 | (63 - jj)) : (jj <= cur ? ((__float_as_int(imp) & ~63) | (63 - jj)) : (-1 - jj));
            int rank = 0;
            for (int i8 = 0; i8 <= curmax; i8 += 8) {
#pragma unroll
                for (int i = 0; i < 8; ++i) { const int ki = __builtin_amdgcn_readlane(key, i8 + i); rank += (ki > key) ? 1 : 0; } }
            const unsigned long long sm = __ballot(rank < 16);
            wmask |= sm; if (q4 == qq) mymask = sm;
        }
        if (lane == 0) *(LAS unsigned long long*)(lds + NSA_WM + 8 * w) = wmask;
    }
    __syncthreads();
    unsigned long long umask = 0ull;
#pragma unroll
    for (int i = 0; i < 8; ++i) umask |= *(const LAS unsigned long long*)(lds + NSA_WM + 8 * i);
    umask &= (2ull << curmax) - 1ull;
    { const unsigned ulo = __builtin_amdgcn_readfirstlane((unsigned)umask), uhi = __builtin_amdgcn_readfirstlane((unsigned)(umask >> 32)); umask = ((unsigned long long)uhi << 32) | ulo; }
    { const unsigned wlo_ = __builtin_amdgcn_readfirstlane((unsigned)wmask), whi_ = __builtin_amdgcn_readfirstlane((unsigned)(wmask >> 32)); wmask = ((unsigned long long)whi_ << 32) | wlo_; }
    {
        float m_s = 0.f, l_s = 0.f; bool has_s = false; f32x16 o0 = f32x16{}, o1 = f32x16{};
        nsa_branch<0, true>(C, (const GAS bf16*)(ws + WS_KS) + ((size_t)b * SEQ) * 192 + g * 96, 192, (const GAS bf16*)(ws + WS_VS) + ((size_t)b * SEQ) * 128 + g * 64, 128, umask, qf, m_s, has_s, l_s, o0, o1,
                            t, 0, t, true, mymask, wmask, 0, tmax, 0, tmin, slope2, 1, 0, 0.f, qi);
        { auto rr = __builtin_amdgcn_permlane32_swap(__float_as_uint(l_s), __float_as_uint(l_s), false, false); l_s = __uint_as_float(rr[0]) + __uint_as_float(rr[1]); }
        const float sc = g_s * (l_s > 0.f ? __builtin_amdgcn_rcpf(l_s) : 0.f);
#pragma unroll
        for (int r = 0; r < 16; ++r) { ost[64 * r] += o0[r] * sc; ost[64 * (16 + r)] += o1[r] * sc; }
    }
    {
        const int plo = 32 * c - 511 > 0 ? 32 * c - 511 : 0;
        const int jlo = plo >> 6, jhi = (32 * c + 31) >> 6;
        const unsigned long long wm_ = ((2ull << jhi) - 1ull) & ~((1ull << jlo) - 1ull);
        float m_w = 0.f, l_w = 0.f; bool has_w = false; f32x16 o0 = f32x16{}, o1 = f32x16{};
        nsa_branch<0, false>(C, (const GAS bf16*)(ws + WS_KW) + ((size_t)b * SEQ) * 192 + g * 96, 192, (const GAS bf16*)(ws + WS_VW) + ((size_t)b * SEQ) * 128 + g * 64, 128, wm_, qf, m_w, has_w, l_w, o0, o1,
                             t, t - 511, t, true, 0ull, 0ull, tmin - 511, tmax, tmax - 511, tmin, slope2, 1, 0, 0.f, qi);
        { auto rr = __builtin_amdgcn_permlane32_swap(__float_as_uint(l_w), __float_as_uint(l_w), false, false); l_w = __uint_as_float(rr[0]) + __uint_as_float(rr[1]); }
        const float sc = g_w * (l_w > 0.f ? __builtin_amdgcn_rcpf(l_w) : 0.f);
        f32x16 out0, out1;
#pragma unroll
        for (int r = 0; r < 16; ++r) { out0[r] = ost[64 * r] + o0[r] * sc; out1[r] = ost[64 * (16 + r)] + o1[r] * sc; }
        LAS char* ot = lds + NSA_K0 + w * 4096;
#pragma unroll
        for (int k = 0; k < 4; ++k) { v2u w0; w0.x = pk2(out0[4 * k], out0[4 * k + 1]); w0.y = pk2(out0[4 * k + 2], out0[4 * k + 3]); *(LAS v2u*)(ot + q4 * 1024 + hh * 128 + (8 * k + 4 * hi) * 2) = w0;
            v2u w1; w1.x = pk2(out1[4 * k], out1[4 * k + 1]); w1.y = pk2(out1[4 * k + 2], out1[4 * k + 3]); *(LAS v2u*)(ot + q4 * 1024 + hh * 128 + (32 + 8 * k + 4 * hi) * 2) = w1; }
        GAS unsigned char* ob = outb + OUT_NSA + ((size_t)b * SEQ + 32 * c + 4 * w) * 2048 + g * 1024;
#pragma unroll
        for (int i = 0; i < 4; ++i) { const v4u v = *(const LAS v4u*)(ot + i * 1024 + lane * 16); *(GAS v4u*)(ob + (size_t)i * 2048 + lane * 16) = v; }
    }
}
__device__ __forceinline__ void p3_nsa(const Ctx& C, const Args& A) {
#if defined(DBG_COPY_OFF)
    { const bf16* src = (const bf16*)(A.ws + (size_t)DBG_COPY_OFF * MiB); bf16* o = (bf16*)((unsigned char*)A.out + OUT_NSA);
      for (size_t i = (size_t)C.vcu * 512 + C.tid; i < (size_t)M_TOK * 1024; i += (size_t)C.G * 512) { const size_t r = (i >> 10) & DBG_COPY_RMASK, c = i & 1023; o[i] = src[r * DBG_COPY_LD + (c % DBG_COPY_LD)]; } }
    return;
#endif
#if defined(DBG_NSA_ZERO)
    { v4u z = v4u{0u, 0u, 0u, 0u}; v4u* o = (v4u*)((unsigned char*)A.out + OUT_NSA);
      for (size_t i = (size_t)C.vcu * 512 + C.tid; i < (size_t)M_TOK * 1024 * 2 / 16; i += (size_t)C.G * 512) o[i] = z; }
    return;
#endif
    for (int u = C.vcu; u < 4096; u += C.G) {
        const int bg = (u & 255) >> 3, c = (u & 7) + 8 * (u >> 8);
        nsa_unit(C, A, bg >> 1, bg & 1, c);
    }
}


constexpr int RT_KZ = 0, RT_KZS = 144, RT_V = 128 * RT_KZS, RT_R = RT_V + 32768, RT_Y = RT_R + 128 * RT_KZS, RT_YS = 528, RT_END = RT_Y + 8 * 16 * RT_YS;
static_assert(RT_END <= LDSCTL_OFF, "retention LDS map");
typedef float f32x4v __attribute__((ext_vector_type(4)));
#ifndef RT_SPLIT
#define RT_SPLIT 18
#endif
#define RT_BAR() asm volatile("s_waitcnt lgkmcnt(0)\n\ts_barrier" ::: "memory")

__device__ __forceinline__ void ret_unit(const Ctx& C, const Args& A, int b, int h, int seg) {
    unsigned char* ws = A.ws;
    const int tid = C.tid, lane = C.lane, w = C.wave, i_in = lane & 15, fq = lane >> 4;
    LAS char* lds = (LAS char*)C.lds;
    const float eps_g = ex2(-5.f - (float)h);
    const float lg = -eps_g * (1.f + eps_g * (0.5f + eps_g * (0.33333334f + eps_g * (0.25f + eps_g * (0.2f + eps_g * 0.16666667f))))) * LOG2E;
    const float dec128 = ex2(128.f * lg);
    const int ic = 16 * w + i_in;
    const float gi = ex2((float)(ic - 127) * lg), xi = ex2((float)(ic + 1) * lg);
    unsigned long long wsu = (unsigned long long)ws, nsu = (unsigned long long)((const unsigned char*)A.out + OUT_NSA);
    const GAS bf16* wsb = (const GAS bf16*)wsu; const GAS bf16* nsb = (const GAS bf16*)nsu;
#define RT_OPAQUE() do { asm volatile("" : "+s"(wsu), "+s"(nsu)); wsb = (const GAS bf16*)wsu; nsb = (const GAS bf16*)nsu; } while (0)
    constexpr unsigned O_RQ = (unsigned)(WS_RQ / 2), O_RK = (unsigned)(WS_RK / 2), O_RV = (unsigned)(WS_RV / 2), O_RG = (unsigned)(WS_RG / 2), O_MG = (unsigned)(WS_MG / 2), O_MX = (unsigned)(WS_MIXIN / 2);
    const int ec = 8 * (lane & 15), er = lane >> 4;
    const f32x4 gnA = *(const f32x4*)(A.in[I_GNG] + h * 128 + ec), gnB = *(const f32x4*)(A.in[I_GNG] + h * 128 + ec + 4);
    f32x4v R[4];
#pragma unroll
    for (int dt = 0; dt < 4; ++dt) R[dt] = f32x4v{0.f, 0.f, 0.f, 0.f};
    const int tq = i_in >> 2, tp = i_in & 3;
    const int c_first = seg ? RT_SPLIT : 0, n_total = seg ? 32 : RT_SPLIT;
    if (c_first == 0) {
#pragma unroll
        for (int dt = 0; dt < 4; ++dt)
#pragma unroll
            for (int r = 0; r < 4; ++r) *(LAS bf16*)(lds + RT_R + (16 * w + 4 * fq + r) * RT_KZS + (16 * dt + i_in) * 2) = (bf16)0;
    }
    v4u sK[2], sV[4]; bf16x8 qn[2] = {bf16x8{}, bf16x8{}};
#define RT_LOADKV(chn) do { const unsigned T_ = (unsigned)(b * SEQ + (chn) * 128); \
        _Pragma("unroll") for (int i_ = 0; i_ < 2; ++i_) { const unsigned x_ = tid + 512 * i_; sK[i_] = *(const GAS v4u*)(wsb + (O_RK + (T_ + (x_ >> 3)) * 512u + h * 64 + (x_ & 7) * 8)); } \
        _Pragma("unroll") for (int i_ = 0; i_ < 4; ++i_) { const unsigned x_ = tid + 512 * i_; sV[i_] = *(const GAS v4u*)(wsb + (O_RV + (T_ + (x_ >> 4)) * 1024u + h * 128 + (x_ & 15) * 8)); } } while (0)
#define RT_LOADQ(chn) do { const unsigned qo_ = O_RQ + (unsigned)(b * SEQ + (chn) * 128 + ic) * 512u + h * 64 + 8 * fq; qn[0] = *(const GAS bf16x8*)(wsb + qo_); qn[1] = *(const GAS bf16x8*)(wsb + qo_ + 32); } while (0)
    RT_LOADKV(0); if (c_first == 0) RT_LOADQ(0);
#pragma unroll 1
    for (int ch = 0; ch < n_total; ++ch) {
        RT_OPAQUE();
        const bool full = ch >= c_first;
        const unsigned T0 = (unsigned)(b * SEQ + ch * 128);
#pragma unroll
        for (int i = 0; i < 2; ++i) { const int x = tid + 512 * i, rr = x >> 3, cc = x & 7; const v4u kv = sK[i];
            const float z = ex2((float)(127 - rr) * lg) * 0.125f;
            v4u o; o.x = pk2(bflo(kv.x) * z, bfhi(kv.x) * z); o.y = pk2(bflo(kv.y) * z, bfhi(kv.y) * z); o.z = pk2(bflo(kv.z) * z, bfhi(kv.z) * z); o.w = pk2(bflo(kv.w) * z, bfhi(kv.w) * z);
            *(LAS v4u*)(lds + RT_KZ + rr * RT_KZS + cc * 16) = o; }
#pragma unroll
        for (int i = 0; i < 4; ++i) { const int x = tid + 512 * i, rr = x >> 4, cc = x & 15;
            *(LAS v4u*)(lds + RT_V + (cc >> 1) * 4096 + rr * 32 + (cc & 1) * 16) = sV[i]; }
        const bf16x8 qf0 = qn[0], qf1 = qn[1];
        RT_BAR();
        if (ch + 1 < n_total) { RT_LOADKV(ch + 1); if (ch + 1 >= c_first) RT_LOADQ(ch + 1); }
        v4u eRG[4], eGA[4], eGB[4], eNS[4];
        if (full) {
#pragma unroll
            for (int k = 0; k < 4; ++k) { const unsigned rw = T0 + 16 * w + 4 * k + er; const unsigned e0 = h * 128 + ec;
                eRG[k] = *(const GAS v4u*)(wsb + (O_RG + rw * 1024u + e0)); eGA[k] = *(const GAS v4u*)(wsb + (O_MG + rw * 2048u + e0));
#if defined(RT_PROBE) && RT_PROBE == 2
                eGB[k] = *(const GAS v4u*)(wsb + (O_MG + rw * 2048u + 1024u + e0)); eNS[k] = *(const GAS v4u*)(nsb + (rw * 1024u + e0));
#endif
                }
        }
        if (full) {
            f32x4v acc[8];
#pragma unroll
            for (int et = 0; et < 8; ++et) { const LAS char* rp = lds + RT_R + (16 * et + i_in) * RT_KZS + fq * 16;
                f32x4v a = f32x4v{0.f, 0.f, 0.f, 0.f};
                a = __builtin_amdgcn_mfma_f32_16x16x32_bf16(*(const LAS bf16x8*)rp, qf0, a, 0, 0, 0);
                a = __builtin_amdgcn_mfma_f32_16x16x32_bf16(*(const LAS bf16x8*)(rp + 64), qf1, a, 0, 0, 0);
                acc[et] = a * xi; }
            bf16x8 pf[4];
#pragma unroll
            for (int a = 0; a < 4; ++a) {
                v4u pw = v4u{0u, 0u, 0u, 0u};
                if (2 * a <= w) {
#pragma unroll
                    for (int hf = 0; hf < 2; ++hf) { const int jt = 2 * a + hf;
                        if (jt <= w) { const LAS char* kp = lds + RT_KZ + (16 * jt + i_in) * RT_KZS + fq * 16;
                            f32x4v s = f32x4v{0.f, 0.f, 0.f, 0.f};
                            s = __builtin_amdgcn_mfma_f32_16x16x32_bf16(*(const LAS bf16x8*)kp, qf0, s, 0, 0, 0);
                            s = __builtin_amdgcn_mfma_f32_16x16x32_bf16(*(const LAS bf16x8*)(kp + 64), qf1, s, 0, 0, 0);
                            float pv[4];
#pragma unroll
                            for (int r = 0; r < 4; ++r) pv[r] = (jt < w || (4 * fq + r) <= i_in) ? s[r] * gi : 0.f;
                            if (hf == 0) { pw.x = pk2(pv[0], pv[1]); pw.y = pk2(pv[2], pv[3]); } else { pw.z = pk2(pv[0], pv[1]); pw.w = pk2(pv[2], pv[3]); } } }
                }
                pf[a] = __builtin_bit_cast(bf16x8, pw);
            }
#if !defined(RT_PROBE) || RT_PROBE != 2
#pragma unroll
            for (int k = 0; k < 4; ++k) { const unsigned rw = T0 + 16 * w + 4 * k + er; const unsigned e0 = h * 128 + ec;
                eGB[k] = *(const GAS v4u*)(wsb + (O_MG + rw * 2048u + 1024u + e0)); eNS[k] = *(const GAS v4u*)(nsb + (rw * 1024u + e0)); }
#endif
#pragma unroll
            for (int a = 0; a < 4; ++a) {
                if (2 * a <= w) {
#pragma unroll
                    for (int et = 0; et < 8; ++et) { const LAS char* vp = lds + RT_V + et * 4096 + (32 * a + 4 * fq + tq) * 32 + tp * 8;
                        const s16x4 lo_ = trrd(vp), hi_ = trrd(vp + 16 * 32);
                        acc[et] = __builtin_amdgcn_mfma_f32_16x16x32_bf16(MK8(lo_, hi_), pf[a], acc[et], 0, 0, 0); }
                }
            }
            float s1 = 0.f;
#pragma unroll
            for (int et = 0; et < 8; ++et) s1 += (acc[et][0] + acc[et][1]) + (acc[et][2] + acc[et][3]);
            s1 += __shfl_xor(s1, 16); s1 += __shfl_xor(s1, 32);
            const float mu = s1 * (1.f / 128.f);
            float s2 = 0.f;
#pragma unroll
            for (int et = 0; et < 8; ++et) { const f32x4v dlt = acc[et] - mu; s2 += (dlt[0] * dlt[0] + dlt[1] * dlt[1]) + (dlt[2] * dlt[2] + dlt[3] * dlt[3]); }
            s2 += __shfl_xor(s2, 16); s2 += __shfl_xor(s2, 32);
            const float rstd = __builtin_amdgcn_rsqf(s2 * (1.f / 128.f) + GN_EPS);
            LAS char* yw = lds + RT_Y + w * (16 * RT_YS);
#pragma unroll
            for (int et = 0; et < 8; ++et) *(LAS f32x4v*)(yw + i_in * RT_YS + (16 * et + 4 * fq) * 4) = (acc[et] - mu) * rstd;
            LDS_WAIT();
#pragma unroll
            for (int k = 0; k < 4; ++k) { const f32x4v ya = *(const LAS f32x4v*)(yw + (4 * k + er) * RT_YS + ec * 4), yb = *(const LAS f32x4v*)(yw + (4 * k + er) * RT_YS + ec * 4 + 16);
                const float yf_[8] = {ya[0], ya[1], ya[2], ya[3], yb[0], yb[1], yb[2], yb[3]};
                const unsigned rg_[4] = {eRG[k].x, eRG[k].y, eRG[k].z, eRG[k].w}, ga_[4] = {eGA[k].x, eGA[k].y, eGA[k].z, eGA[k].w};
                const unsigned gb_[4] = {eGB[k].x, eGB[k].y, eGB[k].z, eGB[k].w}, ns_[4] = {eNS[k].x, eNS[k].y, eNS[k].z, eNS[k].w};
                const float gn_[8] = {gnA.x, gnA.y, gnA.z, gnA.w, gnB.x, gnB.y, gnB.z, gnB.w};
                unsigned ow[4];
#pragma unroll
                for (int q = 0; q < 4; ++q) { float o2[2];
#pragma unroll
                    for (int hh = 0; hh < 2; ++hh) { const float y = yf_[2 * q + hh] * gn_[2 * q + hh], rg = hh ? bfhi(rg_[q]) : bflo(rg_[q]), ga = hh ? bfhi(ga_[q]) : bflo(ga_[q]);
                        const float gb = hh ? bfhi(gb_[q]) : bflo(gb_[q]), nsv = hh ? bfhi(ns_[q]) : bflo(ns_[q]);
                        const float den = (1.f + ex2(-rg * LOG2E)) * (1.f + ex2(-ga));
                        o2[hh] = rg * __builtin_amdgcn_rcpf(den) * y + __builtin_amdgcn_rcpf(1.f + ex2(-gb)) * nsv; }
                    ow[q] = pk2(o2[0], o2[1]); }
                v4u ov; ov.x = ow[0]; ov.y = ow[1]; ov.z = ow[2]; ov.w = ow[3];
                *(GAS v4u*)((GAS bf16*)wsb + (O_MX + (T0 + 16 * w + 4 * k + er) * 1024u + h * 128 + ec)) = ov; }
        }
#pragma unroll
        for (int dt = 0; dt < 4; ++dt) R[dt] = R[dt] * dec128;
#pragma unroll
        for (int a = 0; a < 4; ++a) { const LAS char* vp = lds + RT_V + w * 4096 + (32 * a + 4 * fq + tq) * 32 + tp * 8;
            const s16x4 vlo = trrd(vp), vhi = trrd(vp + 16 * 32); const bf16x8 vf = MK8(vlo, vhi);
#pragma unroll
            for (int dt = 0; dt < 4; ++dt) { const LAS char* kp = lds + RT_KZ + (32 * a + 4 * fq + tq) * RT_KZS + (16 * dt + 4 * tp) * 2;
                const s16x4 klo = trrd(kp), khi = trrd(kp + 16 * RT_KZS);
                R[dt] = __builtin_amdgcn_mfma_f32_16x16x32_bf16(vf, MK8(klo, khi), R[dt], 0, 0, 0); } }
        RT_BAR();
        if (ch + 1 >= c_first && ch + 1 < n_total) {
#pragma unroll
            for (int dt = 0; dt < 4; ++dt)
#pragma unroll
                for (int r = 0; r < 4; ++r) *(LAS bf16*)(lds + RT_R + (16 * w + 4 * fq + r) * RT_KZS + (16 * dt + i_in) * 2) = (bf16)(pk2(R[dt][r], 0.f) & 0xffffu);
        }
    }
    __syncthreads();
#undef RT_LOADKV
#undef RT_OPAQUE
#undef RT_LOADQ
}
__device__ __forceinline__ void p4_retention(const Ctx& C, const Args& A) {
    for (int u = C.vcu; u < 256; u += C.G) ret_unit(C, A, u >> 4, (u >> 1) & 7, u & 1);
}


template <bool XF32>
__device__ __forceinline__ void thin_phase(const Ctx& C, const void* xi, const bf16* add, const float* ssp, const float* g_post, bf16* xo, float* rso) {
    const int gw = C.vcu * NWAVES + C.wave, NGW = C.G * NWAVES, lane = C.lane;
    for (int m = gw; m < M_TOK; m += NGW) {
        const float sp = lane < 16 ? ssp[(size_t)m * 16 + lane] : 0.f;
        const float rs = __builtin_amdgcn_rsqf(wave_sum(sp) * (1.f / DM) + RMS_EPS);
        const GAS v2u* ar = (const GAS v2u*)(add + (size_t)m * DM) + lane; const GAS f32x4* gp = (const GAS f32x4*)g_post + lane;
        f32x4 v[4]; float s = 0.f;
#pragma unroll
        for (int j = 0; j < 4; ++j) { f32x4 x;
            if (XF32) x = ((const GAS f32x4*)((const float*)xi + (size_t)m * DM) + lane)[64 * j];
            else { const v2u xb = ((const GAS v2u*)((const bf16*)xi + (size_t)m * DM) + lane)[64 * j]; x = f32x4{bflo(xb.x), bfhi(xb.x), bflo(xb.y), bfhi(xb.y)}; }
            const f32x4 g = gp[64 * j]; const v2u a = ar[64 * j];
            v[j].x = x.x + bflo(a.x) * rs * g.x; v[j].y = x.y + bfhi(a.x) * rs * g.y; v[j].z = x.z + bflo(a.y) * rs * g.z; v[j].w = x.w + bfhi(a.y) * rs * g.w;
            s += (v[j].x * v[j].x + v[j].y * v[j].y) + (v[j].z * v[j].z + v[j].w * v[j].w); }
        GAS v2u* hw = (GAS v2u*)(xo + (size_t)m * DM) + lane;
#pragma unroll
        for (int j = 0; j < 4; ++j) { v2u w; w.x = pk2(v[j].x, v[j].y); w.y = pk2(v[j].z, v[j].w); hw[64 * j] = w; }
        const float r2 = __builtin_amdgcn_rsqf(wave_sum(s) * (1.f / DM) + RMS_EPS);
        if (lane == 0) rso[m] = r2;
    }
}

#define CAS __attribute__((address_space(4)))
__device__ __forceinline__ Args load_args() {
    Args a{};
#if defined(__HIP_DEVICE_COMPILE__)
    const CAS Args* p_ = (const CAS Args*)__builtin_amdgcn_kernarg_segment_ptr(); asm volatile("" : "+s"(p_));
#pragma unroll
    for (int i = 0; i < 19; ++i) a.in[i] = p_->in[i];
    a.out = p_->out; a.ws = p_->ws; a.ph_lo = p_->ph_lo; a.ph_hi = p_->ph_hi; a.li = p_->li; a.pad = 0;
#endif
    return a;
}
__global__ void __launch_bounds__(NWAVES * 64, 2) hyb_fwd(Args args) {
    extern __shared__ __attribute__((aligned(16))) unsigned char lds[];
#define MKCTX() Ctx C; C.lds = (LAS unsigned char*)lds; C.tid = threadIdx.x; C.lane = C.tid & 63; C.wave = __builtin_amdgcn_readfirstlane(C.tid >> 6); \
    C.G = gridDim.x; { const int bx_ = blockIdx.x; C.vcu = (C.G % 8 == 0) ? (bx_ % 8) * (C.G / 8) + bx_ / 8 : bx_; }
    volatile LAS unsigned* MISC = (volatile LAS unsigned*)((LAS unsigned char*)lds + MISC_OFF);
    gu32* ctl = (gu32*)(args.ws + WS_CTL);
    for (int u = threadIdx.x; u < (LDS_BYTES - LDSCTL_OFF) / 4; u += NWAVES * 64) ((LAS unsigned*)((LAS unsigned char*)lds + LDSCTL_OFF))[u] = 0u;
    __syncthreads();
    XcdBarrier bar; bar.bar = (unsigned*)(ctl + CW_BAR); bar.x = 0; bar.st = nullptr;
    if (N_LAUNCHES == 1) bar = xcd_barrier_post((unsigned*)(ctl + CW_BAR), MISC + 8);
    const int lo = args.ph_lo, hi = args.ph_hi;
#ifndef PH_REP
#define PH_REP 0
#endif
#ifndef PH_MASK
#define PH_MASK 0x7ff
#endif
#define IN(k) (((PH_MASK >> (k)) & 1) && lo <= (k) && (k) < hi)
#define SEAM(k) do { if (IN(k) && IN((k) + 1)) xcd_barrier(bar); } while (0)
#define LOAD_ARGS(Av) const Args Av = load_args(); unsigned char* ws = Av.ws; (void)ws

    if (IN(0)) { LOAD_ARGS(a); MKCTX(); LAS unsigned char* ring = C.lds; const int bx = (int)blockIdx.x; (void)ring; (void)bx; p0_prologue(C, a); if ((PH_REP >> 0) & 1) { __syncthreads(); p0_prologue(C, a); } }
    SEAM(0);
    if (IN(1)) { LOAD_ARGS(a); MKCTX(); LAS unsigned char* ring = C.lds; const int bx = (int)blockIdx.x; (void)ring; (void)bx;
        pg8::Gemm g{(const bf16*)((const unsigned char*)a.out + OUT_H), (const bf16*)(ws + WS_WIN), M_TOK, IN_VIRT, DM}; pg8::StaticOrder S; S.init(M_TOK, IN_VIRT, C.G, bx);
        pg8::EpiProj E{(bf16*)ws, ring, (unsigned char*)a.out + 160 * MiB};
#if defined(P1_STAGGER)
        for (int i = 0; i < ((bx >> 3) & 3) * P1_STAGGER; ++i) __builtin_amdgcn_s_sleep(127);
#endif
        pg8::gemm_phase<pg8::EpiProj, pg8::StaticOrder, true, true>(ring, g, S, E);
#if defined(GEMM_PROBE)
        { __syncthreads(); asm volatile("" ::: "memory"); __builtin_amdgcn_sched_barrier(0); pg8::EpiNone EN{ring}; pg8::gemm_phase<pg8::EpiNone, pg8::StaticOrder, true, true>(ring, g, S, EN); }
#else
        if ((PH_REP >> 1) & 1) { __syncthreads(); asm volatile("" ::: "memory"); __builtin_amdgcn_sched_barrier(0); pg8::gemm_phase<pg8::EpiProj, pg8::StaticOrder, true, true>(ring, g, S, E); }
#endif
    }
    SEAM(1);
    if (IN(2)) { LOAD_ARGS(a); MKCTX(); LAS unsigned char* ring = C.lds; const int bx = (int)blockIdx.x; (void)ring; (void)bx; p2_compress(C, a); if ((PH_REP >> 2) & 1) { __syncthreads(); p2_compress(C, a); } }
    SEAM(2);
    if (IN(3)) { LOAD_ARGS(a); MKCTX(); LAS unsigned char* ring = C.lds; const int bx = (int)blockIdx.x; (void)ring; (void)bx; p3_nsa(C, a); if ((PH_REP >> 3) & 1) { __syncthreads(); p3_nsa(C, a); } }
    SEAM(3);
    if (IN(4)) { LOAD_ARGS(a); MKCTX(); LAS unsigned char* ring = C.lds; const int bx = (int)blockIdx.x; (void)ring; (void)bx; p4_retention(C, a); if ((PH_REP >> 4) & 1) { __syncthreads(); p4_retention(C, a); } }
    SEAM(4);
    if (IN(5)) { LOAD_ARGS(a); MKCTX(); LAS unsigned char* ring = C.lds; const int bx = (int)blockIdx.x; (void)ring; (void)bx;
        { pg8::Gemm g{(const bf16*)(ws + WS_MIXIN), (const bf16*)(ws + WS_WOUT), M_TOK, DM, DM}; pg8::StaticOrder S; S.init(M_TOK, DM, C.G, bx);
          pg8::EpiNormRes<true> E{(const void*)a.in[I_X], (bf16*)(ws + WS_H2), a.in[I_NMPOST], (float*)(ws + WS_SSP), (unsigned*)(ws + WS_XBUF), (unsigned*)(ws + WS_CTL + CW_XCNT2), ring};
          pg8::gemm_phase<pg8::EpiNormRes<true>, pg8::StaticOrder, true, true>(ring, g, S, E); }
        __syncthreads(); asm volatile("" ::: "memory"); __builtin_amdgcn_sched_barrier(0);
        { pg8::Gemm g{(const bf16*)((const unsigned char*)a.out + OUT_PBF), (const bf16*)(ws + WS_WPLE), M_TOK, DM, PLE_D}; pg8::StaticOrder S; S.init(M_TOK, DM, C.G, bx);
          pg8::EpiPlain E{(bf16*)(ws + WS_PLEO), DM, ring};
          pg8::gemm_phase<pg8::EpiPlain, pg8::StaticOrder, true, true>(ring, g, S, E); }
    }
    SEAM(5);
    if (IN(7)) { LOAD_ARGS(a); MKCTX(); LAS unsigned char* ring = C.lds; const int bx = (int)blockIdx.x; (void)ring; (void)bx;
        pg8::Gemm g{(const bf16*)(ws + WS_H2), (const bf16*)(ws + WS_WFI), M_TOK, 2 * DFF, DM}; pg8::StaticOrder S; S.init(M_TOK, 2 * DFF, C.G, bx);
        pg8::EpiSwiglu E{(bf16*)(ws + WS_ACT), (const float*)(ws + WS_SSP)};
        pg8::gemm_phase<pg8::EpiSwiglu, pg8::StaticOrder, true, true>(ring, g, S, E);
        if ((PH_REP >> 7) & 1) { __syncthreads(); asm volatile("" ::: "memory"); __builtin_amdgcn_sched_barrier(0); pg8::gemm_phase<pg8::EpiSwiglu, pg8::StaticOrder, true, true>(ring, g, S, E); }
    }
    SEAM(7);
    if (IN(8)) { LOAD_ARGS(a); MKCTX(); LAS unsigned char* ring = C.lds; const int bx = (int)blockIdx.x; (void)ring; (void)bx;
        pg8::Gemm g{(const bf16*)(ws + WS_ACT), (const bf16*)(ws + WS_WFO), M_TOK, DM, DFF}; pg8::StaticOrder S; S.init(M_TOK, DM, C.G, bx);
        pg8::EpiNormRes<false> E{(const void*)(ws + WS_H2), (bf16*)(ws + WS_H2), a.in[I_NFPOST], (float*)(ws + WS_SSP2), (unsigned*)(ws + WS_XBUF), (unsigned*)(ws + WS_CTL + CW_XCNT), ring};
        pg8::gemm_phase<pg8::EpiNormRes<false>, pg8::StaticOrder, true, true>(ring, g, S, E);
    }
    SEAM(8);
    if (IN(10)) { LOAD_ARGS(a); MKCTX(); LAS unsigned char* ring = C.lds; const int bx = (int)blockIdx.x; (void)ring; (void)bx;
        pg8::Gemm g{(const bf16*)(ws + WS_H2), (const bf16*)(ws + WS_WG), M_TOK, DM, DM}; pg8::StaticOrder S; S.init(M_TOK, DM, C.G, bx);
        pg8::EpiFinal E{(const bf16*)(ws + WS_H2), (const bf16*)(ws + WS_PLEO), (const float*)(ws + WS_SSP2), a.out, ring};
#if defined(P10_STAGGER)
        for (int i = 0; i < (bx & (P10_GROUPS - 1)) * P10_STAGGER; ++i) __builtin_amdgcn_s_sleep(127);
#endif
        pg8::gemm_phase<pg8::EpiFinal, pg8::StaticOrder, true, true>(ring, g, S, E);
        if ((PH_REP >> 10) & 1) { __syncthreads(); asm volatile("" ::: "memory"); __builtin_amdgcn_sched_barrier(0); pg8::gemm_phase<pg8::EpiFinal, pg8::StaticOrder, true, true>(ring, g, S, E); }
    }
#undef IN
#undef SEAM
}

static_assert(pg8::EPI_X_END <= LDSCTL_OFF, "fused-epilogue LDS tables fit below the control words");
extern "C" void kernel_launch(void* const* d_in, const int* in_sizes, int n_in, void* d_out, int out_size, void* d_ws, size_t ws_size, hipStream_t stream) {
    static int grid = 0;
    if (grid == 0) {
        if (n_in != 19 || in_sizes[0] != M_TOK * DM || out_size != M_TOK * DM || ws_size < WS_END) {
            fprintf(stderr, "kernel_launch: built for 19 inputs, x/out of %d floats, >= %zu bytes of workspace; got n_in %d, in0 %d, out %d, ws %zu; nothing launched\n", M_TOK * DM, (size_t)WS_END, n_in, n_in > 0 ? in_sizes[0] : -1, out_size, ws_size);
            grid = -1; return; }
        int dev = 0, cus = 0, per_cu = 0;
        if (hipGetDevice(&dev) != hipSuccess || hipDeviceGetAttribute(&cus, hipDeviceAttributeMultiprocessorCount, dev) != hipSuccess) { fprintf(stderr, "kernel_launch: device query failed\n"); grid = -1; return; }
        if (hipFuncSetAttribute((const void*)hyb_fwd, hipFuncAttributeMaxDynamicSharedMemorySize, LDS_BYTES) != hipSuccess) { fprintf(stderr, "kernel_launch: hipFuncSetAttribute failed\n"); grid = -1; return; }
        if (hipOccupancyMaxActiveBlocksPerMultiprocessor(&per_cu, (const void*)hyb_fwd, NWAVES * 64, LDS_BYTES) != hipSuccess || per_cu < 1)
            fprintf(stderr, "kernel_launch: note: occupancy query reports %d workgroups per CU\n", per_cu);
        (void)hipGetLastError();
        grid = cus;
    }
    if (grid < 0) return;
    if (N_LAUNCHES == 1) { if (hipMemsetAsync((char*)d_ws + WS_CTL, 0, CTL_ZERO_BYTES, stream) != hipSuccess) { fprintf(stderr, "kernel_launch: hipMemsetAsync failed\n"); return; } }
    Args a{};
    for (int i = 0; i < 19; ++i) a.in[i] = (const float*)d_in[i];
    a.out = (float*)d_out; a.ws = (unsigned char*)d_ws;
    for (int li = 0; li < N_LAUNCHES; ++li) {
        a.ph_lo = (N_LAUNCHES == 1) ? 0 : li; a.ph_hi = (N_LAUNCHES == 1) ? N_PHASES : li + 1; a.li = li; a.pad = 0;
        hipLaunchKernelGGL(hyb_fwd, dim3(grid), dim3(NWAVES * 64), LDS_BYTES, stream, a);
        const hipError_t le = hipPeekAtLastError();
        if (le != hipSuccess) { fprintf(stderr, "kernel_launch: launch %d failed: %s\n", li, hipGetErrorName(le)); break; }
    }
}
```
